# Optimizing an MI355X kernel written in HIP

```python
import math
import jax, jax.numpy as jnp
from jax import lax
import numpy as np

D_MODEL = 2048
BATCH = 4
SEQ = 2048
DEPTH = 4

N_META = 16
EPS = 1e-6
ATT_HEADS = 8
QK_NOPE = 128
QK_ROPE = 64
V_DIM = 128
Q_LORA = 512
KV_LORA = 256
ROPE_THETA = 10000.0
Q_BLOCK = 128
ATT_WIDTH = ATT_HEADS * V_DIM
SSM_GROUP = 16
SSM_WIDTH = D_MODEL - ATT_WIDTH
SSM_GROUPS = SSM_WIDTH // SSM_GROUP
SSM_STATE = 64
DT_MIN = 1e-3
DT_MAX = 1e-1
MIX_WIDTH = ATT_WIDTH + SSM_WIDTH
IN_COLS = Q_LORA + KV_LORA + QK_ROPE + SSM_WIDTH
D_FF = 5632
N_EXPERTS = 8
TOP_K = 2
D_FF_EXPERT = 1408
N_DENSE = (DEPTH + 1) // 2
N_MOE = DEPTH // 2

kernel_name = "hybrid_mla_s5_moe_encoder"

F32 = jnp.float32


def rms_norm(x, g):
    xf = x.astype(F32)
    y = xf * lax.rsqrt(jnp.mean(xf * xf, axis=-1, keepdims=True) + EPS)
    return (y * g.astype(F32)).astype(x.dtype)


def rope_tables(n):
    inv = ROPE_THETA ** (-jnp.arange(0, QK_ROPE, 2, dtype=F32) / QK_ROPE)
    ang = jnp.arange(n, dtype=F32)[:, None] * inv[None, :]
    return jnp.cos(ang), jnp.sin(ang)


def apply_rope(x, cos, sin):
    xf = x.astype(F32)
    x1, x2 = jnp.split(xf, 2, axis=-1)
    return jnp.concatenate([x1 * cos - x2 * sin, x1 * sin + x2 * cos], axis=-1).astype(x.dtype)


def mla_attention(c_q, c_kv, k_rope, q_norm, w_uq, kv_norm, w_ukv, cos, sin):
    bsz, L, _ = c_q.shape
    q = (rms_norm(c_q, q_norm) @ w_uq).reshape(bsz, L, ATT_HEADS, QK_NOPE + QK_ROPE)
    q = jnp.concatenate([q[..., :QK_NOPE], apply_rope(q[..., QK_NOPE:], cos[:, None, :], sin[:, None, :])], axis=-1)
    kv = (rms_norm(c_kv, kv_norm) @ w_ukv).reshape(bsz, L, ATT_HEADS, QK_NOPE + V_DIM)
    k_nope, v = kv[..., :QK_NOPE], kv[..., QK_NOPE:]
    k_pe = apply_rope(k_rope, cos, sin)
    k = jnp.concatenate([k_nope, jnp.broadcast_to(k_pe[:, :, None, :], (bsz, L, ATT_HEADS, QK_ROPE))], axis=-1)
    n_blk = -(-L // Q_BLOCK)
    lp = n_blk * Q_BLOCK
    q = jnp.pad(q, ((0, 0), (0, lp - L), (0, 0), (0, 0)))
    qb = q.reshape(bsz, n_blk, Q_BLOCK, ATT_HEADS, QK_NOPE + QK_ROPE).transpose(1, 0, 2, 3, 4)
    scale = (QK_NOPE + QK_ROPE) ** -0.5

    def block(q_blk):
        s = jnp.einsum('bqhd,bkhd->bhqk', q_blk, k, preferred_element_type=F32) * scale
        p = jax.nn.softmax(s, axis=-1)
        return jnp.einsum('bhqk,bkhd->bqhd', p.astype(v.dtype), v)

    o = lax.map(block, qb)
    return o.transpose(1, 0, 2, 3, 4).reshape(bsz, lp, ATT_WIDTH)[:, :L]


def s5_direction(u_c, lam_re, lam_im, log_step, b_re, b_im, c_re, c_im, reverse):
    lam = lax.complex(lam_re.astype(F32), lam_im.astype(F32))
    dt = jnp.exp(log_step.astype(F32))[:, None]
    lam_bar = jnp.exp(lam * dt)
    b = lax.complex(b_re.astype(F32), b_im.astype(F32))
    b_bar = ((lam_bar - 1.0) / lam)[..., None] * b
    bu = jnp.einsum('gpc,blgc->blgp', b_bar, u_c)
    a = jnp.broadcast_to(lam_bar, bu.shape)

    def combine(left, right):
        a_l, b_l = left
        a_r, b_r = right
        return a_r * a_l, a_r * b_l + b_r

    _, h = lax.associative_scan(combine, (a, bu), axis=1, reverse=reverse)
    c = lax.complex(c_re.astype(F32), c_im.astype(F32))
    return jnp.real(jnp.einsum('gcp,blgp->blgc', c, h))


def s5_mixer(u, lam_re, lam_im, log_step, b_re, b_im, c_re, c_im, d_skip, w_glu):
    bsz, L, _ = u.shape
    uf = u.astype(F32)
    ug = uf.reshape(bsz, L, SSM_GROUPS, SSM_GROUP)
    uc = lax.complex(ug, jnp.zeros_like(ug))
    y_fwd = s5_direction(uc, lam_re[0], lam_im[0], log_step[0], b_re[0], b_im[0], c_re[0], c_im[0], False)
    y_bwd = s5_direction(uc, lam_re[1], lam_im[1], log_step[1], b_re[1], b_im[1], c_re[1], c_im[1], True)
    y = (y_fwd + y_bwd).reshape(bsz, L, SSM_WIDTH) + d_skip.astype(F32) * uf
    g = jax.nn.gelu(y).astype(u.dtype)
    return g * jax.nn.sigmoid(g @ w_glu)


def swiglu(x, w_gate, w_up, w_down):
    return (jax.nn.silu(x @ w_gate) * (x @ w_up)) @ w_down


def moe_swiglu(x, w_router, w_gate, w_up, w_down):
    bsz, L, d = x.shape
    t = x.reshape(bsz * L, d)
    logits = (t @ w_router).astype(F32)
    top_val, top_idx = lax.top_k(logits, TOP_K)
    top_w = jax.nn.softmax(top_val, axis=-1)
    gates = jnp.sum(jax.nn.one_hot(top_idx, N_EXPERTS, dtype=F32) * top_w[..., None], axis=1)
    hid = jax.nn.silu(jnp.einsum('td,edf->etf', t, w_gate)) * jnp.einsum('td,edf->etf', t, w_up)
    hid = hid * gates.T[:, :, None].astype(hid.dtype)
    out = jnp.einsum('etf,efd->td', hid, w_down)
    return out.reshape(bsz, L, d)


def setup_inputs(seed: int = 0) -> dict:
    key = jax.random.key(seed)
    ks = iter(jax.random.split(key, 40))
    nrm = lambda shape, s: jax.random.normal(next(ks), shape, F32) * s
    gain = lambda shape: 1.0 + 0.01 * jax.random.normal(next(ks), shape, F32)
    res_scale = (2 * DEPTH) ** -0.5
    n_idx = jnp.arange(SSM_STATE, dtype=F32)
    lam_re = -0.5 + 0.01 * jax.random.normal(next(ks), (DEPTH, 2, SSM_GROUPS, SSM_STATE), F32)
    lam_im = math.pi * n_idx + 0.01 * jax.random.normal(next(ks), (DEPTH, 2, SSM_GROUPS, SSM_STATE), F32)
    log_step = jax.random.uniform(next(ks), (DEPTH, 2, SSM_GROUPS), F32, math.log(DT_MIN), math.log(DT_MAX))
    return {
        "x": nrm((BATCH, SEQ, D_MODEL), 1.0),
        "meta_tokens": nrm((N_META, D_MODEL), 1.0),
        "mix_norm": gain((DEPTH, D_MODEL)),
        "w_in": nrm((DEPTH, D_MODEL, IN_COLS), D_MODEL ** -0.5),
        "q_norm": gain((DEPTH, Q_LORA)),
        "w_uq": nrm((DEPTH, Q_LORA, ATT_HEADS * (QK_NOPE + QK_ROPE)), Q_LORA ** -0.5),
        "kv_norm": gain((DEPTH, KV_LORA)),
        "w_ukv": nrm((DEPTH, KV_LORA, ATT_HEADS * (QK_NOPE + V_DIM)), KV_LORA ** -0.5),
        "ssm_lambda_re": lam_re,
        "ssm_lambda_im": lam_im,
        "ssm_log_step": log_step,
        "ssm_b_re": nrm((DEPTH, 2, SSM_GROUPS, SSM_STATE, SSM_GROUP), (2 * SSM_GROUP) ** -0.5),
        "ssm_b_im": nrm((DEPTH, 2, SSM_GROUPS, SSM_STATE, SSM_GROUP), (2 * SSM_GROUP) ** -0.5),
        "ssm_c_re": nrm((DEPTH, 2, SSM_GROUPS, SSM_GROUP, SSM_STATE), 0.5),
        "ssm_c_im": nrm((DEPTH, 2, SSM_GROUPS, SSM_GROUP, SSM_STATE), 0.5),
        "ssm_d": nrm((DEPTH, SSM_WIDTH), 0.5),
        "ssm_w_glu": nrm((DEPTH, SSM_WIDTH, SSM_WIDTH), SSM_WIDTH ** -0.5),
        "attn_out_norm": gain((DEPTH, ATT_WIDTH)),
        "ssm_out_norm": gain((DEPTH, SSM_WIDTH)),
        "w_out": nrm((DEPTH, MIX_WIDTH, D_MODEL), MIX_WIDTH ** -0.5 * res_scale),
        "ffn_norm": gain((DEPTH, D_MODEL)),
        "dense_w_gate": nrm((N_DENSE, D_MODEL, D_FF), D_MODEL ** -0.5),
        "dense_w_up": nrm((N_DENSE, D_MODEL, D_FF), D_MODEL ** -0.5),
        "dense_w_down": nrm((N_DENSE, D_FF, D_MODEL), D_FF ** -0.5 * res_scale),
        "moe_router": nrm((N_MOE, D_MODEL, N_EXPERTS), D_MODEL ** -0.5),
        "moe_w_gate": nrm((N_MOE, N_EXPERTS, D_MODEL, D_FF_EXPERT), D_MODEL ** -0.5),
        "moe_w_up": nrm((N_MOE, N_EXPERTS, D_MODEL, D_FF_EXPERT), D_MODEL ** -0.5),
        "moe_w_down": nrm((N_MOE, N_EXPERTS, D_FF_EXPERT, D_MODEL), D_FF_EXPERT ** -0.5 * res_scale),
        "final_norm": gain((D_MODEL,)),
    }


def reference(x, meta_tokens, mix_norm, w_in, q_norm, w_uq, kv_norm, w_ukv,
              ssm_lambda_re, ssm_lambda_im, ssm_log_step, ssm_b_re, ssm_b_im, ssm_c_re, ssm_c_im,
              ssm_d, ssm_w_glu, attn_out_norm, ssm_out_norm, w_out, ffn_norm,
              dense_w_gate, dense_w_up, dense_w_down,
              moe_router, moe_w_gate, moe_w_up, moe_w_down, final_norm):
    bsz, seq, d = x.shape
    L = N_META + seq
    meta = jnp.broadcast_to(meta_tokens[None].astype(x.dtype), (bsz, N_META, d))
    h = jnp.concatenate([meta, x], axis=1)
    cos, sin = rope_tables(L)
    splits = [Q_LORA, Q_LORA + KV_LORA, Q_LORA + KV_LORA + QK_ROPE]
    for layer in range(DEPTH):
        hn = rms_norm(h, mix_norm[layer])
        proj = hn @ w_in[layer]
        c_q, c_kv, k_rope, u = jnp.split(proj, splits, axis=-1)
        att = mla_attention(c_q, c_kv, k_rope, q_norm[layer], w_uq[layer],
                            kv_norm[layer], w_ukv[layer], cos, sin)
        ssm = s5_mixer(u, ssm_lambda_re[layer], ssm_lambda_im[layer], ssm_log_step[layer],
                       ssm_b_re[layer], ssm_b_im[layer], ssm_c_re[layer], ssm_c_im[layer],
                       ssm_d[layer], ssm_w_glu[layer])
        mixed = jnp.concatenate([rms_norm(att, attn_out_norm[layer]),
                                 rms_norm(ssm.astype(h.dtype), ssm_out_norm[layer])], axis=-1)
        h = h + mixed @ w_out[layer]
        hn = rms_norm(h, ffn_norm[layer])
        if layer % 2 == 0:
            i = layer // 2
            h = h + swiglu(hn, dense_w_gate[i], dense_w_up[i], dense_w_down[i])
        else:
            i = layer // 2
            h = h + moe_swiglu(hn, moe_router[i], moe_w_gate[i], moe_w_up[i], moe_w_down[i])
    out = rms_norm(h, final_norm)[:, N_META:]
    return out
```

```cpp
#include <hip/hip_runtime.h>
#include <cstdio>
#include <cstdint>

#ifndef PROBE_REP
#define PROBE_REP 0
#endif
#ifndef DBG
#define DBG 0
#endif

constexpr int DM = 2048, NBATCH = 4, SEQ = 2048, NMETA = 16, LTOK = SEQ + NMETA, DEPTH = 4;
constexpr int MX = NBATCH * SEQ, MREAL = MX + NBATCH * NMETA, MP = 8448;
constexpr int QL = 512, KVL = 256, ROPE = 64, NH = 8, DNOPE = 128, DQK = 192, DV = 128;
constexpr int ATTW = 1024, SSMW = 1024, NG = 64, GS = 16, NS = 64, INC = 1856;
constexpr int DFF = 5632, NE = 8, DFE = 1408;
constexpr float EPS = 1e-6f;
constexpr float CQ = 0.07216878364870323f * 1.4426950408889634f;
constexpr int PROJW = 2048;
constexpr int MOE_ROWS = 18688;

typedef unsigned short bf16_t;
typedef short bf16x8 __attribute__((ext_vector_type(8)));
typedef short s16x4 __attribute__((ext_vector_type(4)));
typedef float f32x4 __attribute__((ext_vector_type(4)));
typedef float f32x2 __attribute__((ext_vector_type(2)));
typedef float f32x16 __attribute__((ext_vector_type(16)));
typedef unsigned u32x4 __attribute__((ext_vector_type(4)));
typedef unsigned u32x2 __attribute__((ext_vector_type(2)));
typedef int i32x8 __attribute__((ext_vector_type(8)));
typedef int i32x4 __attribute__((ext_vector_type(4)));
#define LAS __attribute__((address_space(3)))
#define GAS __attribute__((address_space(1)))

constexpr size_t al256(size_t x) { return (x + 255) / 256 * 256; }
constexpr size_t WS_CTL = 0;
constexpr int CW_TMO = 0, CW_BAR = 4096, CW_CNT = 8192, CW_TKT = 12288;
constexpr size_t CTL_SSQ = 65536;
constexpr int NSSQ = DEPTH * 4 + 1;
constexpr size_t CTL_BYTES = al256(CTL_SSQ + (size_t)NSSQ * MP * 8);
constexpr size_t WS_TAB = al256(CTL_BYTES);
constexpr size_t WS_DBG_ERR = WS_TAB + 256;
constexpr size_t WS_W = WS_DBG_ERR + 4096;
constexpr size_t SZ_WIN = (size_t)2048 * 2048 * 2, SZ_WUQ = (size_t)1536 * 512 * 2, SZ_WUKV = (size_t)2048 * 256 * 2, SZ_WGLU = (size_t)1024 * 1024 * 2, SZ_WOUT = (size_t)2048 * 2048 * 2;
constexpr size_t SZ_LAYER = SZ_WIN + SZ_WUQ + SZ_WUKV + SZ_WGLU + SZ_WOUT;
constexpr size_t OFF_WIN = 0, OFF_WUQ = SZ_WIN, OFF_WUKV = OFF_WUQ + SZ_WUQ, OFF_WGLU = OFF_WUKV + SZ_WUKV, OFF_WOUT = OFF_WGLU + SZ_WGLU;
constexpr size_t WS_WFF = WS_W + DEPTH * SZ_LAYER;
constexpr size_t SZ_DGU = (size_t)2 * DFF * DM * 2, SZ_DDN = (size_t)DM * DFF * 2, SZ_DENSE = SZ_DGU + SZ_DDN;
constexpr size_t SZ_EGU = (size_t)2 * DFE * DM * 2, SZ_EDN = (size_t)DM * DFE * 2, SZ_EXP = SZ_EGU + SZ_EDN;
constexpr size_t SZ_MOE = NE * SZ_EXP;
constexpr size_t WS_S5 = WS_WFF + 2 * SZ_DENSE + 2 * SZ_MOE;
constexpr size_t S5_LAM = 0, S5_BRE = 512, S5_BIM = 512 + 2048, S5_CEF = 512 + 4096, S5_STRIDE = 512 + 4096 + 4096;
constexpr size_t WS_ROPE = al256(WS_S5 + (size_t)DEPTH * 2 * NG * S5_STRIDE);
constexpr size_t WS_H = al256(WS_ROPE + (size_t)2 * LTOK * 32 * 4);
constexpr size_t WS_HB = WS_H + (size_t)MP * DM * 4;
constexpr size_t WS_PROJ = WS_HB + (size_t)MP * DM * 2;
constexpr size_t WS_KPE = WS_PROJ + (size_t)MP * PROJW * 2;
constexpr size_t WS_QB = WS_KPE + (size_t)MP * 64 * 2;
constexpr size_t WS_KVB = WS_QB + (size_t)MP * 1536 * 2;
constexpr size_t WS_MIX = WS_KVB + (size_t)MP * 2048 * 2;
constexpr size_t WS_MIXN = WS_PROJ;
constexpr size_t WS_YP = WS_MIX + (size_t)MP * 2048 * 2;
constexpr size_t WS_GB = WS_YP + (size_t)MP * 1024 * 4;
constexpr size_t WS_APART = WS_GB + (size_t)MP * 1024 * 2;
constexpr size_t APART_STRIDE = (16 * 128 + 32) * 4;
constexpr size_t WS_ROUTE = al256(WS_APART + (size_t)NBATCH * NH * 8 * APART_STRIDE);
constexpr size_t WS_RPERM = WS_ROUTE + (size_t)MP * 32;
constexpr size_t WS_GPERM = WS_RPERM + (size_t)NE * MP * 4;
constexpr size_t WS_BIG = al256(WS_GPERM + (size_t)NE * MP * 4);
constexpr size_t WS_MACT = WS_BIG, WS_XPERM = WS_MACT + (size_t)MOE_ROWS * DFE * 2, WS_YSLOT = WS_XPERM;
constexpr size_t WS_END = WS_YSLOT + (size_t)MOE_ROWS * 2048 * 4;
static_assert((size_t)MP * DFF * 2 <= WS_END - WS_BIG, "dense act fits the overlay");
constexpr size_t WS_DBG_H = WS_QB;
static_assert(WS_DBG_H + (size_t)MP * DM * 4 <= WS_YP, "snapshot fits");
constexpr size_t WS_SLAB = al256(WS_END);
constexpr int SLAB_MAXSL = 22;
constexpr size_t WS_TOTAL = WS_SLAB + (size_t)SLAB_MAXSL * 64 * 2048 * 4;

typedef unsigned long long ssq_t;
constexpr float SSQ_SCALE = 16777216.0f, SSQ_INV = 1.0f / 16777216.0f;
__device__ __forceinline__ float ssq_get(const ssq_t* p, int row) { return (float)p[row] * SSQ_INV; }
__device__ __forceinline__ ssq_t ssq_fix(float ss) { return (ssq_t)(ss * SSQ_SCALE); }
__host__ __device__ constexpr int SSQ_H1(int l) { return l * 4; }
__host__ __device__ constexpr int SSQ_CQ(int l) { return l * 4 + 1; }
__host__ __device__ constexpr int SSQ_CKV(int l) { return l * 4 + 2; }
__host__ __device__ constexpr int SSQ_H2(int l) { return l * 4 + 3; }

__device__ __forceinline__ unsigned cvt_pk_bf16(float lo, float hi) { unsigned r; asm volatile("v_cvt_pk_bf16_f32 %0, %1, %2" : "=v"(r) : "v"(lo), "v"(hi)); return r; }
constexpr float F8_HS = 4.0f, F8_WGU = 64.0f, F8_AS = 8.0f, F8_WDN = 256.0f;
constexpr int DFEP = 1536;
constexpr float F8_GS = 16.0f, F8_WGL = 32.0f;
__device__ __forceinline__ unsigned pk4_fp8(float a, float b, float c, float d) {
    unsigned r = 0;
    r = __builtin_amdgcn_cvt_pk_fp8_f32(__builtin_amdgcn_fmed3f(a, -448.0f, 448.0f), __builtin_amdgcn_fmed3f(b, -448.0f, 448.0f), r, false);
    r = __builtin_amdgcn_cvt_pk_fp8_f32(__builtin_amdgcn_fmed3f(c, -448.0f, 448.0f), __builtin_amdgcn_fmed3f(d, -448.0f, 448.0f), r, true);
    return r; }
__device__ __forceinline__ float bf2f(unsigned short b) { return __uint_as_float(((unsigned)b) << 16); }
__device__ __forceinline__ float bflo(unsigned w) { return __uint_as_float(w << 16); }
__device__ __forceinline__ float bfhi(unsigned w) { return __uint_as_float(w & 0xffff0000u); }
__device__ __forceinline__ float fast_exp2(float x) { return __builtin_amdgcn_exp2f(x); }
__device__ __forceinline__ float fast_rcp(float x) { return __builtin_amdgcn_rcpf(x); }
__device__ __forceinline__ float sigmoidf_(float z) { return fast_rcp(1.0f + fast_exp2(-1.4426950408889634f * z)); }
__device__ __forceinline__ float gelu_tanh(float y) { const float t = 0.7978845608028654f * (y + 0.044715f * y * y * y); return y * sigmoidf_(2.0f * t); }
__device__ __forceinline__ float wave_sum(float v) {
#pragma unroll
    for (int o = 1; o < 64; o <<= 1) v += __shfl_xor(v, o);
    return v;
}
__device__ __forceinline__ float swap32(float x, int hh) { auto rr = __builtin_amdgcn_permlane32_swap(__float_as_uint(x), __float_as_uint(x), false, false); return __uint_as_float(hh ? rr[0] : rr[1]); }
__device__ __forceinline__ int row_pos(int row) { return row < MX ? NMETA + (row & (SEQ - 1)) : ((row - MX) & (NMETA - 1)); }
__device__ __forceinline__ int tok_row(int b, int t) { return t < NMETA ? MX + NMETA * b + t : SEQ * b + t - NMETA; }
#define LDS_WAIT() asm volatile("s_waitcnt lgkmcnt(0)" ::: "memory")
#define VM_WAIT() asm volatile("s_waitcnt vmcnt(0)" ::: "memory")

namespace pg8 {
constexpr int BM = 256, BK = 64, HALF = 128, HTB = HALF * BK * 2, STAGE_BYTES = 8 * HTB, NXCD = 8, WGM = 8;
__host__ __device__ __forceinline__ int lds_byte(int r, int c) { const int st = (r >> 4) * 2 + (c >> 5), rr = r & 15, cc = c & 31, ob = rr * 64 + cc * 2; return st * 1024 + (ob ^ (((ob >> 9) & 1) << 5)); }
__host__ __device__ __forceinline__ void stage_rc(int b, int& R, int& C) { const int st = b / 1024, sb = b % 1024, swz = sb ^ (((sb >> 9) & 1) << 5); R = (st >> 1) * 16 + swz / 64; C = (st & 1) * 32 + (swz % 64) / 2; }
__host__ __device__ __forceinline__ int perm32(int rho) { const int n = rho >> 4, i = rho & 15; return 8 * (i >> 2) + 4 * n + (i & 3); }
struct Unit { int pm, pn, ks, roff; };

__device__ __forceinline__ bool order2d(int i, int G, int c, int nM, int nN, Unit& u) {
    const int nwg = nM * nN; const long L = (long)i * G + c; if (L >= nwg) return false;
    int wgid = (int)L; { const int q = nwg / NXCD, r = nwg % NXCD, xcd = wgid % NXCD, off = wgid / NXCD; wgid = (xcd < r ? xcd * (q + 1) : r * (q + 1) + (xcd - r) * q) + off; }
    const int nig = WGM * nN, gid = wgid / nig, fm = gid * WGM, gsz = (nM - fm) < WGM ? (nM - fm) : WGM;
    u.pm = fm + ((wgid % nig) % gsz); u.pn = (wgid % nig) / gsz; u.ks = -1; u.roff = 0; return true;
}
struct Sched2D {
    static constexpr bool HAS_TAIL = false;
    const bf16_t* A; const bf16_t* Bt; int lda, K, nM, nN, G, c;
    __device__ __forceinline__ int nt(const Unit&) const { return K / BK; }
    __device__ __forceinline__ bool next(int i, Unit& u) const { return order2d(i, G, c, nM, nN, u); }
    __device__ __forceinline__ void ptrs(const Unit& u, const char*& a, const char*& b) const { a = (const char*)A + (size_t)u.pm * BM * lda * 2; b = (const char*)Bt + (size_t)u.pn * BM * K * 2; }
};
struct SchedT {
    static constexpr bool HAS_TAIL = true;
    const bf16_t* A; const bf16_t* Bt; int lda, K, nN, G, c, sliceK, nslice;
    __device__ __forceinline__ int nt(const Unit& u) const { return (u.ks < 0 ? K : sliceK) / BK; }
    __device__ __forceinline__ bool next(int i, Unit& u) const {
        if (order2d(i, G, c, MX / BM, nN, u)) return true;
        const long L = (long)i * G + c - (long)(MX / BM) * nN; if (L < 0 || L >= (long)nN * nslice) return false;
        u.pm = MX / BM; u.pn = (int)(L % nN); u.ks = (int)(L / nN); u.roff = 0; return true; }
    __device__ __forceinline__ void ptrs(const Unit& u, const char*& a, const char*& b) const { const size_t ko = u.ks < 0 ? 0 : (size_t)u.ks * sliceK * 2;
        a = (const char*)A + (size_t)u.pm * BM * lda * 2 + ko; b = (const char*)Bt + (size_t)u.pn * BM * K * 2 + ko; }
};
struct SchedMoE {
    static constexpr bool HAS_TAIL = false;
    const bf16_t* A; const bf16_t* Bt0; size_t estride; int lda, K, nN, G, c; int pfx[NE + 1]; int capA;
    __device__ __forceinline__ int nt(const Unit&) const { return K / BK; }
    __device__ __forceinline__ bool next(int i, Unit& u) const {
        if (!order2d(i, G, c, pfx[NE], nN, u)) return false;
        int e = 0, pe = 0;
#pragma unroll
        for (int j = 1; j < NE; ++j) if (u.pm >= pfx[j]) { e = j; pe = pfx[j]; }
        u.roff = e * MP - pe * BM; return true; }
    __device__ __forceinline__ void ptrs(const Unit& u, const char*& a, const char*& b) const {
        int e = 0;
#pragma unroll
        for (int j = 1; j < NE; ++j) e += (u.pm >= pfx[j]) ? 1 : 0;
        a = (const char*)A + (size_t)(u.pm * BM + (capA ? u.roff : 0)) * lda * 2; b = (const char*)Bt0 + (size_t)e * estride + (size_t)u.pn * BM * K * 2; }
};

template <bool PERM>
__device__ __forceinline__ void tail_store(const f32x4 (&acc)[2][2][4][2], const Unit& u, int wr, int wc, int fr, int fq, float* slab, int N) {
    if (wr != 0) return;
    { unsigned z = 0u; asm volatile("" : "+v"(z)); const int ln = (int)__builtin_amdgcn_mbcnt_hi(~0u, __builtin_amdgcn_mbcnt_lo(~0u, z)); fr = ln & 15; fq = ln >> 4; }
    asm volatile("" : "+s"(slab), "+v"(fr), "+v"(fq));
#pragma unroll
    for (int m = 0; m < 4; ++m) { float* rp = slab + ((size_t)u.ks * 64 + m * 16 + fr) * N + u.pn * BM + wc * 32;
#pragma unroll
        for (int bj = 0; bj < 2; ++bj)
#pragma unroll
            for (int n = 0; n < 2; ++n) *(f32x4*)(rp + bj * HALF + (PERM ? 8 * fq + 4 * n : 16 * n + 4 * fq)) = acc[0][bj][m][n]; }
}
__host__ __device__ __forceinline__ int f8_p(int fr) { return ((fr >> 1) & 7) ^ (2 * (((fr >> 2) ^ (fr >> 3)) & 1)); }
template <class Epi, class Sched, bool ALIGN_EPI, bool F8 = false>
__device__ __forceinline__ void gemm_phase(LAS unsigned char* lds, const Sched& S, const Epi& E, int tid) {
    const int wid = __builtin_amdgcn_readfirstlane(tid >> 6), lane = tid & 63, wr = wid >> 2, wc = wid & 3, fr = lane & 15, fq = lane >> 4;
    const int K = S.K, lda = S.lda;
    unsigned voffA[2], voffB[2];
#pragma unroll
    for (int i = 0; i < 2; ++i) { int R, C;
        if constexpr (F8) { const int a = tid * 16 + i * 8192; R = a >> 7; C = ((((a >> 4) & 7) ^ f8_p(R & 15)) * 8); } else stage_rc(tid * 16 + i * 8192, R, C);
        const int Rb = Epi::PERM ? ((R & ~31) + perm32(R & 31)) : R;
        voffA[i] = (unsigned)(R * lda + C) * 2u; voffB[i] = (unsigned)(Rb * K + C) * 2u; }
    const size_t kstep = (size_t)(BK * 2);
    const size_t hstepA = (size_t)HALF * lda * 2, hstepB = (size_t)HALF * K * 2;
    const unsigned ldsw = (unsigned)wid * 1024u;
    const int aoff = F8 ? wr * 8192 + fr * 128 + (((2 * fq) ^ f8_p(fr)) * 16) : lds_byte(wr * 64 + fr, fq * 8), boff = F8 ? wc * 4096 + fr * 128 + (((2 * fq) ^ f8_p(fr)) * 16) : lds_byte(wc * 32 + fr, fq * 8);
    const int xoff1 = F8 ? ((((2 * fq + 1) ^ f8_p(fr)) - ((2 * fq) ^ f8_p(fr))) * 16) : 1024;
#define PG8_SA(b, h) (((b) * 2 + (h)) * HTB)
#define PG8_SB(b, h) ((4 + (b) * 2 + (h)) * HTB)
#define PG8_STAGE(bufoff, gbase, voff) do { _Pragma("unroll") for (int _i = 0; _i < 2; ++_i) \
        __builtin_amdgcn_global_load_lds((const unsigned*)((const char*)(gbase) + (voff)[_i]), (LAS unsigned*)(lds + (bufoff) + ldsw + _i * 8192), 16, 0, 0); } while (0)
#define PG8_LDA(dst, b, h) do { _Pragma("unroll") for (int m = 0; m < 4; ++m) { dst[m][0] = *(const LAS bf16x8*)(lds + PG8_SA(b, h) + aoff + m * 2048); dst[m][1] = *(const LAS bf16x8*)(lds + PG8_SA(b, h) + aoff + m * 2048 + xoff1); } } while (0)
#define PG8_LDB(dst, b, h) do { _Pragma("unroll") for (int n = 0; n < 2; ++n) { dst[n][0] = *(const LAS bf16x8*)(lds + PG8_SB(b, h) + boff + n * 2048); dst[n][1] = *(const LAS bf16x8*)(lds + PG8_SB(b, h) + boff + n * 2048 + xoff1); } } while (0)
#define PG8_F8FRAG(F) __builtin_shufflevector(__builtin_bit_cast(i32x4, F[0]), __builtin_bit_cast(i32x4, F[1]), 0, 1, 2, 3, 4, 5, 6, 7)
#define PG8_MMA(ai, bj, At, Bt) do { __builtin_amdgcn_s_setprio(1); if constexpr (F8) asm volatile("s_nop 1"); _Pragma("unroll") for (int m = 0; m < 4; ++m) _Pragma("unroll") for (int n = 0; n < 2; ++n) { \
        if constexpr (F8) asm volatile("v_mfma_f32_16x16x128_f8f6f4 %0, %1, %2, %0" : "+v"(acc[ai][bj][m][n]) : "v"(PG8_F8FRAG(Bt[n])), "v"(PG8_F8FRAG(At[m])));   \
        else { _Pragma("unroll") for (int k = 0; k < 2; ++k) acc[ai][bj][m][n] = __builtin_amdgcn_mfma_f32_16x16x32_bf16(Bt[n][k], At[m][k], acc[ai][bj][m][n], 0, 0, 0); } } \
        __builtin_amdgcn_s_setprio(0); } while (0)
#define PG8_WAIT_V(n) asm volatile("s_waitcnt vmcnt(" #n ")" ::: "memory")
#define PG8_WAIT_L(n) asm volatile("s_waitcnt lgkmcnt(" #n ")" ::: "memory")
#define PG8_BAR __builtin_amdgcn_s_barrier()
#define PG8_SCHED __builtin_amdgcn_sched_barrier(0)
    Unit cur, nxt; int ui = 0;
    if (!S.next(0, cur)) return;
    int nt = S.nt(cur);
    f32x4 acc[2][2][4][2];
#pragma unroll
    for (int a = 0; a < 2; ++a)
#pragma unroll
        for (int b = 0; b < 2; ++b)
#pragma unroll
            for (int m = 0; m < 4; ++m)
#pragma unroll
                for (int n = 0; n < 2; ++n) acc[a][b][m][n] = (f32x4){0.f, 0.f, 0.f, 0.f};
    bf16x8 At[4][2], B0[2][2], B1[2][2];
    const char* cA; const char* cB; S.ptrs(cur, cA, cB);
    PG8_STAGE(PG8_SB(0, 0), cB, voffB); PG8_STAGE(PG8_SB(0, 1), cB + hstepB, voffB); PG8_STAGE(PG8_SA(0, 0), cA, voffA); PG8_STAGE(PG8_SA(0, 1), cA + hstepA, voffA);
    if constexpr (Epi::MIDSCALE) E.prep(S, tid);
    if (wr == 1) PG8_BAR;
    PG8_WAIT_V(2); PG8_BAR;
    PG8_STAGE(PG8_SB(1, 0), cB + kstep, voffB); PG8_STAGE(PG8_SA(1, 0), cA + kstep, voffA); PG8_STAGE(PG8_SB(1, 1), cB + hstepB + kstep, voffB);
    PG8_WAIT_V(6); PG8_BAR;
    for (;;) {
        const bool has_next = S.next(ui + 1, nxt);
        const char* nA = cA; const char* nB = cB; if (has_next) S.ptrs(nxt, nA, nB);
        for (int t = 0; t < nt; t += 2) {
            if constexpr (Epi::MIDSCALE) { if (cur.ks < 0 && t == nt / 2) E.midscale(acc, cur, wr, fr); }
            const bool last = (t == nt - 2);
            const char* a1 = cA + (size_t)(t + 1) * kstep;
            const char* a2 = last ? nA : cA + (size_t)(t + 2) * kstep; const char* b2 = last ? nB : cB + (size_t)(t + 2) * kstep;
            const char* a3 = a2 + kstep; const char* b3 = b2 + kstep;
            PG8_LDB(B0, 0, 0); PG8_LDB(B1, 0, 1); PG8_SCHED; PG8_LDA(At, 0, 0); PG8_STAGE(PG8_SA(1, 1), a1 + hstepA, voffA);
            PG8_WAIT_V(8); PG8_WAIT_L(0); PG8_BAR; PG8_MMA(0, 0, At, B0); PG8_MMA(0, 1, At, B1); PG8_BAR; PG8_SCHED;
            PG8_LDA(At, 0, 1); PG8_STAGE(PG8_SB(0, 0), b2, voffB); PG8_STAGE(PG8_SB(0, 1), b2 + hstepB, voffB); PG8_STAGE(PG8_SA(0, 0), a2, voffA);
            PG8_WAIT_V(8); PG8_WAIT_L(0); PG8_BAR; PG8_MMA(1, 0, At, B0); PG8_MMA(1, 1, At, B1); PG8_BAR; PG8_SCHED;
            PG8_LDB(B0, 1, 0); PG8_LDB(B1, 1, 1); PG8_SCHED; PG8_LDA(At, 1, 0); PG8_STAGE(PG8_SA(0, 1), a2 + hstepA, voffA);
            PG8_WAIT_V(8); PG8_WAIT_L(0); PG8_BAR; PG8_MMA(0, 0, At, B0); PG8_MMA(0, 1, At, B1); PG8_BAR; PG8_SCHED;
            PG8_LDA(At, 1, 1); PG8_STAGE(PG8_SB(1, 0), b3, voffB); PG8_STAGE(PG8_SB(1, 1), b3 + hstepB, voffB); PG8_STAGE(PG8_SA(1, 0), a3, voffA);
            PG8_WAIT_V(8); PG8_WAIT_L(0); PG8_BAR; PG8_MMA(1, 0, At, B0); PG8_MMA(1, 1, At, B1); PG8_BAR; PG8_SCHED;
        }
        if constexpr (ALIGN_EPI) { if (wr == 0) PG8_BAR; }
        if constexpr (F8) asm volatile("s_nop 15\n\ts_nop 15" ::: "memory");
        if constexpr (Sched::HAS_TAIL) { if (cur.ks < 0) E(acc, cur, wr, wc, fr, fq); else tail_store<Epi::PERM>(acc, cur, wr, wc, fr, fq, E.slab, S.nN * BM); }
        else E(acc, cur, wr, wc, fr, fq);
        if (!has_next) break;
#pragma unroll
        for (int a = 0; a < 2; ++a)
#pragma unroll
            for (int b = 0; b < 2; ++b)
#pragma unroll
                for (int m = 0; m < 4; ++m)
#pragma unroll
                    for (int n = 0; n < 2; ++n) acc[a][b][m][n] = (f32x4){0.f, 0.f, 0.f, 0.f};
        cur = nxt; cA = nA; cB = nB; ++ui; nt = S.nt(cur);
        if constexpr (ALIGN_EPI) { if (wr == 1) PG8_BAR; }
    }
    PG8_WAIT_V(0);
    if constexpr (!ALIGN_EPI) { if (wr == 0) PG8_BAR; }
    PG8_BAR;
#undef PG8_SA
#undef PG8_SB
#undef PG8_STAGE
#undef PG8_LDA
#undef PG8_LDB
#undef PG8_MMA
#undef PG8_F8FRAG
#undef PG8_WAIT_V
#undef PG8_WAIT_L
#undef PG8_BAR
#undef PG8_SCHED
}

__device__ __forceinline__ float quad_sum(float s) { s += __shfl_xor(s, 16); s += __shfl_xor(s, 32); return s; }

#define EPI_ROW(ai, m) (u.pm * BM + (ai) * HALF + wr * 64 + (m) * 16 + fr)
#define EPI_FOR8(ai, m) _Pragma("unroll") for (int ai = 0; ai < 2; ++ai) _Pragma("unroll") for (int m = 0; m < 4; ++m)
__device__ __forceinline__ float rms_scale(const ssq_t* ssq, int row, float inv_n) { return __builtin_amdgcn_rsqf(ssq_get(ssq, row) * inv_n + EPS); }

struct EpiG1 {
    static constexpr bool PERM = true, MIDSCALE = false;
    bf16_t* proj; bf16_t* kpe; const ssq_t* ssq_h; ssq_t* ssq_cq; ssq_t* ssq_ckv; const float* cosb; const float* sinb; float* slab; float* psq;
    __device__ __forceinline__ void operator()(const f32x4 (&acc)[2][2][4][2], const Unit& u, int wr, int wc, int fr, int fq) const {
        float rr[2][4];
        EPI_FOR8(ai, m) rr[ai][m] = rms_scale(ssq_h, EPI_ROW(ai, m), 1.0f / DM);
        if (u.pn == 3) {
            if (wc < 2) {
                f32x2 cs[2][2], nx[2][2];
#define G1_CS(dst, ai, m) do { const int pos_ = row_pos(EPI_ROW(ai, m)); _Pragma("unroll") for (int n = 0; n < 2; ++n) { const int i0_ = 16 * wc + 4 * fq + 2 * n; \
                    dst[n][0] = *(const f32x2*)(cosb + pos_ * 32 + i0_); dst[n][1] = *(const f32x2*)(sinb + pos_ * 32 + i0_); } } while (0)
                G1_CS(cs, 0, 0);
                EPI_FOR8(ai, m) {
                    const int row = EPI_ROW(ai, m), k = ai * 4 + m; const float r = rr[ai][m];
                    if (k < 7) G1_CS(nx, (k + 1) >> 2, (k + 1) & 3);
                    f32x4 o[2];
#pragma unroll
                    for (int n = 0; n < 2; ++n) { const f32x4 v = acc[ai][0][m][n] * r; const f32x2 c = cs[n][0], s = cs[n][1];
                        o[n] = (f32x4){v[0] * c.x - v[1] * s.x, v[0] * s.x + v[1] * c.x, v[2] * c.y - v[3] * s.y, v[2] * s.y + v[3] * c.y}; }
                    u32x4 w; w.x = cvt_pk_bf16(o[0][0], o[0][1]); w.y = cvt_pk_bf16(o[0][2], o[0][3]); w.z = cvt_pk_bf16(o[1][0], o[1][1]); w.w = cvt_pk_bf16(o[1][2], o[1][3]);
                    *(u32x4*)(kpe + (size_t)row * 64 + 32 * wc + 8 * fq) = w;
#pragma unroll
                    for (int n = 0; n < 2; ++n) { cs[n][0] = nx[n][0]; cs[n][1] = nx[n][1]; }
                }
#undef G1_CS
            }
        } else {
            EPI_FOR8(ai, m) {
                const int row = EPI_ROW(ai, m); const float r = rr[ai][m];
                float ss = 0.f;
#pragma unroll
                for (int bj = 0; bj < 2; ++bj) { const f32x4 v0 = acc[ai][bj][m][0] * r, v1 = acc[ai][bj][m][1] * r;
                    ss += (v0[0] * v0[0] + v0[1] * v0[1]) + (v0[2] * v0[2] + v0[3] * v0[3]) + (v1[0] * v1[0] + v1[1] * v1[1]) + (v1[2] * v1[2] + v1[3] * v1[3]);
                    u32x4 w; w.x = cvt_pk_bf16(v0[0], v0[1]); w.y = cvt_pk_bf16(v0[2], v0[3]); w.z = cvt_pk_bf16(v1[0], v1[1]); w.w = cvt_pk_bf16(v1[2], v1[3]);
                    *(u32x4*)(proj + (size_t)row * PROJW + u.pn * BM + bj * HALF + wc * 32 + 8 * fq) = w; }
                if (u.pn < 3) { ss = quad_sum(ss); if (fq == 0) psq[(size_t)row * 12 + u.pn * 4 + wc] = ss; }
            }
        }
    }
};
struct EpiQ {
    static constexpr bool PERM = true, MIDSCALE = false;
    bf16_t* qb; const ssq_t* ssq_cq; const float* cosb; const float* sinb;
    __device__ __forceinline__ void operator()(const f32x4 (&acc)[2][2][4][2], const Unit& u, int wr, int wc, int fr, int fq) const {
        float rr[2][4];
        EPI_FOR8(ai, m) rr[ai][m] = CQ * rms_scale(ssq_cq, EPI_ROW(ai, m), 1.0f / QL);
        const int st0 = u.pn * 8 + wc, st1 = st0 + 4, sm0 = st0 % 6, sm1 = st1 % 6;
        const bool rope = sm0 >= 4 || sm1 >= 4; const int rsm = (sm0 >= 4 ? sm0 : sm1) - 4;
        f32x2 cs[2][2] = {}, nx[2][2] = {};
#define Q_CS(dst, ai, m) do { const int pos_ = row_pos(EPI_ROW(ai, m)); _Pragma("unroll") for (int n = 0; n < 2; ++n) { const int i0_ = 16 * rsm + 4 * fq + 2 * n; \
            dst[n][0] = *(const f32x2*)(cosb + pos_ * 32 + i0_); dst[n][1] = *(const f32x2*)(sinb + pos_ * 32 + i0_); } } while (0)
        if (rope) Q_CS(cs, 0, 0);
        EPI_FOR8(ai, m) {
            const int row = EPI_ROW(ai, m), k = ai * 4 + m; const float r = rr[ai][m];
            if (rope && k < 7) Q_CS(nx, (k + 1) >> 2, (k + 1) & 3);
#pragma unroll
            for (int bj = 0; bj < 2; ++bj) {
                const int strip = bj ? st1 : st0, sm = bj ? sm1 : sm0;
                f32x4 v[2] = {acc[ai][bj][m][0] * r, acc[ai][bj][m][1] * r};
                if (sm >= 4) {
#pragma unroll
                    for (int n = 0; n < 2; ++n) { const f32x2 c = cs[n][0], s = cs[n][1]; const f32x4 x = v[n];
                        v[n] = (f32x4){x[0] * c.x - x[1] * s.x, x[0] * s.x + x[1] * c.x, x[2] * c.y - x[3] * s.y, x[2] * s.y + x[3] * c.y}; }
                }
                u32x4 w; w.x = cvt_pk_bf16(v[0][0], v[0][1]); w.y = cvt_pk_bf16(v[0][2], v[0][3]); w.z = cvt_pk_bf16(v[1][0], v[1][1]); w.w = cvt_pk_bf16(v[1][2], v[1][3]);
                *(u32x4*)(qb + (size_t)row * 1536 + strip * 32 + 8 * fq) = w;
            }
#pragma unroll
            for (int n = 0; n < 2; ++n) { cs[n][0] = nx[n][0]; cs[n][1] = nx[n][1]; }
        }
#undef Q_CS
    }
};
struct EpiScaleBf16 {
    static constexpr bool PERM = true, MIDSCALE = false;
    bf16_t* out; int ldo; const ssq_t* ssq; float inv_n;
    __device__ __forceinline__ void operator()(const f32x4 (&acc)[2][2][4][2], const Unit& u, int wr, int wc, int fr, int fq) const {
        float rr[2][4];
        EPI_FOR8(ai, m) rr[ai][m] = rms_scale(ssq, EPI_ROW(ai, m), inv_n);
        EPI_FOR8(ai, m) {
            const int row = EPI_ROW(ai, m); const float r = rr[ai][m];
#pragma unroll
            for (int bj = 0; bj < 2; ++bj) { const f32x4 v0 = acc[ai][bj][m][0] * r, v1 = acc[ai][bj][m][1] * r;
                u32x4 w; w.x = cvt_pk_bf16(v0[0], v0[1]); w.y = cvt_pk_bf16(v0[2], v0[3]); w.z = cvt_pk_bf16(v1[0], v1[1]); w.w = cvt_pk_bf16(v1[2], v1[3]);
                *(u32x4*)(out + (size_t)row * ldo + u.pn * BM + bj * HALF + wc * 32 + 8 * fq) = w; }
        }
    }
};
struct EpiGlu {
    static constexpr bool PERM = true, MIDSCALE = false;
    const bf16_t* gb; bf16_t* mix; float* psq_ssm;
    __device__ __forceinline__ void operator()(const f32x4 (&acc)[2][2][4][2], const Unit& u, int wr, int wc, int fr, int fq) const {
        constexpr float ZS = 1.0f / (F8_GS * F8_WGL);
        u32x4 gq[3][2];
#define GLU_LD(dst, ai, m) do { _Pragma("unroll") for (int bj = 0; bj < 2; ++bj) dst[bj] = *(const u32x4*)(gb + (size_t)EPI_ROW(ai, m) * SSMW + u.pn * BM + bj * HALF + wc * 32 + 8 * fq); } while (0)
        GLU_LD(gq[0], 0, 0); GLU_LD(gq[1], 0, 1);
        EPI_FOR8(ai, m) {
            const int row = EPI_ROW(ai, m), k = ai * 4 + m;
            if (k < 6) GLU_LD(gq[(k + 2) % 3], (k + 2) >> 2, (k + 2) & 3);
            float ss = 0.f;
#pragma unroll
            for (int bj = 0; bj < 2; ++bj) { const int col = u.pn * BM + bj * HALF + wc * 32 + 8 * fq;
                const u32x4 gv = gq[k % 3][bj]; const f32x4 z0 = acc[ai][bj][m][0] * ZS, z1 = acc[ai][bj][m][1] * ZS;
                u32x4 w; w.x = cvt_pk_bf16(bflo(gv.x) * sigmoidf_(z0[0]), bfhi(gv.x) * sigmoidf_(z0[1])); w.y = cvt_pk_bf16(bflo(gv.y) * sigmoidf_(z0[2]), bfhi(gv.y) * sigmoidf_(z0[3]));
                w.z = cvt_pk_bf16(bflo(gv.z) * sigmoidf_(z1[0]), bfhi(gv.z) * sigmoidf_(z1[1])); w.w = cvt_pk_bf16(bflo(gv.w) * sigmoidf_(z1[2]), bfhi(gv.w) * sigmoidf_(z1[3]));
                *(u32x4*)(mix + (size_t)row * 2048 + ATTW + col) = w;
                ss += (bflo(w.x) * bflo(w.x) + bfhi(w.x) * bfhi(w.x)) + (bflo(w.y) * bflo(w.y) + bfhi(w.y) * bfhi(w.y)) + (bflo(w.z) * bflo(w.z) + bfhi(w.z) * bfhi(w.z)) + (bflo(w.w) * bflo(w.w) + bfhi(w.w) * bfhi(w.w)); }
            ss = quad_sum(ss); if (fq == 0) psq_ssm[(size_t)row * 16 + u.pn * 4 + wc] = ss;
        }
#undef GLU_LD
    }
};
template <bool F8OUT, bool MIDS = false> struct EpiRes {
    static constexpr bool PERM = true, MIDSCALE = MIDS;
    float* h; bf16_t* hb; ssq_t* ssq; float* slab; float sc; const float* scl;
    const float* hin;
    float* psq;
    const float* psq_in; int nr;
    template <class Sched>
    __device__ __forceinline__ void prep(const Sched& S, int tid) const {
        float* sclw = const_cast<float*>(scl);
        for (int i = 0; ; ++i) { Unit u; if (!S.next(i, u)) break;
            const int row = u.pm * 256 + tid;
            if (tid < 256 && row < nr) {
                const f32x4 a0 = *(const f32x4*)(psq_in + (size_t)row * 8), a1 = *(const f32x4*)(psq_in + (size_t)row * 8 + 4);
                const float* ps = psq_in + (size_t)MP * 8 + (size_t)row * 16;
                const f32x4 s0 = *(const f32x4*)ps, s1 = *(const f32x4*)(ps + 4), s2 = *(const f32x4*)(ps + 8), s3 = *(const f32x4*)(ps + 12);
                const f32x4 sa = a0 + a1, sv = (s0 + s1) + (s2 + s3);
                const float ra = 1.0f / sqrtf(((sa[0] + sa[1]) + (sa[2] + sa[3])) * (1.0f / ATTW) + EPS), rs = 1.0f / sqrtf(((sv[0] + sv[1]) + (sv[2] + sv[3])) * (1.0f / SSMW) + EPS);
                sclw[row] = ra / rs; sclw[MP + row] = rs; } }
        VM_WAIT(); __syncthreads();
    }
    __device__ __forceinline__ void midscale(f32x4 (&acc)[2][2][4][2], const Unit& u, int wr, int fr) const {
        float f[2][4];
        EPI_FOR8(ai, m) f[ai][m] = scl[EPI_ROW(ai, m)];
        EPI_FOR8(ai, m) {
#pragma unroll
            for (int bj = 0; bj < 2; ++bj)
#pragma unroll
                for (int n = 0; n < 2; ++n) acc[ai][bj][m][n] *= f[ai][m]; }
    }
    __device__ __forceinline__ void operator()(const f32x4 (&acc)[2][2][4][2], const Unit& u, int wr, int wc, int fr, int fq) const {
        float fs[2][4];
        EPI_FOR8(ai, m) fs[ai][m] = MIDS ? scl[MP + EPI_ROW(ai, m)] * sc : sc;
        f32x4 hq[3][2][2];
#define RES_OFF(ai, m, bj, n) ((size_t)EPI_ROW(ai, m) * DM + u.pn * BM + (bj) * HALF + wc * 32 + 8 * fq + 4 * (n))
#define RES_LD(dst, ai, m) do { _Pragma("unroll") for (int bj = 0; bj < 2; ++bj) _Pragma("unroll") for (int n = 0; n < 2; ++n) dst[bj][n] = *(const f32x4*)(hin + RES_OFF(ai, m, bj, n)); } while (0)
        RES_LD(hq[0], 0, 0); RES_LD(hq[1], 0, 1);
        EPI_FOR8(ai, m) {
            const int row = EPI_ROW(ai, m), k = ai * 4 + m;
            if (k < 6) RES_LD(hq[(k + 2) % 3], (k + 2) >> 2, (k + 2) & 3);
            const bool real = row < MREAL; float ss = 0.f;
#pragma unroll
            for (int bj = 0; bj < 2; ++bj) { const size_t off = RES_OFF(ai, m, bj, 0); f32x4 v[2];
#pragma unroll
                for (int n = 0; n < 2; ++n) { v[n] = hq[k % 3][bj][n] + acc[ai][bj][m][n] * fs[ai][m]; if (!real) v[n] = (f32x4){0.f, 0.f, 0.f, 0.f};
                    *(f32x4*)(h + off + 4 * n) = v[n]; ss += (v[n][0] * v[n][0] + v[n][1] * v[n][1]) + (v[n][2] * v[n][2] + v[n][3] * v[n][3]); }
                if constexpr (F8OUT) { if (hb) { u32x2 w; w.x = pk4_fp8(v[0][0] * F8_HS, v[0][1] * F8_HS, v[0][2] * F8_HS, v[0][3] * F8_HS); w.y = pk4_fp8(v[1][0] * F8_HS, v[1][1] * F8_HS, v[1][2] * F8_HS, v[1][3] * F8_HS);
                    *(u32x2*)((unsigned char*)hb + off) = w; } }
                else { u32x4 w; w.x = cvt_pk_bf16(v[0][0], v[0][1]); w.y = cvt_pk_bf16(v[0][2], v[0][3]); w.z = cvt_pk_bf16(v[1][0], v[1][1]); w.w = cvt_pk_bf16(v[1][2], v[1][3]); *(u32x4*)(hb + off) = w; } }
            if (!F8OUT || hb) { ss = quad_sum(ss); if (fq == 0) psq[(size_t)row * 32 + u.pn * 4 + wc] = ss; }
        }
#undef RES_LD
#undef RES_OFF
    }
};
template <bool F8OUT> struct EpiGU {
    static constexpr bool PERM = true, MIDSCALE = false;
    bf16_t* act; int ldo; const float* rs;
    __device__ __forceinline__ void operator()(const f32x4 (&acc)[2][2][4][2], const Unit& u, int wr, int wc, int fr, int fq) const {
        float rr[2][4];
        EPI_FOR8(ai, m) rr[ai][m] = rs[u.roff + EPI_ROW(ai, m)];
        EPI_FOR8(ai, m) {
            const int row = EPI_ROW(ai, m);
            const float r = rr[ai][m], rl = r * -1.4426950408889634f, c2 = r * r * (F8OUT ? F8_AS : 1.0f);
            float o[8];
#pragma unroll
            for (int n = 0; n < 2; ++n)
#pragma unroll
                for (int j = 0; j < 4; ++j) { const float ag = acc[ai][0][m][n][j], au = acc[ai][1][m][n][j]; o[4 * n + j] = (ag * au) * (fast_rcp(1.0f + fast_exp2(ag * rl)) * c2); }
            if constexpr (F8OUT) { u32x2 w; w.x = pk4_fp8(o[0], o[1], o[2], o[3]); w.y = pk4_fp8(o[4], o[5], o[6], o[7]);
                *(u32x2*)((unsigned char*)act + (size_t)row * ldo + u.pn * HALF + wc * 32 + 8 * fq) = w; }
            else { u32x4 w; w.x = cvt_pk_bf16(o[0], o[1]); w.y = cvt_pk_bf16(o[2], o[3]); w.z = cvt_pk_bf16(o[4], o[5]); w.w = cvt_pk_bf16(o[6], o[7]);
                *(u32x4*)(act + (size_t)row * ldo + u.pn * HALF + wc * 32 + 8 * fq) = w; }
        }
    }
};
struct EpiMD {
    static constexpr bool PERM = true, MIDSCALE = false;
    bf16_t* y; const float* gperm;
    __device__ __forceinline__ void operator()(const f32x4 (&acc)[2][2][4][2], const Unit& u, int wr, int wc, int fr, int fq) const {
        float rr[2][4];
        EPI_FOR8(ai, m) rr[ai][m] = gperm[u.roff + EPI_ROW(ai, m)] * (1.0f / (F8_AS * F8_WDN));
        EPI_FOR8(ai, m) {
            const int row = EPI_ROW(ai, m); const float gt = rr[ai][m];
#pragma unroll
            for (int bj = 0; bj < 2; ++bj) { const f32x4 v0 = acc[ai][bj][m][0] * gt, v1 = acc[ai][bj][m][1] * gt;
                u32x4 w; w.x = cvt_pk_bf16(v0[0], v0[1]); w.y = cvt_pk_bf16(v0[2], v0[3]); w.z = cvt_pk_bf16(v1[0], v1[1]); w.w = cvt_pk_bf16(v1[2], v1[3]);
                *(u32x4*)(y + (size_t)row * DM + u.pn * BM + bj * HALF + wc * 32 + 8 * fq) = w; }
        }
    }
};
#undef EPI_ROW
#undef EPI_FOR8
}

#define XB_TMO      128
#define XB_XCNT(j)  (256  + 64 * (j))
#define XB_XSUB(j)  (1280 + 64 * (j))
#define XB_XGEN(j)  (2304 + 64 * (j))
#define XB_TOP      3328
#define XB_TOPGEN   3392
#define XCD_BAR_WORDS 3456
#define XB_SPIN_CAP (1u << 18)
__device__ __forceinline__ unsigned xb_ld(unsigned* p)              { return __hip_atomic_load(p, __ATOMIC_RELAXED, __HIP_MEMORY_SCOPE_AGENT); }
__device__ __forceinline__ unsigned xb_add(unsigned* p, unsigned v) { return __hip_atomic_fetch_add(p, v, __ATOMIC_RELAXED, __HIP_MEMORY_SCOPE_AGENT); }
__device__ __forceinline__ unsigned xb_xcc_id() { return (unsigned)__builtin_amdgcn_s_getreg((3 << 11) | 20) & 0xFu; }
#define XB_SPIN(cond, bar) do { unsigned _sp = 0; while (cond) { __builtin_amdgcn_s_sleep(1); \
    if ((++_sp & 255u) == 0u) { if (xb_ld(&(bar)[XB_TMO])) break; if (_sp > XB_SPIN_CAP) { atomicAdd(&(bar)[XB_TMO], 1u); break; } } } } while (0)
struct XcdBarrier { unsigned* bar; unsigned x; volatile LAS unsigned* st; };
__device__ __forceinline__ XcdBarrier xcd_barrier_post(unsigned* bar, volatile LAS unsigned* st) {
    XcdBarrier b; b.bar = bar; b.x = xb_xcc_id(); b.st = st;
    if (threadIdx.x == 0) (void)xb_add(&bar[XB_XCNT(b.x)], 1u);
    return b;
}
__device__ __forceinline__ void xcd_barrier_complete(unsigned* bar, unsigned x, unsigned& nloc, unsigned& nx) {
    const unsigned G = gridDim.x * gridDim.y * gridDim.z;
    unsigned sum, cnt, mine, sp = 0u;
    for (;;) {
        sum = 0u; cnt = 0u; mine = 0u;
#pragma unroll
        for (unsigned j = 0; j < 16; ++j) { const unsigned c = xb_ld(&bar[XB_XCNT(j)]); sum += c; cnt += (c > 0u) ? 1u : 0u; mine = (j == x) ? c : mine; }
        if (sum == G) break;
        __builtin_amdgcn_s_sleep(1);
        if ((++sp & 255u) == 0u) { if (xb_ld(&bar[XB_TMO])) break; if (sp > XB_SPIN_CAP) { atomicAdd(&bar[XB_TMO], 1u); break; } }
    }
    nloc = mine > 0u ? mine : 1u; nx = cnt > 0u ? cnt : 1u;
}
__device__ __forceinline__ void xcd_barrier(const XcdBarrier& b) {
    asm volatile("s_waitcnt vmcnt(0)" ::: "memory");
    __syncthreads();
    if (threadIdx.x == 0) {
        unsigned* bar = b.bar;
        __builtin_amdgcn_s_waitcnt(0);
        unsigned nloc = b.st[0], nx = b.st[1];
        if (nloc == 0u) { xcd_barrier_complete(bar, b.x, nloc, nx); b.st[0] = nloc; b.st[1] = nx; }
        const unsigned old = xb_add(&bar[XB_XSUB(b.x)], 1u);
        const unsigned gen = old / nloc, target = (gen + 1u) * nx;
        if (old + 1u == (gen + 1u) * nloc) {
            __builtin_amdgcn_fence(__ATOMIC_RELEASE, "agent");
            asm volatile("s_waitcnt vmcnt(0)" ::: "memory");
#pragma unroll
            for (unsigned j = 0; j < 16; ++j) (void)xb_add(&bar[XB_XGEN(j)], 1u);
            XB_SPIN(xb_ld(&bar[XB_XGEN(b.x)]) < target, bar);
            __builtin_amdgcn_fence(__ATOMIC_ACQUIRE, "agent");
            asm volatile("s_waitcnt vmcnt(0)" ::: "memory");
        } else {
            asm volatile("buffer_inv sc1" ::: "memory");
            XB_SPIN(xb_ld(&bar[XB_XGEN(b.x)]) < target, bar);
            asm volatile("s_waitcnt vmcnt(0)" ::: "memory");
        }
    }
    __syncthreads();
}

constexpr int RING_BYTES = 131072;
constexpr int LDS_BYTES = 155648;
constexpr int MISC_OFF = LDS_BYTES - 256;
constexpr int NWAVES = 8, NTHR = 512;

struct Inputs { const float* p[29]; };

template <class MAP>
__device__ __forceinline__ void transpose_item(const float* __restrict__ W, int K, int N, bf16_t* __restrict__ WT, const float* __restrict__ gA, int splitK, const float* __restrict__ gB,
                                               LAS float* scr, int item, int lane, const MAP& map) {
    const int nblk = N / 32, kb = item / nblk, nb = item - kb * nblk, k0 = 64 * kb, n0 = 32 * nb;
    float v[32];
#pragma unroll
    for (int i = 0; i < 32; ++i) { const int kk = 2 * i + (lane >> 5); v[i] = W[(size_t)(k0 + kk) * N + n0 + (lane & 31)]; }
#pragma unroll
    for (int i = 0; i < 32; ++i) { const int kk = 2 * i + (lane >> 5); scr[kk * 33 + (lane & 31)] = v[i]; }
    LDS_WAIT(); asm volatile("" ::: "memory");
    const int c = lane & 7;
    const float* gp = gA ? (k0 < splitK ? gA + k0 : gB + (k0 - splitK)) : nullptr;
    float g[8];
#pragma unroll
    for (int j = 0; j < 8; ++j) g[j] = gp ? gp[8 * c + j] : 1.0f;
#pragma unroll
    for (int j = 0; j < 4; ++j) { const int n = (lane >> 3) + 8 * j; const LAS float* s = scr + (8 * c) * 33 + n;
        u32x4 o; o.x = cvt_pk_bf16(s[0 * 33] * g[0], s[1 * 33] * g[1]); o.y = cvt_pk_bf16(s[2 * 33] * g[2], s[3 * 33] * g[3]); o.z = cvt_pk_bf16(s[4 * 33] * g[4], s[5 * 33] * g[5]); o.w = cvt_pk_bf16(s[6 * 33] * g[6], s[7 * 33] * g[7]);
        *(u32x4*)(WT + (size_t)map(n0 + n) * K + k0 + 8 * c) = o; }
    LDS_WAIT(); asm volatile("" ::: "memory");
}
template <class MAP>
__device__ __forceinline__ void transpose_item8(const float* __restrict__ W, int K, int N, unsigned char* __restrict__ WT, int pitch, const float* __restrict__ gA, float wscale,
                                                LAS float* scr, int item, int lane, const MAP& map) {
    const int nblk = N / 32, kb = item / nblk, nb = item - kb * nblk, k0 = 64 * kb, n0 = 32 * nb;
    float v[32];
#pragma unroll
    for (int i = 0; i < 32; ++i) { const int kk = 2 * i + (lane >> 5); v[i] = W[(size_t)(k0 + kk) * N + n0 + (lane & 31)]; }
#pragma unroll
    for (int i = 0; i < 32; ++i) { const int kk = 2 * i + (lane >> 5); scr[kk * 33 + (lane & 31)] = v[i]; }
    LDS_WAIT(); asm volatile("" ::: "memory");
    const int c = lane >> 4, nl = lane & 15;
    float g[16];
#pragma unroll
    for (int j = 0; j < 16; ++j) g[j] = (gA ? gA[k0 + 16 * c + j] : 1.0f) * wscale;
#pragma unroll
    for (int j2 = 0; j2 < 2; ++j2) { const int n = nl + 16 * j2; const LAS float* s = scr + (16 * c) * 33 + n;
        u32x4 o; o.x = pk4_fp8(s[0 * 33] * g[0], s[1 * 33] * g[1], s[2 * 33] * g[2], s[3 * 33] * g[3]); o.y = pk4_fp8(s[4 * 33] * g[4], s[5 * 33] * g[5], s[6 * 33] * g[6], s[7 * 33] * g[7]);
        o.z = pk4_fp8(s[8 * 33] * g[8], s[9 * 33] * g[9], s[10 * 33] * g[10], s[11 * 33] * g[11]); o.w = pk4_fp8(s[12 * 33] * g[12], s[13 * 33] * g[13], s[14 * 33] * g[14], s[15 * 33] * g[15]);
        *(u32x4*)(WT + (size_t)map(n0 + n) * pitch + k0 + 16 * c) = o; }
    LDS_WAIT(); asm volatile("" ::: "memory");
}
struct MapId { __device__ __forceinline__ int operator()(int n) const { return n; } };
struct MapWin {
    __device__ __forceinline__ int operator()(int n) const { if (n < 768) return n; if (n < 832) { const int i = n - 768; return 768 + (i < 32 ? 2 * i : 2 * (i - 32) + 1); } return 1024 + (n - 832); } };
struct MapWuq {
    __device__ __forceinline__ int operator()(int n) const { const int hd = n / DQK, d = n - hd * DQK; if (d < DNOPE) return n; const int i = d - DNOPE; return hd * DQK + DNOPE + (i < 32 ? 2 * i : 2 * (i - 32) + 1); } };
struct MapGU {
    int sel; __device__ __forceinline__ int operator()(int n) const { return 256 * (n >> 7) + 128 * sel + (n & 127); } };

template <class MAP>
__device__ __forceinline__ void transpose_matrix(const float* W, int K, int N, bf16_t* WT, const float* gA, int splitK, const float* gB, LAS float* scr, int lane, int gw, int ngw, int& base, const MAP& map) {
    const int nit = (K / 64) * (N / 32);
    int first = gw - (base % ngw); if (first < 0) first += ngw;
    for (int it = first; it < nit; it += ngw) transpose_item(W, K, N, WT, gA, splitK, gB, scr, it, lane, map);
    base += nit;
}

template <class MAP>
__device__ __forceinline__ void transpose_matrix8(const float* W, int K, int N, unsigned char* WT, const float* gA, float wscale, LAS float* scr, int lane, int gw, int ngw, int& base, const MAP& map, int pitch = 0) {
    const int nit = (K / 64) * (N / 32); if (pitch == 0) pitch = K;
    int first = gw - (base % ngw); if (first < 0) first += ngw;
    for (int it = first; it < nit; it += ngw) transpose_item8(W, K, N, WT, pitch, gA, wscale, scr, it, lane, map);
    base += nit;
}

struct PendItem { float v[32]; f32x4 g[4]; unsigned char* dst; int rstride; int fmt; };
__device__ __forceinline__ void item_finish(const PendItem& p, LAS float* scr, int lane) {
#pragma unroll
    for (int i = 0; i < 32; ++i) { const int kk = 2 * i + (lane >> 5); scr[kk * 33 + (lane & 31)] = p.v[i]; }
    LDS_WAIT(); asm volatile("" ::: "memory");
    if (p.fmt == 1) {
        const int c = lane & 7; const float g[8] = {p.g[0][0], p.g[0][1], p.g[0][2], p.g[0][3], p.g[1][0], p.g[1][1], p.g[1][2], p.g[1][3]};
#pragma unroll
        for (int j = 0; j < 4; ++j) { const int n = (lane >> 3) + 8 * j; const LAS float* s = scr + (8 * c) * 33 + n;
            u32x4 o; o.x = cvt_pk_bf16(s[0 * 33] * g[0], s[1 * 33] * g[1]); o.y = cvt_pk_bf16(s[2 * 33] * g[2], s[3 * 33] * g[3]); o.z = cvt_pk_bf16(s[4 * 33] * g[4], s[5 * 33] * g[5]); o.w = cvt_pk_bf16(s[6 * 33] * g[6], s[7 * 33] * g[7]);
            *(u32x4*)(p.dst + (size_t)n * p.rstride + 16 * c) = o; }
    } else {
        const int c = lane >> 4, nl = lane & 15; float g[16];
#pragma unroll
        for (int j = 0; j < 16; ++j) g[j] = p.g[j >> 2][j & 3];
#pragma unroll
        for (int j2 = 0; j2 < 2; ++j2) { const int n = nl + 16 * j2; const LAS float* s = scr + (16 * c) * 33 + n;
            u32x4 o; o.x = pk4_fp8(s[0 * 33] * g[0], s[1 * 33] * g[1], s[2 * 33] * g[2], s[3 * 33] * g[3]); o.y = pk4_fp8(s[4 * 33] * g[4], s[5 * 33] * g[5], s[6 * 33] * g[6], s[7 * 33] * g[7]);
            o.z = pk4_fp8(s[8 * 33] * g[8], s[9 * 33] * g[9], s[10 * 33] * g[10], s[11 * 33] * g[11]); o.w = pk4_fp8(s[12 * 33] * g[12], s[13 * 33] * g[13], s[14 * 33] * g[14], s[15 * 33] * g[15]);
            *(u32x4*)(p.dst + (size_t)n * p.rstride + 16 * c) = o; }
    }
    LDS_WAIT(); asm volatile("" ::: "memory");
}
template <class MAP>
__device__ __forceinline__ void convert_matrix(PendItem& pend, const float* W, int K, int N, unsigned char* WT, int pitchB, int fmt, const float* gA, int splitK, const float* gB, float wscale,
                                               LAS float* scr, int lane, int gw, int ngw, int& base, const MAP& map) {
    const int nblk = N / 32, nit = (K / 64) * nblk, esize = fmt == 1 ? 2 : 1;
    int first = gw - (base % ngw); if (first < 0) first += ngw;
    for (int it = first; it < nit; it += ngw) {
        const int kb = it / nblk, nb = it - kb * nblk, k0 = 64 * kb, n0 = 32 * nb;
        float nv[32];
#pragma unroll
        for (int i = 0; i < 32; ++i) { const int kk = 2 * i + (lane >> 5); nv[i] = W[(size_t)(k0 + kk) * N + n0 + (lane & 31)]; }
        if (pend.fmt) item_finish(pend, scr, lane);
#pragma unroll
        for (int i = 0; i < 32; ++i) pend.v[i] = nv[i];
        const int r0 = map(n0);
        pend.dst = WT + (size_t)r0 * pitchB + (size_t)k0 * esize; pend.rstride = (map(n0 + 1) - r0) * pitchB;
        const float* gq = gA ? (k0 < splitK ? gA + k0 : gB + (k0 - splitK)) : W; const int goff = fmt == 1 ? 8 * (lane & 7) : 16 * (lane >> 4);
        f32x4 gv[4]; gv[0] = *(const f32x4*)(gq + goff); gv[1] = *(const f32x4*)(gq + goff + 4);
        if (fmt == 2) { gv[2] = *(const f32x4*)(gq + goff + 8); gv[3] = *(const f32x4*)(gq + goff + 12); } else { gv[2] = gv[0]; gv[3] = gv[1]; }
#pragma unroll
        for (int j = 0; j < 4; ++j) pend.g[j] = gA ? gv[j] * wscale : (f32x4){wscale, wscale, wscale, wscale};
        pend.fmt = fmt;
    }
    base += nit;
}

constexpr int IT_DENSE_M = (DM / 64) * (DFF / 32), IT_DENSE = 3 * IT_DENSE_M;
constexpr int IT_EXP_M = (DM / 64) * (DFE / 32), IT_EXP = 3 * IT_EXP_M, IT_MOE = NE * IT_EXP;
static_assert((DFF / 64) * (DM / 32) == IT_DENSE_M && (DFE / 64) * (DM / 32) == IT_EXP_M, "gate/up and down matrices have equal item counts");
#ifndef TAIL_BUDGET
#define TAIL_BUDGET 2
#endif
#ifndef GU_BUDGET
#define GU_BUDGET 10
#endif
#ifndef MDN_BUDGET
#define MDN_BUDGET 7
#endif
__device__ __forceinline__ int cap_mdn(int G) { return G == 256 ? (G - 64) * NWAVES * MDN_BUDGET : 0; }
#ifndef S5E_BUDGET
#define S5E_BUDGET 6
#endif
__device__ __forceinline__ int cap_s5e(int G) { return G == 256 ? 50 * NWAVES * S5E_BUDGET : 0; }
__device__ __forceinline__ int set_total(int set) { return set == 2 ? IT_DENSE : IT_MOE; }
__device__ __forceinline__ int cap_tail(int G, int ntail) { return (G > ntail ? G - ntail : 0) * NWAVES * TAIL_BUDGET; }
__device__ __forceinline__ int gu_short(int G) { const int rem = ((MP / 256) * (2 * DFF / 256)) % G; return rem ? G - rem : 0; }
__device__ __forceinline__ int cap_gu(int G) { return gu_short(G) * NWAVES * GU_BUDGET; }
__device__ __forceinline__ int slot_begin(int s, int G) { int o = 0; if (s > 0) o += cap_tail(G, 64); if (s > 1) o += cap_tail(G, 64); if (s == 3 || s == 5) o += cap_gu(G); if (s == 5) o += cap_tail(G, 88); return o; }
__device__ __forceinline__ int slot_cap(int s, int G) { return s < 2 ? cap_tail(G, 64) : (s == 2 ? cap_gu(G) : (s == 3 ? cap_tail(G, 88) : (s == 4 ? cap_mdn(G) : cap_s5e(G)))); }
__device__ __forceinline__ int set_deferred(int set, int G) { const int l = set - 1; int o = 2 * cap_tail(G, 64); if ((l & 1) == 0) o += cap_gu(G) + cap_tail(G, 88) + cap_s5e(G); else o += cap_mdn(G); const int t = set_total(set); return o < t ? o : t; }
struct FfnSrc { const float* fn; const float* dg; const float* du; const float* dd; const float* mg; const float* mu; const float* md; };
#define TO_GLOBAL(T, p) ((T)({ GAS void* _g = (GAS void*)(p); asm volatile("" : "+v"(_g)); _g; }))
__device__ __forceinline__ void ffn_convert_range(int set, int t0, int t1, int jw, int nw, const FfnSrc& src, unsigned char* ws, LAS float* scr, int lane) {
    PendItem pend; pend.fmt = 0; pend.dst = nullptr; pend.rstride = 0;
#pragma unroll
    for (int i = 0; i < 32; ++i) pend.v[i] = 0.f;
#pragma unroll
    for (int j = 0; j < 4; ++j) pend.g[j] = (f32x4){0.f, 0.f, 0.f, 0.f};
    for (int t = t0 + jw; t < t1; t += nw) {
        const float* W; const float* gn; unsigned char* WT; int K, N, pitch, sel, local; float wscale;
        if (set == 2) { const int m = t / IT_DENSE_M; local = t - m * IT_DENSE_M; unsigned char* wd = ws + WS_WFF + SZ_DENSE;
            if (m < 2) { W = (m ? src.du : src.dg) + (size_t)DM * DFF; K = DM; N = DFF; WT = wd; pitch = DM; gn = src.fn + 2 * DM; wscale = F8_WGU; sel = m; }
            else { W = src.dd + (size_t)DFF * DM; K = DFF; N = DM; WT = wd + SZ_DGU; pitch = DFF; gn = nullptr; wscale = F8_WDN; sel = -1; } }
        else { const int i = set == 1 ? 0 : 1, e = t / IT_EXP, r = t - e * IT_EXP, m = r / IT_EXP_M; local = r - m * IT_EXP_M;
            unsigned char* we = ws + WS_WFF + 2 * SZ_DENSE + (size_t)i * SZ_MOE + (size_t)e * SZ_EXP;
            if (m < 2) { W = (m ? src.mu : src.mg) + (size_t)(i * NE + e) * DM * DFE; K = DM; N = DFE; WT = we; pitch = DM; gn = src.fn + (2 * i + 1) * DM; wscale = F8_WGU; sel = m; }
            else { W = src.md + (size_t)(i * NE + e) * DFE * DM; K = DFE; N = DM; WT = we + SZ_EGU; pitch = DFEP; gn = nullptr; wscale = F8_WDN; sel = -1; } }
        (void)K;
        W = TO_GLOBAL(const float*, W);
        const int nblk = N / 32, kb = local / nblk, nb = local - kb * nblk, k0 = 64 * kb, n0 = 32 * nb;
        float nv[32];
#pragma unroll
        for (int i = 0; i < 32; ++i) { const int kk = 2 * i + (lane >> 5); nv[i] = W[(size_t)(k0 + kk) * N + n0 + (lane & 31)]; }
        if (pend.fmt) item_finish(pend, scr, lane);
#pragma unroll
        for (int i = 0; i < 32; ++i) pend.v[i] = nv[i];
        const int r0 = sel >= 0 ? 256 * (n0 >> 7) + 128 * sel + (n0 & 127) : n0;
        pend.dst = (unsigned char*)TO_GLOBAL(unsigned char*, WT + (size_t)r0 * pitch + k0); pend.rstride = pitch;
        const float* gq = TO_GLOBAL(const float*, gn ? gn + k0 : W); const int goff = 16 * (lane >> 4);
        f32x4 gv[4];
#pragma unroll
        for (int j = 0; j < 4; ++j) gv[j] = *(const f32x4*)(gq + goff + 4 * j);
#pragma unroll
        for (int j = 0; j < 4; ++j) pend.g[j] = gn ? gv[j] * wscale : (f32x4){wscale, wscale, wscale, wscale};
        pend.fmt = 2;
    }
    if (pend.fmt) item_finish(pend, scr, lane);
}

__device__ __forceinline__ void ffn_slot(int l, int s, int G, int c, int tid, const float* const* itab, unsigned char* ws, LAS unsigned char* lds) {
    if (l >= DEPTH - 1) return;
    asm volatile("" : "+s"(G), "+s"(l));
    const int set = l + 1, lane = tid & 63, wave = tid >> 6;
    int first_idle, nidle;
    if (s == 2) { nidle = gu_short(G); first_idle = G - nidle; } else { const int nt = s == 3 ? 88 : 64; first_idle = nt < G ? nt : G; nidle = G - first_idle; }
    if ((s == 4 || s == 5) && G != 256) return;
    if (s == 5) { if (l & 1) return; first_idle = 206; nidle = 50; }
    if (c < first_idle || nidle == 0) return;
    const int t0 = slot_begin(s, G), dl = set_deferred(set, G); int t1 = t0 + slot_cap(s, G); if (t1 > dl) t1 = dl;
    if (t0 >= t1) return;
    const FfnSrc src{itab[20], itab[21], itab[22], itab[23], itab[25], itab[26], itab[27]};
    ffn_convert_range(set, t0, t1, (c - first_idle) * NWAVES + wave, nidle * NWAVES, src, ws, (LAS float*)(lds + wave * 8704), lane);
}

__device__ __forceinline__ void prologue_phase(const Inputs& in_, unsigned char* ws, LAS unsigned char* lds, int tid, int G) {
    const int lane = tid & 63, wave = tid >> 6, gw = blockIdx.x * NWAVES + wave, ngw = G * NWAVES;
    LAS float* scr = (LAS float*)(lds + wave * 8704);
    Inputs in;
#pragma unroll
    for (int k = 0; k < 29; ++k) in.p[k] = (const float*)(GAS const void*)in_.p[k];
    ws = (unsigned char*)(GAS void*)ws;
    {
        float* h = (float*)(ws + WS_H); bf16_t* hb = (bf16_t*)(ws + WS_HB); ssq_t* ssq = (ssq_t*)(ws + CTL_SSQ) + (size_t)SSQ_H1(0) * MP;
        for (int row = gw; row < MP; row += ngw) {
            const float* src = row < MX ? in.p[0] + (size_t)row * DM : (row < MREAL ? in.p[1] + (size_t)((row - MX) & (NMETA - 1)) * DM : nullptr);
            float ss = 0.f;
#pragma unroll
            for (int jj = 0; jj < 4; ++jj) { const int c = 8 * lane + 512 * jj;
                const f32x4 v = src ? *(const f32x4*)(src + c) : (f32x4){0.f, 0.f, 0.f, 0.f}, v2 = src ? *(const f32x4*)(src + c + 4) : (f32x4){0.f, 0.f, 0.f, 0.f};
                if (row >= MX) { *(f32x4*)(h + (size_t)row * DM + c) = v; *(f32x4*)(h + (size_t)row * DM + c + 4) = v2; }
                u32x4 w; w.x = cvt_pk_bf16(v[0], v[1]); w.y = cvt_pk_bf16(v[2], v[3]); w.z = cvt_pk_bf16(v2[0], v2[1]); w.w = cvt_pk_bf16(v2[2], v2[3]); *(u32x4*)(hb + (size_t)row * DM + c) = w;
                ss += (v[0] * v[0] + v[1] * v[1]) + (v[2] * v[2] + v[3] * v[3]) + (v2[0] * v2[0] + v2[1] * v2[1]) + (v2[2] * v2[2] + v2[3] * v2[3]); }
            ss = wave_sum(ss); if (lane == 0) ssq[row] = ssq_fix(ss);
        }
    }
    { bf16_t* proj = (bf16_t*)(ws + WS_PROJ); bf16_t* kpe = (bf16_t*)(ws + WS_KPE);
      for (int row = MREAL + gw; row < MP; row += ngw) {
#pragma unroll
          for (int j = 0; j < 4; ++j) *(u32x4*)(proj + (size_t)row * PROJW + 512 * j + 8 * lane) = (u32x4){0u, 0u, 0u, 0u};
          if (lane < 8) *(u32x4*)(kpe + (size_t)row * 64 + 8 * lane) = (u32x4){0u, 0u, 0u, 0u}; } }
    {
        float* cosb = (float*)(ws + WS_ROPE); float* sinb = cosb + LTOK * 32;
        for (int i = gw * 64 + lane; i < LTOK * 32; i += ngw * 64) { const int t = i >> 5, k = i & 31;
            const float inv = powf(10000.0f, -(float)(2 * k) / 64.0f); const float ang = (float)t * inv; cosb[i] = cosf(ang); sinb[i] = sinf(ang); }
    }
    for (int i = gw * 64 + lane; i < DEPTH * 2 * NG * NS; i += ngw * 64) {
        const int p = i & 63, ldg = i >> 6;
        unsigned char* tb = ws + WS_S5 + (size_t)ldg * S5_STRIDE;
        const float lr = in.p[8][i], li = in.p[9][i], dt = expf(in.p[10][ldg]);
        const float mag = expf(lr * dt), ar = mag * cosf(li * dt), ai = mag * sinf(li * dt);
        ((f32x2*)(tb + S5_LAM))[p] = (f32x2){ar, ai};
        const float den = 1.0f / (lr * lr + li * li), xr = ar - 1.0f, xi = ai;
        const float fr_ = (xr * lr + xi * li) * den, fi_ = (xi * lr - xr * li) * den;
        const float* bre = in.p[11] + (size_t)i * GS; const float* bim = in.p[12] + (size_t)i * GS;
        bf16_t* ore = (bf16_t*)(tb + S5_BRE) + p * GS; bf16_t* oim = (bf16_t*)(tb + S5_BIM) + p * GS;
#pragma unroll
        for (int c = 0; c < GS; c += 2) { const float r0 = fr_ * bre[c] - fi_ * bim[c], i0 = fr_ * bim[c] + fi_ * bre[c], r1 = fr_ * bre[c + 1] - fi_ * bim[c + 1], i1 = fr_ * bim[c + 1] + fi_ * bre[c + 1];
            *(unsigned*)(ore + c) = cvt_pk_bf16(r0, r1); *(unsigned*)(oim + c) = cvt_pk_bf16(i0, i1); }
        const float* cre = in.p[13] + (size_t)ldg * GS * NS; const float* cim = in.p[14] + (size_t)ldg * GS * NS; bf16_t* ce = (bf16_t*)(tb + S5_CEF);
#pragma unroll
        for (int co = 0; co < GS; ++co) *(unsigned*)(ce + co * 128 + 2 * p) = cvt_pk_bf16(cre[co * NS + p], -cim[co * NS + p]);
    }
    int base = 0;
    PendItem pend; pend.fmt = 0; pend.dst = nullptr; pend.rstride = 0;
#pragma unroll
    for (int i = 0; i < 32; ++i) pend.v[i] = 0.f;
#pragma unroll
    for (int j = 0; j < 4; ++j) pend.g[j] = (f32x4){0.f, 0.f, 0.f, 0.f};
    for (int l = 0; l < DEPTH; ++l) {
        unsigned char* wl = ws + WS_W + (size_t)l * SZ_LAYER;
        convert_matrix(pend, in.p[3] + (size_t)l * DM * INC, DM, INC, wl + OFF_WIN, DM * 2, 1, in.p[2] + l * DM, 1 << 30, nullptr, 1.0f, scr, lane, gw, ngw, base, MapWin());
        convert_matrix(pend, in.p[5] + (size_t)l * QL * 1536, QL, 1536, wl + OFF_WUQ, QL * 2, 1, in.p[4] + l * QL, 1 << 30, nullptr, 1.0f, scr, lane, gw, ngw, base, MapWuq());
        convert_matrix(pend, in.p[7] + (size_t)l * KVL * 2048, KVL, 2048, wl + OFF_WUKV, KVL * 2, 1, in.p[6] + l * KVL, 1 << 30, nullptr, 1.0f, scr, lane, gw, ngw, base, MapId());
        convert_matrix(pend, in.p[16] + (size_t)l * SSMW * SSMW, SSMW, SSMW, wl + OFF_WGLU, SSMW, 2, nullptr, 0, nullptr, F8_WGL, scr, lane, gw, ngw, base, MapId());
        convert_matrix(pend, in.p[19] + (size_t)l * DM * DM, DM, DM, wl + OFF_WOUT, DM * 2, 1, in.p[17] + l * ATTW, ATTW, in.p[18] + l * SSMW, 1.0f, scr, lane, gw, ngw, base, MapId());
    }
    for (int i = 0; i < 1; ++i) {
        unsigned char* wd = ws + WS_WFF + (size_t)i * SZ_DENSE; const float* gn = in.p[20] + (size_t)(2 * i) * DM;
        convert_matrix(pend, in.p[21] + (size_t)i * DM * DFF, DM, DFF, wd, DM, 2, gn, 1 << 30, nullptr, F8_WGU, scr, lane, gw, ngw, base, MapGU{0});
        convert_matrix(pend, in.p[22] + (size_t)i * DM * DFF, DM, DFF, wd, DM, 2, gn, 1 << 30, nullptr, F8_WGU, scr, lane, gw, ngw, base, MapGU{1});
        convert_matrix(pend, in.p[23] + (size_t)i * DFF * DM, DFF, DM, wd + SZ_DGU, DFF, 2, nullptr, 0, nullptr, F8_WDN, scr, lane, gw, ngw, base, MapId());
    }
    if (pend.fmt) item_finish(pend, scr, lane);
    pend.fmt = 0;
    { FfnSrc src{in.p[20], in.p[21], in.p[22], in.p[23], in.p[25], in.p[26], in.p[27]};
      for (int set = 1; set <= 3; ++set) ffn_convert_range(set, set_deferred(set, G), set_total(set), gw, ngw, src, ws, scr, lane); }
    for (int i = 0; i < 2 * NE; ++i) { unsigned char* we = ws + WS_WFF + 2 * SZ_DENSE + (size_t)i * SZ_EXP;
        for (int r = gw; r < DM; r += ngw) if (lane < 8) *(u32x4*)(we + SZ_EGU + (size_t)r * DFEP + DFE + 16 * lane) = (u32x4){0u, 0u, 0u, 0u}; }
}

constexpr int S5_HROW = 304;
constexpr int S5_POFF = 2 * 2 * 32 * S5_HROW;
constexpr int S5_NCH = 66, S5_LP = S5_NCH * 32;
#define WG_BAR() do { LDS_WAIT(); __builtin_amdgcn_s_barrier(); asm volatile("" ::: "memory"); } while (0)
__device__ __forceinline__ void s5_phase(const unsigned char* ws_tab, const bf16_t* proj, unsigned char* g8, bf16_t* gb, const float* dskip, int l, LAS unsigned char* lds, int tid, int G) {
    const int lane = tid & 63, wid = __builtin_amdgcn_readfirstlane(tid >> 6);
    for (int unit0 = blockIdx.x; unit0 < NBATCH * NG; unit0 += G) {
        const int unit = (G == 256) ? ((unit0 & 7) << 5) | (unit0 >> 3) : unit0;
        const int b = unit >> 6, g = unit & 63;
        if (wid < 4) {
            const int d = wid >> 1, pt = wid & 1, pl = lane & 31, hh = lane >> 5, p = 32 * pt + pl;
            const unsigned char* tb = ws_tab + (size_t)((l * 2 + d) * NG + g) * S5_STRIDE;
            const f32x2 lam = ((const f32x2*)(tb + S5_LAM))[p];
            const bf16x8 Bre = *(const bf16x8*)(tb + S5_BRE + (p * GS + 8 * hh) * 2), Bim = *(const bf16x8*)(tb + S5_BIM + (p * GS + 8 * hh) * 2);
            float pr[4], pi[4]; pr[0] = lam.x; pi[0] = lam.y;
#pragma unroll
            for (int k = 1; k < 4; ++k) { pr[k] = pr[k - 1] * lam.x - pi[k - 1] * lam.y; pi[k] = pr[k - 1] * lam.y + pi[k - 1] * lam.x; }
            const float l4r = pr[3], l4i = pi[3], l8r = l4r * l4r - l4i * l4i, l8i = 2.f * l4r * l4i, l12r = l8r * l4r - l8i * l4i, l12i = l8r * l4i + l8i * l4r, l16r = l8r * l8r - l8i * l8i, l16i = 2.f * l8r * l8i;
            float Hr = 0.f, Hi = 0.f;
            const int arow = lane & 31, ipos = 16 * ((arow >> 2) & 1) + 4 * (arow & 3) + (arow >> 3), kh = lane >> 5;
            const bf16_t* ubase = proj + 1024 + GS * g + 8 * kh;
#define S5_UROW(it_) ({ const int tau_ = 32 * (it_) + ipos, t_ = d ? (S5_LP - 1 - tau_) : tau_; (size_t)tok_row(b, t_ < LTOK ? t_ : 0) * PROJW; })
#define S5_UOK(it_) ({ const int tau_ = 32 * (it_) + ipos, t_ = d ? (S5_LP - 1 - tau_) : tau_; t_ < LTOK; })
            bf16x8 aq[4];
#pragma unroll
            for (int k = 0; k < 4; ++k) aq[k] = *(const bf16x8*)(ubase + S5_UROW(k));
            for (int it0 = 0; it0 <= S5_NCH; it0 += 4) {
#pragma unroll
              for (int kq = 0; kq < 4; ++kq) { const int it = it0 + kq;
               if (it <= S5_NCH) {
                if (it < S5_NCH) {
                    const bf16x8 a = S5_UOK(it) ? aq[kq] : (bf16x8){0, 0, 0, 0, 0, 0, 0, 0};
                    f32x16 are = {}, aim = {};
                    are = __builtin_amdgcn_mfma_f32_32x32x16_bf16(a, Bre, are, 0, 0, 0);
                    aim = __builtin_amdgcn_mfma_f32_32x32x16_bf16(a, Bim, aim, 0, 0, 0);
                    aq[kq] = *(const bf16x8*)(ubase + S5_UROW(it + 4 < S5_NCH ? it + 4 : it));
#define CMA(or_, oi_, ar_, ai_, br_, bi_, cr_, ci_) do { or_ = fmaf(ar_, br_, fmaf(-(ai_), bi_, cr_)); oi_ = fmaf(ar_, bi_, fmaf(ai_, br_, ci_)); } while (0)
#define CMA2(or_, oi_, ar_, ai_, br_, bi_, cr_, ci_) do { const f32x2 _tr = (br_) * (ar_) + (cr_), _ti = (bi_) * (ar_) + (ci_); or_ = _tr - (bi_) * (ai_); oi_ = _ti + (br_) * (ai_); } while (0)
                    f32x2 XR[4][2], XI[4][2];
#pragma unroll
                    for (int j = 0; j < 4; ++j)
#pragma unroll
                        for (int q = 0; q < 2; ++q) { XR[j][q] = (f32x2){are[4 * j + 2 * q], are[4 * j + 2 * q + 1]}; XI[j][q] = (f32x2){aim[4 * j + 2 * q], aim[4 * j + 2 * q + 1]}; }
#pragma unroll
                    for (int j = 1; j < 4; ++j)
#pragma unroll
                        for (int q = 0; q < 2; ++q) { f32x2 nr, ni; CMA2(nr, ni, lam.x, lam.y, XR[j - 1][q], XI[j - 1][q], XR[j][q], XI[j][q]); XR[j][q] = nr; XI[j][q] = ni; }
                    const float e0r = XR[3][0].x, e0i = XI[3][0].x, e1r = XR[3][0].y, e1i = XI[3][0].y, e2r = XR[3][1].x, e2i = XI[3][1].x, e3r = XR[3][1].y, e3i = XI[3][1].y;
                    float er, ei, t1r, t1i; CMA(er, ei, l4r, l4i, e2r, e2i, e3r, e3i); CMA(t1r, t1i, l12r, l12i, e0r, e0i, er, ei); CMA(er, ei, l8r, l8i, e1r, e1i, t1r, t1i);
                    const float Eor = swap32(er, hh), Eoi = swap32(ei, hh);
                    float i0r = Hr, i0i = Hi; if (hh) CMA(i0r, i0i, l16r, l16i, Hr, Hi, Eor, Eoi);
                    float i1r, i1i, i2r, i2i, i3r, i3i; CMA(i1r, i1i, l4r, l4i, i0r, i0i, e0r, e0i); CMA(i2r, i2i, l4r, l4i, i1r, i1i, e1r, e1i); CMA(i3r, i3i, l4r, l4i, i2r, i2i, e2r, e2i);
                    const f32x2 INR[2] = {(f32x2){i0r, i1r}, (f32x2){i2r, i3r}}, INI[2] = {(f32x2){i0i, i1i}, (f32x2){i2i, i3i}};
                    LAS unsigned char* hrow = lds + (size_t)(((it & 1) * 2 + d) * 32 + 16 * hh) * S5_HROW + 4 * p;
                    if (pt == 0) *(LAS bf16x8*)(lds + (size_t)(((it & 1) * 2 + d) * 32 + ipos) * S5_HROW + 256 + 16 * kh) = a;
                    float cr = 0.f, ci = 0.f;
#pragma unroll
                    for (int j = 0; j < 4; ++j)
#pragma unroll
                        for (int q = 0; q < 2; ++q) { f32x2 hr2, hi2; CMA2(hr2, hi2, pr[j], pi[j], INR[q], INI[q], XR[j][q], XI[j][q]);
                            *(LAS unsigned*)(hrow + (4 * (2 * q) + j) * S5_HROW) = cvt_pk_bf16(hr2.x, hi2.x); *(LAS unsigned*)(hrow + (4 * (2 * q + 1) + j) * S5_HROW) = cvt_pk_bf16(hr2.y, hi2.y);
                            if (j == 3 && q == 1) { cr = hr2.y; ci = hi2.y; } }
#undef CMA
#undef CMA2
                    const float ocr = swap32(cr, hh), oci = swap32(ci, hh);
                    Hr = hh ? cr : ocr; Hi = hh ? ci : oci;
                }
                WG_BAR();
               }
              }
            }
        } else {
            const int cw = wid - 4, d = cw >> 1, tt = cw & 1, tk = lane & 15, q = lane >> 4;
            const unsigned char* tb = ws_tab + (size_t)((l * 2 + d) * NG + g) * S5_STRIDE;
            bf16x8 Cf[4];
#pragma unroll
            for (int ks = 0; ks < 4; ++ks) Cf[ks] = *(const bf16x8*)(tb + S5_CEF + (tk * 128 + 32 * ks + 8 * q) * 2);
            bf16x8 Dfrag = {0, 0, 0, 0, 0, 0, 0, 0};
            if (d == 0 && q < 2) { const float dv = dskip[GS * g + tk]; const unsigned short db = (unsigned short)(cvt_pk_bf16(dv, 0.f) & 0xffffu);
#pragma unroll
                for (int jj = 0; jj < 8; ++jj) Dfrag[jj] = (8 * q + jj == tk) ? (short)db : (short)0; }
            LAS unsigned char* part = lds + S5_POFF;
            for (int it = 0; it <= S5_NCH; ++it) {
                if (it >= 1) {
                    const int s = it - 1;
                    const LAS unsigned char* hrow = lds + (size_t)(((s & 1) * 2 + d) * 32 + 16 * tt + tk) * S5_HROW;
                    f32x4 acc = {0.f, 0.f, 0.f, 0.f};
#pragma unroll
                    for (int ks = 0; ks < 4; ++ks) { const bf16x8 hf = *(const LAS bf16x8*)(hrow + 16 * q + 64 * ks); acc = __builtin_amdgcn_mfma_f32_16x16x32_bf16(Cf[ks], hf, acc, 0, 0, 0); }
                    if (d == 0) { bf16x8 uf = {0, 0, 0, 0, 0, 0, 0, 0}; if (q < 2) uf = *(const LAS bf16x8*)(hrow + 256 + 16 * q); acc = __builtin_amdgcn_mfma_f32_16x16x32_bf16(Dfrag, uf, acc, 0, 0, 0); }
                    const int tau = 32 * s + 16 * tt + tk, t = d ? (S5_LP - 1 - tau) : tau;
                    if (t < LTOK) {
                        LAS unsigned char* pp = part + (size_t)(t * GS + 4 * q) * 2;
                        if (s <= 32) { u32x2 w; w.x = cvt_pk_bf16(acc[0], acc[1]); w.y = cvt_pk_bf16(acc[2], acc[3]); *(LAS u32x2*)pp = w; }
                        else { const u32x2 o = *(const LAS u32x2*)pp;
                            const float y0 = acc[0] + bflo(o.x), y1 = acc[1] + bfhi(o.x), y2 = acc[2] + bflo(o.y), y3 = acc[3] + bfhi(o.y);
                            const float g0 = gelu_tanh(y0), g1 = gelu_tanh(y1), g2 = gelu_tanh(y2), g3 = gelu_tanh(y3); const size_t ro = (size_t)tok_row(b, t) * SSMW + GS * g + 4 * q;
                            u32x2 w; w.x = cvt_pk_bf16(g0, g1); w.y = cvt_pk_bf16(g2, g3); *(u32x2*)(gb + ro) = w;
                            *(unsigned*)(g8 + ro) = pk4_fp8(g0 * F8_GS, g1 * F8_GS, g2 * F8_GS, g3 * F8_GS); }
                    }
                }
                WG_BAR();
            }
        }
        __syncthreads();
    }
}

namespace att {
constexpr int KVBLK = 64, NMINI = 7;
constexpr int SHM_V = 16384, SHM_K = 16384, SHM_P = 8192;
constexpr int V_OFF = 0, KN_OFF = 3 * SHM_V, KP_OFF = KN_OFF + 2 * SHM_K, WS_OFF = KP_OFF + 2 * SHM_P, QR_OFF = WS_OFF + NWAVES * 256, NQL = 6, LDS_NEED = QR_OFF + NWAVES * NQL * 1024;
static_assert(LDS_NEED <= MISC_OFF, "attention LDS");
constexpr float THRL = 8.0f * 1.4426950408889634f;
#define KSWZ(row, colB) ((row) * 256 + ((colB) ^ (((row) & 7) << 4)))
#define KPSWZ(row, colB) ((row) * 128 + ((colB) ^ ((((row) >> 1) & 7) << 4)))
#define SBAR() __builtin_amdgcn_sched_barrier(0)
__device__ __forceinline__ int crow(int r, int hi) { return (r & 3) + 8 * (r >> 2) + 4 * hi; }
__device__ __forceinline__ void partialSM(f32x16& p0, f32x16& p1, float& m_reg, float& mn, float& alpha) {
    float pmax = p0[0];
#pragma unroll
    for (int r = 1; r < 16; ++r) pmax = fmaxf(pmax, p0[r]);
#pragma unroll
    for (int r = 0; r < 16; ++r) pmax = fmaxf(pmax, p1[r]);
    { auto rr = __builtin_amdgcn_permlane32_swap(__float_as_uint(pmax), __float_as_uint(pmax), false, false); pmax = fmaxf(__uint_as_float(rr[0]), __uint_as_float(rr[1])); }
    if (__builtin_expect(__all(pmax - m_reg <= THRL), 1)) { mn = m_reg; alpha = 1.f; }
    else { mn = fmaxf(m_reg, pmax); alpha = fast_exp2(m_reg - mn); m_reg = mn; }
#pragma unroll
    for (int r = 0; r < 16; ++r) p0[r] = p0[r] - mn;
#pragma unroll
    for (int r = 0; r < 16; ++r) p1[r] = p1[r] - mn;
#pragma unroll
    for (int r = 0; r < 16; ++r) p0[r] = fast_exp2(p0[r]);
}
__device__ __forceinline__ void finishSM(f32x16& p0, f32x16& p1, float alpha, float& l_reg, bf16x8& pa0, bf16x8& pa1, bf16x8& pa2, bf16x8& pa3) {
#pragma unroll
    for (int r = 0; r < 16; ++r) p1[r] = fast_exp2(p1[r]);
    float ps = 0;
#pragma unroll
    for (int r = 0; r < 16; ++r) ps += p0[r];
#pragma unroll
    for (int r = 0; r < 16; ++r) ps += p1[r];
    { auto rr = __builtin_amdgcn_permlane32_swap(__float_as_uint(ps), __float_as_uint(ps), false, false); ps = __uint_as_float(rr[0]) + __uint_as_float(rr[1]); }
    l_reg = l_reg * alpha + ps;
#define PK4(P, BASE, OUT) do { unsigned a0 = cvt_pk_bf16(P[BASE + 0], P[BASE + 1]), a1 = cvt_pk_bf16(P[BASE + 2], P[BASE + 3]);   \
    unsigned b0 = cvt_pk_bf16(P[BASE + 4], P[BASE + 5]), b1 = cvt_pk_bf16(P[BASE + 6], P[BASE + 7]);                              \
    auto r0 = __builtin_amdgcn_permlane32_swap(a0, b0, false, false); auto r1 = __builtin_amdgcn_permlane32_swap(a1, b1, false, false); \
    u32x4 w = {r0[0], r1[0], r0[1], r1[1]}; OUT = *reinterpret_cast<bf16x8*>(&w); } while (0)
    PK4(p0, 0, pa0); PK4(p0, 8, pa1); PK4(p1, 0, pa2); PK4(p1, 8, pa3);
#undef PK4
}
__device__ __forceinline__ void qkt(f32x16& p0, f32x16& p1, const LAS char* Kn, const LAS char* Kp, const bf16x8* qr, const LAS char* qrl, int r32, int hi, bool masked) {
    p0 = f32x16{}; p1 = f32x16{};
#pragma unroll
    for (int d0 = 0; d0 < 8; ++d0) { const int cb = (d0 * 16 + hi * 8) * 2;
        const bf16x8 b0 = *(const LAS bf16x8*)(Kn + KSWZ(r32, cb)), b1 = *(const LAS bf16x8*)(Kn + KSWZ(32 + r32, cb));
        const bf16x8 qf = d0 < 6 ? qr[d0 < 6 ? d0 : 0] : *(const LAS bf16x8*)(qrl + (d0 == 6 ? 5 : 4) * 1024);
        p0 = __builtin_amdgcn_mfma_f32_32x32x16_bf16(b0, qf, p0, 0, 0, 0); p1 = __builtin_amdgcn_mfma_f32_32x32x16_bf16(b1, qf, p1, 0, 0, 0); }
#pragma unroll
    for (int d0 = 0; d0 < 4; ++d0) { const int cb = (d0 * 16 + hi * 8) * 2;
        const bf16x8 b0 = *(const LAS bf16x8*)(Kp + KPSWZ(r32, cb)), b1 = *(const LAS bf16x8*)(Kp + KPSWZ(32 + r32, cb));
        const bf16x8 qf = *(const LAS bf16x8*)(qrl + d0 * 1024);
        p0 = __builtin_amdgcn_mfma_f32_32x32x16_bf16(b0, qf, p0, 0, 0, 0); p1 = __builtin_amdgcn_mfma_f32_32x32x16_bf16(b1, qf, p1, 0, 0, 0); }
    if (masked) {
#pragma unroll
        for (int r = 8; r < 16; ++r) p0[r] = -1e30f;
#pragma unroll
        for (int r = 0; r < 16; ++r) p1[r] = -1e30f;
    }
}
__device__ __forceinline__ int v_st(int k, int c) { const int kk = (k & ~0xC) | ((k & 4) << 1) | ((k & 8) >> 1); return ((kk >> 3) * 4 + (c >> 5)) * 512 + ((kk & 7) * 32 + (c & 31)) * 2; }
__device__ __forceinline__ int v_rd_base(int lane) { return ((lane & 3) << 3) | (((lane >> 2) & 3) << 6) | (((lane >> 4) & 1) << 5) | (((lane >> 5) & 1) << 8); }
constexpr int v_rd_off(int d0, int ks, int half) { return d0 * 512 + ks * 4096 + half * 2048; }
template <int OFF> __device__ __forceinline__ s16x4 tr_read(int vb) { s16x4 r; asm volatile("ds_read_b64_tr_b16 %0, %1 offset:%2" : "=&v"(r) : "v"(vb), "i"(OFF) : "memory"); return r; }
template <int D0> __device__ __forceinline__ void pv_one(f32x16& od, int vb, bf16x8 pa0, bf16x8 pa1, bf16x8 pa2, bf16x8 pa3) {
    const s16x4 l0 = tr_read<v_rd_off(D0, 0, 0)>(vb), h0 = tr_read<v_rd_off(D0, 0, 1)>(vb), l1 = tr_read<v_rd_off(D0, 1, 0)>(vb), h1 = tr_read<v_rd_off(D0, 1, 1)>(vb);
    const s16x4 l2 = tr_read<v_rd_off(D0, 2, 0)>(vb), h2 = tr_read<v_rd_off(D0, 2, 1)>(vb), l3 = tr_read<v_rd_off(D0, 3, 0)>(vb), h3 = tr_read<v_rd_off(D0, 3, 1)>(vb);
    asm volatile("s_waitcnt lgkmcnt(0)" ::: "memory"); SBAR();
#define PK(L, H) (bf16x8){L[0], L[1], L[2], L[3], H[0], H[1], H[2], H[3]}
    od = __builtin_amdgcn_mfma_f32_32x32x16_bf16(pa0, PK(l0, h0), od, 0, 0, 0);
    od = __builtin_amdgcn_mfma_f32_32x32x16_bf16(pa1, PK(l1, h1), od, 0, 0, 0);
    od = __builtin_amdgcn_mfma_f32_32x32x16_bf16(pa2, PK(l2, h2), od, 0, 0, 0);
    od = __builtin_amdgcn_mfma_f32_32x32x16_bf16(pa3, PK(l3, h3), od, 0, 0, 0);
#undef PK
}
__device__ __forceinline__ void pv_d0(f32x16* o, int vb, bf16x8 pa0, bf16x8 pa1, bf16x8 pa2, bf16x8 pa3) {
    pv_one<0>(o[0], vb, pa0, pa1, pa2, pa3); pv_one<1>(o[1], vb, pa0, pa1, pa2, pa3); pv_one<2>(o[2], vb, pa0, pa1, pa2, pa3); pv_one<3>(o[3], vb, pa0, pa1, pa2, pa3);
}

template <bool MINI>
__device__ __forceinline__ void attn_unit(int b, int h, int qrow0, int x0, int nx, bool has_meta, const bf16_t* __restrict__ qb, const bf16_t* __restrict__ kvb, const bf16_t* __restrict__ kpe,
                                          bf16_t* __restrict__ mix, float* __restrict__ part, float* __restrict__ psq_att, LAS char* lds, int tid) {
    const int wid = tid >> 6, lane = tid & 63, r32 = lane & 31, hi = lane >> 5;
    LAS char* V_lds = lds + V_OFF; LAS char* Kn_lds = lds + KN_OFF; LAS char* Kp_lds = lds + KP_OFF;
    LAS float* wsf = (LAS float*)(lds + WS_OFF) + wid * 64; LAS float* li_l = wsf; LAS float* al_l = wsf + 32;
    float m_reg = -1e30f, l_reg = 0; f32x16 o[4] = {}; bf16x8 qr[6];
    LAS char* qrl = lds + QR_OFF + wid * (NQL * 1024) + lane * 16;
    const int krow = tid >> 4, kcol = (((tid & 15) ^ (krow & 7)) * 8);
    const int vk0 = (tid >> 7) * 8 + ((tid & 31) >> 2), vc = ((tid >> 5) & 3) * 32 + (tid & 3) * 8;
    const int vkk1 = vk0 + 32, vka = (vk0 & ~0xC) | ((vk0 & 4) << 1) | ((vk0 & 8) >> 1), vkb = (vkk1 & ~0xC) | ((vkk1 & 4) << 1) | ((vkk1 & 8) >> 1);
    const int prow = tid >> 3, pcol = (((tid & 7) ^ ((prow >> 1) & 7)) * 8);
    const int vb0 = (int)(uintptr_t)V_lds + v_rd_base(lane);
    const int NT = nx + (has_meta ? 1 : 0);
    const bf16_t* kvh = kvb + h * 256;
    const unsigned ldsw = (unsigned)__builtin_amdgcn_readfirstlane(wid) * 1024u;
#define TILE_ID(i) ((i) < nx ? x0 + (i) : 32)
#define GLDS(src, dst) __builtin_amdgcn_global_load_lds((const unsigned*)(src), (LAS unsigned*)(dst), 16, 0, 0)
#define SLOAD(i, bf, vbf) do { const int _t = TILE_ID(i); const size_t _kb = _t < 32 ? (size_t)b * SEQ + 64 * _t : (size_t)MX + NMETA * b; \
    GLDS(kvh + (_kb + krow) * 2048 + kcol, Kn_lds + (bf) * SHM_K + ldsw); GLDS(kvh + (_kb + 32 + krow) * 2048 + kcol, Kn_lds + (bf) * SHM_K + 8192 + ldsw); \
    GLDS(kvh + (_kb + vka) * 2048 + 128 + vc, V_lds + (vbf) * SHM_V + ldsw); GLDS(kvh + (_kb + vkb) * 2048 + 128 + vc, V_lds + (vbf) * SHM_V + 8192 + ldsw); \
    GLDS(kpe + (_kb + prow) * 64 + pcol, Kp_lds + (bf) * SHM_P + ldsw); } while (0)
#define RESC(a) do { if (__any((a) < 1.f)) { if (hi == 0) al_l[r32] = (a); asm volatile("s_waitcnt lgkmcnt(0)" ::: "memory"); \
    _Pragma("unroll") for (int d = 0; d < 4; ++d) _Pragma("unroll") for (int r = 0; r < 16; ++r) o[d][r] *= al_l[crow(r, hi)]; } } while (0)
    f32x16 pA0, pA1; float mnA, alA; bf16x8 pa0 = {}, pa1 = {}, pa2 = {}, pa3 = {};
    const bool lag = wid >= 4;
    const bool act = !MINI || wid == 0;
    SLOAD(0, 0, 0);
    { const int qrow = MINI ? qrow0 + (r32 & 15) : qrow0 + wid * 32 + r32; const bf16_t* Qw = qb + (size_t)qrow * 1536 + h * DQK + hi * 8;
#pragma unroll
      for (int d0 = 0; d0 < 6; ++d0) qr[d0] = *(const bf16x8*)(Qw + d0 * 16);
#pragma unroll
      for (int d0 = 0; d0 < 4; ++d0) *(LAS bf16x8*)(qrl + d0 * 1024) = *(const bf16x8*)(Qw + (8 + d0) * 16);
      *(LAS bf16x8*)(qrl + 4 * 1024) = *(const bf16x8*)(Qw + 7 * 16); *(LAS bf16x8*)(qrl + 5 * 1024) = *(const bf16x8*)(Qw + 6 * 16); }
    VM_WAIT(); __syncthreads();
    int vcur = 0, vprev = 2;
    for (int i = 0; i < NT; ++i) {
        const int bf = i & 1; const bool more = (i + 1 < NT); const int vnext = vcur == 2 ? 0 : vcur + 1;
        if (more) SLOAD(i + 1, bf ^ 1, vnext);
        if (act) {
        if (lag && i > 0) { SBAR(); pv_d0(o, vb0 + vprev * SHM_V, pa0, pa1, pa2, pa3); }
        SBAR(); qkt(pA0, pA1, Kn_lds + bf * SHM_K, Kp_lds + bf * SHM_P, qr, qrl, r32, hi, TILE_ID(i) == 32);
        partialSM(pA0, pA1, m_reg, mnA, alA);
        RESC(alA);
        finishSM(pA0, pA1, alA, l_reg, pa0, pa1, pa2, pa3); SBAR();
        if (!lag) pv_d0(o, vb0 + vcur * SHM_V, pa0, pa1, pa2, pa3);
        }
        VM_WAIT();
        __syncthreads();
        vprev = vcur; vcur = vnext;
    }
    if (lag && act) pv_d0(o, vb0 + vprev * SHM_V, pa0, pa1, pa2, pa3);
    __syncthreads();
    if constexpr (!MINI) {
        if (hi == 0) li_l[r32] = l_reg; asm volatile("s_waitcnt lgkmcnt(0)" ::: "memory");
        float rli[16];
#pragma unroll
        for (int r = 0; r < 16; ++r) rli[r] = fast_rcp(li_l[crow(r, hi)]);
        LAS char* ost = lds + wid * 8192;
#pragma unroll
        for (int r = 0; r < 16; ++r)
#pragma unroll
            for (int d0 = 0; d0 < 4; ++d0) *(LAS unsigned short*)(ost + crow(r, hi) * 256 + (d0 * 32 + r32) * 2) = (unsigned short)(cvt_pk_bf16(o[d0][r] * rli[r], 0.f) & 0xffffu);
        asm volatile("s_waitcnt lgkmcnt(0)" ::: "memory");
        bf16_t* Ob = mix + (size_t)(qrow0 + wid * 32) * 2048 + h * DV;
        float* psq = psq_att; asm volatile("" : "+s"(psq));
#pragma unroll
        for (int i = 0; i < 8; ++i) { const int ch = i * 64 + lane, rw = ch >> 4, cp = ch & 15; const u32x4 ov = *(const LAS u32x4*)(ost + rw * 256 + cp * 16);
            *(u32x4*)(Ob + (size_t)rw * 2048 + cp * 8) = ov;
            float ss = (bflo(ov.x) * bflo(ov.x) + bfhi(ov.x) * bfhi(ov.x)) + (bflo(ov.y) * bflo(ov.y) + bfhi(ov.y) * bfhi(ov.y)) + (bflo(ov.z) * bflo(ov.z) + bfhi(ov.z) * bfhi(ov.z)) + (bflo(ov.w) * bflo(ov.w) + bfhi(ov.w) * bfhi(ov.w));
            ss += __shfl_xor(ss, 1); ss += __shfl_xor(ss, 2); ss += __shfl_xor(ss, 4); ss += __shfl_xor(ss, 8);
            if (cp == 0) psq[(size_t)(qrow0 + wid * 32 + rw) * 8 + h] = ss; }
        __syncthreads();
    } else {
        asm volatile("" :: "v"(o[0]), "v"(o[1]), "v"(o[2]), "v"(o[3]));
        if (wid == 0) {
#pragma unroll
            for (int r = 0; r < 8; ++r)
#pragma unroll
                for (int d0 = 0; d0 < 4; ++d0) __hip_atomic_store(part + crow(r, hi) * 128 + d0 * 32 + r32, o[d0][r], __ATOMIC_RELAXED, __HIP_MEMORY_SCOPE_AGENT);
            if (lane < 16) { __hip_atomic_store(part + 16 * 128 + lane, m_reg, __ATOMIC_RELAXED, __HIP_MEMORY_SCOPE_AGENT); __hip_atomic_store(part + 16 * 128 + 16 + lane, l_reg, __ATOMIC_RELAXED, __HIP_MEMORY_SCOPE_AGENT); }
        }
        __syncthreads();
    }
#undef TILE_ID
#undef SLOAD
#undef GLDS
#undef RESC
}
__device__ __forceinline__ void meta_merge(int b, int h, const float* apart, bf16_t* mix, float* psq_att, int wid, int lane) {
    const float* p0 = (const float*)((const char*)apart + (size_t)((b * NH + h) * 8) * APART_STRIDE);
    float ml[2][NMINI], ll[2][NMINI]; unsigned long long ov[2][NMINI];
#pragma unroll
    for (int j = 0; j < 2; ++j)
#pragma unroll
        for (int e = 0; e < NMINI; ++e) { const float* pe = (const float*)((const char*)p0 + (size_t)e * APART_STRIDE); const int i = 2 * wid + j;
            ml[j][e] = __hip_atomic_load(pe + 16 * 128 + i, __ATOMIC_RELAXED, __HIP_MEMORY_SCOPE_AGENT); ll[j][e] = __hip_atomic_load(pe + 16 * 128 + 16 + i, __ATOMIC_RELAXED, __HIP_MEMORY_SCOPE_AGENT);
            ov[j][e] = __hip_atomic_load((const unsigned long long*)(pe + i * 128 + 2 * lane), __ATOMIC_RELAXED, __HIP_MEMORY_SCOPE_AGENT); }
#pragma unroll
    for (int j = 0; j < 2; ++j) { float m = -1e30f;
#pragma unroll
        for (int e = 0; e < NMINI; ++e) m = fmaxf(m, ml[j][e]);
        float L = 0.f, o0 = 0.f, o1 = 0.f;
#pragma unroll
        for (int e = 0; e < NMINI; ++e) { const float w = fast_exp2(ml[j][e] - m); L += w * ll[j][e]; o0 += w * __uint_as_float((unsigned)ov[j][e]); o1 += w * __uint_as_float((unsigned)(ov[j][e] >> 32)); }
        const float rl = 1.0f / L; const unsigned pk = cvt_pk_bf16(o0 * rl, o1 * rl); const int row = MX + NMETA * b + 2 * wid + j;
        *(unsigned*)(mix + (size_t)row * 2048 + h * DV + 2 * lane) = pk;
        const float ss = wave_sum(bflo(pk) * bflo(pk) + bfhi(pk) * bfhi(pk)); if (lane == 0) psq_att[(size_t)row * 8 + h] = ss; }
}
__device__ __forceinline__ void attn_phase(const bf16_t* qb, const bf16_t* kvb, const bf16_t* kpe, bf16_t* mix, float* apart, float* psq_att, unsigned* tkt, LAS char* lds, int tid, int G, bool minis) {
    for (int u0 = blockIdx.x; u0 < 256; u0 += G) { const int u = (G == 256) ? ((u0 & 7) << 5) | (u0 >> 3) : u0;
        const int bh = u >> 3, qblk = u & 7, b = bh >> 3, h = bh & 7;
        attn_unit<false>(b, h, b * SEQ + 256 * qblk, 0, 32, true, qb, kvb, kpe, mix, nullptr, psq_att, lds, tid); }
    const int nglu = (MP / 256) * (SSMW / 256), first = G > nglu ? nglu : 0, nw = G - first;
    if (minis && (int)blockIdx.x >= first)
        for (int v = (int)blockIdx.x - first; v < 32 * NMINI; v += nw) { const int bh = v / NMINI, e = v - bh * NMINI, b = bh >> 3, h = bh & 7;
            const int x0 = e == 0 ? 0 : (e <= 5 ? 5 * e - 1 : 24 + 4 * (e - 5)), nx = (e == 0 || e >= 5) ? 4 : 5;
            attn_unit<true>(b, h, MX + NMETA * b, x0, nx, e == 0, qb, kvb, kpe, nullptr, (float*)((char*)apart + (size_t)(bh * 8 + e) * APART_STRIDE), nullptr, lds, tid);
            LAS unsigned* flag = (LAS unsigned*)(lds + MISC_OFF + 80);
            if (tid == 0) { VM_WAIT(); *flag = atomicAdd(tkt + bh * 16, 1u); }
            __syncthreads();
            if (*flag == NMINI - 1) meta_merge(b, h, apart, mix, psq_att, tid >> 6, tid & 63); }
}
#undef KSWZ
#undef KPSWZ
#undef SBAR
}

template <class Sched>
__device__ __forceinline__ void outnorm_scales(const Sched& S, const float* psq, float* scl, int nr, int tid) {
    for (int i = 0; ; ++i) { pg8::Unit u; if (!S.next(i, u)) break;
        const int row = u.pm * 256 + tid;
        if (tid < 256 && row < nr) {
            const f32x4 a0 = *(const f32x4*)(psq + (size_t)row * 8), a1 = *(const f32x4*)(psq + (size_t)row * 8 + 4);
            const float* ps = psq + (size_t)MP * 8 + (size_t)row * 16;
            const f32x4 s0 = *(const f32x4*)ps, s1 = *(const f32x4*)(ps + 4), s2 = *(const f32x4*)(ps + 8), s3 = *(const f32x4*)(ps + 12);
            const f32x4 sa = a0 + a1, sv = (s0 + s1) + (s2 + s3);
            const float ra = 1.0f / sqrtf(((sa[0] + sa[1]) + (sa[2] + sa[3])) * (1.0f / ATTW) + EPS), rs = 1.0f / sqrtf(((sv[0] + sv[1]) + (sv[2] + sv[3])) * (1.0f / SSMW) + EPS);
            scl[row] = ra / rs; scl[MP + row] = rs; } }
    VM_WAIT(); __syncthreads();
}


template <int N>
__device__ __forceinline__ float psq_sum(const float* p) {
    f32x4 v[N / 4];
#pragma unroll
    for (int j = 0; j < N / 4; ++j) v[j] = *(const f32x4*)(p + 4 * j);
    f32x4 a = v[0];
#pragma unroll
    for (int j = 1; j < N / 4; ++j) a += v[j];
    return (a[0] + a[1]) + (a[2] + a[3]);
}
template <int LO, int HI>
__device__ __forceinline__ f32x4 slab_sum_range(const float* slab, int r, int N, int c) {
    f32x4 v[HI - LO];
#pragma unroll
    for (int s = LO; s < HI; ++s) v[s - LO] = *(const f32x4*)(slab + ((size_t)s * 64 + r) * N + c);
    f32x4 a = v[0];
#pragma unroll
    for (int s = 1; s < HI - LO; ++s) a += v[s];
    return a;
}
template <int NS>
__device__ __forceinline__ f32x4 slab_sum(const float* slab, int r, int N, int c) {
    f32x4 v[NS];
#pragma unroll
    for (int s = 0; s < NS; ++s) v[s] = *(const f32x4*)(slab + ((size_t)s * 64 + r) * N + c);
    f32x4 a = v[0];
#pragma unroll
    for (int s = 1; s < NS; ++s) a += v[s];
    return a;
}
template <int NS>
__device__ __forceinline__ void tail_res_ffn_phase(float* h, bf16_t* hb, const float* psq, float* rs, const float* slab, const float* scl, int tid, int G) {
    const int lane = tid & 63, gw = blockIdx.x * NWAVES + (tid >> 6), ngw = G * NWAVES;
    constexpr float C = 1.0f / (F8_HS * F8_WGU);
    for (int r = ngw - 1 - gw; r < 64; r += ngw) { float ss = 0.f; const float rs_ = scl[MP + MX + r]; const f32x2 sc2 = {scl[MX + r] * rs_, rs_};
#pragma unroll 2
        for (int j = 0; j < 8; ++j) { const int c = j * 256 + 4 * lane; const size_t off = (size_t)(MX + r) * DM + c;
            const f32x4 v = *(const f32x4*)(h + off) + slab_sum_range<0, NS / 2>(slab, r, DM, c) * sc2.x + slab_sum_range<NS / 2, NS>(slab, r, DM, c) * sc2.y;
            *(f32x4*)(h + off) = v; *(unsigned*)((unsigned char*)hb + off) = pk4_fp8(v[0] * F8_HS, v[1] * F8_HS, v[2] * F8_HS, v[3] * F8_HS);
            ss += (v[0] * v[0] + v[1] * v[1]) + (v[2] * v[2] + v[3] * v[3]); }
        ss = wave_sum(ss); if (lane == 0) rs[MX + r] = C * __builtin_amdgcn_rsqf(ss * (1.0f / DM) + EPS); }
    for (int row = gw * 64 + lane; row < MP; row += ngw * 64)
        if (row < MX || row >= MREAL) rs[row] = row < MX ? C * __builtin_amdgcn_rsqf(psq_sum<32>(psq + (size_t)row * 32) * (1.0f / DM) + EPS) : 0.f;
}
template <bool F8OUT, int NS>
__device__ __forceinline__ void tail_res_phase(float* h, bf16_t* hb, ssq_t* ssq, const float* psq, const float* slab, float sc, int tid, int G) {
    const int lane = tid & 63, gw = blockIdx.x * NWAVES + (tid >> 6), ngw = G * NWAVES;
    for (int row = (ngw - 1 - gw) * 64 + lane; row < MX; row += ngw * 64) ssq[row] = ssq_fix(psq_sum<32>(psq + (size_t)row * 32));
    for (int w = gw; w < 64 * 8; w += ngw) { const int r = w >> 3, c = (w & 7) * 256 + 4 * lane; const size_t off = (size_t)(MX + r) * DM + c;
        const f32x4 v = *(const f32x4*)(h + off) + slab_sum<NS>(slab, r, DM, c) * sc;
        *(f32x4*)(h + off) = v;
        if constexpr (F8OUT) *(unsigned*)((unsigned char*)hb + off) = pk4_fp8(v[0] * F8_HS, v[1] * F8_HS, v[2] * F8_HS, v[3] * F8_HS);
        else { u32x2 pk; pk.x = cvt_pk_bf16(v[0], v[1]); pk.y = cvt_pk_bf16(v[2], v[3]); *(u32x2*)(hb + off) = pk; }
        const float ss = wave_sum((v[0] * v[0] + v[1] * v[1]) + (v[2] * v[2] + v[3] * v[3])); if (lane == 0) atomicAdd(ssq + MX + r, ssq_fix(ss)); }
}
template <int NS>
__device__ __forceinline__ void tail_g1_phase(bf16_t* proj, bf16_t* kpe, const ssq_t* ssq_h, ssq_t* ssq_cq, ssq_t* ssq_ckv, const float* psq, const float* cosb, const float* sinb, const float* slab, int tid, int G) {
    const int lane = tid & 63, gw = blockIdx.x * NWAVES + (tid >> 6), ngw = G * NWAVES;
    for (int row = (ngw - 1 - gw) * 64 + lane; row < MX; row += ngw * 64) {
        ssq_cq[row] = ssq_fix(psq_sum<8>(psq + (size_t)row * 12)); ssq_ckv[row] = ssq_fix(psq_sum<4>(psq + (size_t)row * 12 + 8)); }
    for (int w = gw; w < 64 * 8; w += ngw) { const int r = w >> 3, pn = w & 7, c = pn * 256 + 4 * lane, row = MX + r;
        const float rr = 1.0f / sqrtf(ssq_get(ssq_h, row) * (1.0f / DM) + EPS);
        const f32x4 v = slab_sum<NS>(slab, r, PROJW, c) * rr;
        if (pn == 3) {
            if (lane < 16) { const int pos = row_pos(row), i0 = 2 * lane; const f32x2 cc = *(const f32x2*)(cosb + pos * 32 + i0), sn = *(const f32x2*)(sinb + pos * 32 + i0);
                u32x2 pk; pk.x = cvt_pk_bf16(v[0] * cc.x - v[1] * sn.x, v[0] * sn.x + v[1] * cc.x); pk.y = cvt_pk_bf16(v[2] * cc.y - v[3] * sn.y, v[2] * sn.y + v[3] * cc.y);
                *(u32x2*)(kpe + (size_t)row * 64 + 4 * lane) = pk; }
        } else {
            u32x2 pk; pk.x = cvt_pk_bf16(v[0], v[1]); pk.y = cvt_pk_bf16(v[2], v[3]); *(u32x2*)(proj + (size_t)row * PROJW + c) = pk;
            if (pn < 3) { const float ss = wave_sum((v[0] * v[0] + v[1] * v[1]) + (v[2] * v[2] + v[3] * v[3])); if (lane == 0) atomicAdd((pn < 2 ? ssq_cq : ssq_ckv) + row, ssq_fix(ss)); }
        }
    }
}

struct Route { int e0, e1, s0, s1; float w0, w1, r, pad; };
template <int NS>
__device__ __forceinline__ void router_phase(float* h, bf16_t* hb, const float* slab, const float* scl, const float* wr, const float* gain, Route* route, unsigned* cnt, unsigned char* xp8, unsigned char* mact8, float* rperm, float* gperm, int nrows, LAS unsigned char* lds, int tid, int G) {
    const int lane = tid & 63, gw = blockIdx.x * NWAVES + (tid >> 6), ngw = G * NWAVES;
    { unsigned zz = 0u; asm volatile("" : "+v"(zz));
      for (int i = gw * 8 + (lane >> 3); i < MOE_ROWS; i += ngw * 8) *(u32x4*)(mact8 + (size_t)i * DFEP + DFE + 16 * (lane & 7)) = (u32x4){zz, zz, zz, zz}; }
    f32x4 nx[8];
#pragma unroll
    for (int j = 0; j < 8; ++j) nx[j] = *(const f32x4*)(h + (size_t)(gw < nrows ? gw : 0) * DM + 4 * lane + 256 * j);
    LAS float* wl = (LAS float*)lds;
    for (int i0 = tid; i0 < DM * NE; i0 += NTHR * 8) { float a[8], g[8];
#pragma unroll
        for (int u = 0; u < 8; ++u) { const int i = i0 + u * NTHR; a[u] = wr[i]; g[u] = gain[i >> 3]; }
#pragma unroll
        for (int u = 0; u < 8; ++u) { const int i = i0 + u * NTHR; wl[(i & 7) * DM + (i >> 3)] = a[u] * g[u]; } }
    __syncthreads();
    for (int row = gw; row < nrows; row += ngw) {
        float lg[NE] = {0.f, 0.f, 0.f, 0.f, 0.f, 0.f, 0.f, 0.f}; float ss = 0.f;
        f32x4 hv[8];
#pragma unroll
        for (int j = 0; j < 8; ++j) hv[j] = nx[j];
        { const int nrow = row + ngw < nrows ? row + ngw : row;
#pragma unroll
          for (int j = 0; j < 8; ++j) nx[j] = *(const f32x4*)(h + (size_t)nrow * DM + 4 * lane + 256 * j); }
        if (row >= MX) {
            const float rs_ = scl[MP + row]; const f32x2 sc2 = {scl[row] * rs_, rs_};
#pragma unroll
            for (int hf = 0; hf < 4; ++hf) { f32x4 sl[2];
#pragma unroll
                for (int j = 0; j < 2; ++j) sl[j] = slab_sum_range<0, NS / 2>(slab, row - MX, DM, 4 * lane + 256 * (2 * hf + j)) * sc2.x + slab_sum_range<NS / 2, NS>(slab, row - MX, DM, 4 * lane + 256 * (2 * hf + j)) * sc2.y;
#pragma unroll
                for (int j = 0; j < 2; ++j) hv[2 * hf + j] += sl[j];
                asm volatile("" : "+v"(hv[2 * hf]), "+v"(hv[2 * hf + 1])); }
#pragma unroll
            for (int j = 0; j < 8; ++j) { const int c = 4 * lane + 256 * j; *(f32x4*)(h + (size_t)row * DM + c) = hv[j]; }
        }
#pragma unroll
        for (int j = 0; j < 8; ++j) { const int c = 4 * lane + 256 * j; const f32x4 x = hv[j];
            ss += (x[0] * x[0] + x[1] * x[1]) + (x[2] * x[2] + x[3] * x[3]);
#pragma unroll
            for (int e = 0; e < NE; ++e) { const f32x4 w = *(const LAS f32x4*)(wl + e * DM + c); lg[e] += (x[0] * w[0] + x[1] * w[1]) + (x[2] * w[2] + x[3] * w[3]); } }
        ss = wave_sum(ss);
#pragma unroll
        for (int e = 0; e < NE; ++e) lg[e] = wave_sum(lg[e]);
        const float r = 1.0f / sqrtf(ss * (1.0f / DM) + EPS);
        {
            int e0 = 0; float v0 = lg[0];
#pragma unroll
            for (int e = 1; e < NE; ++e) if (lg[e] > v0) { v0 = lg[e]; e0 = e; }
            int e1 = -1; float v1 = -3.0e38f;
#pragma unroll
            for (int e = 0; e < NE; ++e) if (e != e0 && lg[e] > v1) { v1 = lg[e]; e1 = e; }
            const float w1 = 1.0f / (1.0f + expf((v0 - v1) * r)), w0 = 1.0f - w1;
            int s0 = 0, s1 = 0;
            if (lane == 0) { s0 = (int)atomicAdd(cnt + 64 * e0, 1u); s1 = (int)atomicAdd(cnt + 64 * e1, 1u); }
            s0 = __builtin_amdgcn_readfirstlane(s0); s1 = __builtin_amdgcn_readfirstlane(s1);
            const size_t d0 = (size_t)e0 * MP + s0, d1 = (size_t)e1 * MP + s1;
            if (lane == 0) { Route rt; rt.e0 = e0; rt.e1 = e1; rt.s0 = s0; rt.s1 = s1; rt.w0 = w0; rt.w1 = w1; rt.r = r; rt.pad = 0.f; route[row] = rt;
                rperm[d0] = r * (1.0f / (F8_HS * F8_WGU)); rperm[d1] = r * (1.0f / (F8_HS * F8_WGU)); gperm[d0] = w0; gperm[d1] = w1; }
#pragma unroll
            for (int j = 0; j < 8; ++j) { const int c = 4 * lane + 256 * j; const unsigned pk = pk4_fp8(hv[j][0] * F8_HS, hv[j][1] * F8_HS, hv[j][2] * F8_HS, hv[j][3] * F8_HS);
                *(unsigned*)(xp8 + d0 * DM + c) = pk; *(unsigned*)(xp8 + d1 * DM + c) = pk; }
        }
    }
    __syncthreads();
}
__device__ __forceinline__ void moe_counts(const unsigned* cnt, int (&cv)[NE]) {
    unsigned t[NE];
#pragma unroll
    for (int e = 0; e < NE; ++e) t[e] = cnt[64 * e];
#pragma unroll
    for (int e = 0; e < NE; ++e) cv[e] = __builtin_amdgcn_readfirstlane((int)t[e]);
}
__device__ __forceinline__ void moe_prefix(const unsigned* cnt, int (&pfx)[NE + 1]) {
    int cv[NE]; moe_counts(cnt, cv);
    pfx[0] = 0;
#pragma unroll
    for (int e = 0; e < NE; ++e) pfx[e + 1] = pfx[e] + ((cv[e] + 255) >> 8);
}
__device__ __forceinline__ void moe_prefix_put(LAS unsigned char* lds, const int (&pfx)[NE + 1], int tid) {
    if (tid == 0) {
#pragma unroll
        for (int e = 0; e <= NE; ++e) *(LAS int*)(lds + MISC_OFF + 40 + 4 * e) = pfx[e]; } }
__device__ __forceinline__ void moe_prefix_get(LAS unsigned char* lds, int (&pfx)[NE + 1]) {
    int t[NE + 1];
#pragma unroll
    for (int e = 0; e <= NE; ++e) t[e] = *(const LAS int*)(lds + MISC_OFF + 40 + 4 * e);
#pragma unroll
    for (int e = 0; e <= NE; ++e) pfx[e] = __builtin_amdgcn_readfirstlane(t[e]); }
__device__ __forceinline__ void permute_phase(const bf16_t* hb, const Route* route, const unsigned* cnt, bf16_t* xperm, unsigned char* mact8, float* rperm, float* gperm, int nrows, int tid, int G) {
    const int lane = tid & 63, gw = blockIdx.x * NWAVES + (tid >> 6), ngw = G * NWAVES;
    int pfx[NE + 1]; moe_prefix(cnt, pfx);
    { unsigned zz = 0u; asm volatile("" : "+v"(zz));
      for (int i = gw * 8 + (lane >> 3); i < pfx[NE] * 256; i += ngw * 8) *(u32x4*)(mact8 + (size_t)i * DFEP + DFE + 16 * (lane & 7)) = (u32x4){zz, zz, zz, zz}; }
    const unsigned char* hb8 = (const unsigned char*)hb; unsigned char* xp8 = (unsigned char*)xperm;
    Route nrt = route[gw < nrows ? gw : 0]; u32x4 nv[2];
#pragma unroll
    for (int j = 0; j < 2; ++j) nv[j] = *(const u32x4*)(hb8 + (size_t)(gw < nrows ? gw : 0) * DM + 1024 * j + 16 * lane);
    for (int row = gw; row < nrows; row += ngw) {
        const Route rt = nrt; u32x4 v[2] = {nv[0], nv[1]};
        const int nrow = row + ngw < nrows ? row + ngw : row;
        nrt = route[nrow];
#pragma unroll
        for (int j = 0; j < 2; ++j) nv[j] = *(const u32x4*)(hb8 + (size_t)nrow * DM + 1024 * j + 16 * lane);
#pragma unroll
        for (int k = 0; k < 2; ++k) { const int e = k ? rt.e1 : rt.e0, s = k ? rt.s1 : rt.s0; const size_t dst = (size_t)pfx[e] * 256 + s;
#pragma unroll
            for (int j = 0; j < 2; ++j) *(u32x4*)(xp8 + dst * DM + 1024 * j + 16 * lane) = v[j];
            if (lane == 0) { rperm[dst] = rt.r * (1.0f / (F8_HS * F8_WGU)); gperm[dst] = k ? rt.w1 : rt.w0; } }
    }
    int cv[NE]; moe_counts(cnt, cv);
    for (int e = 0; e < NE; ++e) { const int c = cv[e]; const int npad = (pfx[e + 1] - pfx[e]) * 256 - c;
        for (int i = gw; i < npad; i += ngw) { const size_t dst = (size_t)pfx[e] * 256 + c + i;
#pragma unroll
            for (int j = 0; j < 2; ++j) *(u32x4*)((unsigned char*)xperm + dst * DM + 1024 * j + 16 * lane) = (u32x4){0u, 0u, 0u, 0u};
            if (lane == 0) { rperm[dst] = 0.f; gperm[dst] = 0.f; } } }
}
template <bool LAST>
__device__ __forceinline__ void combine_phase(float* h, bf16_t* hb, ssq_t* ssq, const bf16_t* y, const Route* route, LAS unsigned char* lds, const float* fnorm, float* out, int tid, int G) {
    const int lane = tid & 63, gw = blockIdx.x * NWAVES + (tid >> 6), ngw = G * NWAVES;
    int pfx[NE + 1]; moe_prefix_get(lds, pfx);
    constexpr int NR = LAST ? MX : MREAL;
    f32x4 fn[8];
#pragma unroll
    for (int j = 0; j < 8; ++j) fn[j] = LAST ? *(const f32x4*)(fnorm + 8 * lane + 512 * (j >> 1) + 4 * (j & 1)) : (f32x4){0.f, 0.f, 0.f, 0.f};
    Route nrt = route[gw + ngw < NR ? gw + ngw : (gw < NR ? gw : 0)];
    u32x4 nya[4], nyb[4]; f32x4 nh[8];
#define CMB_LD(r_, rt_) do { const size_t d0_ = ((size_t)pfx[(rt_).e0] * 256 + (rt_).s0) * DM, d1_ = ((size_t)pfx[(rt_).e1] * 256 + (rt_).s1) * DM; \
        _Pragma("unroll") for (int jj = 0; jj < 4; ++jj) { const int c_ = 8 * lane + 512 * jj; nya[jj] = *(const u32x4*)(y + d0_ + c_); nyb[jj] = *(const u32x4*)(y + d1_ + c_); \
            nh[2 * jj] = *(const f32x4*)(h + (size_t)(r_) * DM + c_); nh[2 * jj + 1] = *(const f32x4*)(h + (size_t)(r_) * DM + c_ + 4); } } while (0)
    { const int r0 = gw < NR ? gw : 0; const Route rt0 = route[r0]; CMB_LD(r0, rt0); }
    for (int row = gw; row < NR; row += ngw) {
        u32x4 cya[4], cyb[4]; f32x4 ch[8];
#pragma unroll
        for (int jj = 0; jj < 4; ++jj) { cya[jj] = nya[jj]; cyb[jj] = nyb[jj]; ch[2 * jj] = nh[2 * jj]; ch[2 * jj + 1] = nh[2 * jj + 1]; }
        { const int nrow = row + ngw < NR ? row + ngw : row; const Route rt = nrt; nrt = route[row + 2 * ngw < NR ? row + 2 * ngw : row]; CMB_LD(nrow, rt); }
        f32x4 v[8]; float ss = 0.f;
#pragma unroll
        for (int jj = 0; jj < 4; ++jj) { const int c = 8 * lane + 512 * jj; const u32x4 ya = cya[jj], yb = cyb[jj];
            v[2 * jj] = ch[2 * jj] + ((f32x4){bflo(ya.x), bfhi(ya.x), bflo(ya.y), bfhi(ya.y)} + (f32x4){bflo(yb.x), bfhi(yb.x), bflo(yb.y), bfhi(yb.y)});
            v[2 * jj + 1] = ch[2 * jj + 1] + ((f32x4){bflo(ya.z), bfhi(ya.z), bflo(ya.w), bfhi(ya.w)} + (f32x4){bflo(yb.z), bfhi(yb.z), bflo(yb.w), bfhi(yb.w)});
#pragma unroll
            for (int n = 0; n < 2; ++n) { const int j = 2 * jj + n; ss += (v[j][0] * v[j][0] + v[j][1] * v[j][1]) + (v[j][2] * v[j][2] + v[j][3] * v[j][3]); } }
        ss = wave_sum(ss);
        if constexpr (!LAST) {
#pragma unroll
            for (int jj = 0; jj < 4; ++jj) { const int c = 8 * lane + 512 * jj; *(f32x4*)(h + (size_t)row * DM + c) = v[2 * jj]; *(f32x4*)(h + (size_t)row * DM + c + 4) = v[2 * jj + 1];
                u32x4 w; w.x = cvt_pk_bf16(v[2 * jj][0], v[2 * jj][1]); w.y = cvt_pk_bf16(v[2 * jj][2], v[2 * jj][3]); w.z = cvt_pk_bf16(v[2 * jj + 1][0], v[2 * jj + 1][1]); w.w = cvt_pk_bf16(v[2 * jj + 1][2], v[2 * jj + 1][3]);
                *(u32x4*)(hb + (size_t)row * DM + c) = w; }
            if (lane == 0) ssq[row] = ssq_fix(ss);
        } else {
#if DBG
#pragma unroll
            for (int j = 0; j < 8; ++j) { const int c = 8 * lane + 512 * (j >> 1) + 4 * (j & 1); *(f32x4*)(h + (size_t)row * DM + c) = v[j]; }
#endif
            if (row < MX) { const float r = 1.0f / sqrtf(ss * (1.0f / DM) + EPS);
#pragma unroll
                for (int j = 0; j < 8; ++j) { const int c = 8 * lane + 512 * (j >> 1) + 4 * (j & 1); *(f32x4*)(out + (size_t)row * DM + c) = v[j] * r * fn[j]; } }
        }
    }
}

struct Args { Inputs in; float* out; unsigned char* ws; int ph_lo, ph_hi; };
__global__ void __launch_bounds__(NTHR, 2) fwd_kernel(Args args) {
    extern __shared__ __attribute__((aligned(16))) unsigned char lds_raw[];
    LAS unsigned char* lds = (LAS unsigned char*)lds_raw;
    volatile LAS unsigned* MISC = (volatile LAS unsigned*)(lds + MISC_OFF);
    const int tid = threadIdx.x, G = gridDim.x;
    unsigned char* ws = args.ws;
    unsigned* ctl = (unsigned*)(ws + WS_CTL);
    for (int u = tid; u < 32; u += NTHR) MISC[u] = 0u;
    __syncthreads();
    const int lo = args.ph_lo, hi = args.ph_hi;
    const bool multi = (hi - lo) > 1;
    XcdBarrier bar; bar.bar = ctl + CW_BAR; bar.x = 0; bar.st = MISC + 8;
    if (multi) bar = xcd_barrier_post(ctl + CW_BAR, MISC + 8);
#ifdef PH_ONLY
#define IN(k) ((((k) % 32) == PH_ONLY) && lo <= (k) && (k) < hi)
#else
#define IN(k) (lo <= (k) && (k) < hi)
#endif
#define SEAM(k) do { if (IN(k) && IN((k) + 1)) { xcd_barrier(bar); if (PROBE_REP & 128) xcd_barrier(bar); } } while (0)
#define SEAM2(k, k2) do { if (IN(k) && IN(k2)) { xcd_barrier(bar); if (PROBE_REP & 128) xcd_barrier(bar); } } while (0)
#define WSL ({ GAS unsigned char* _w = (GAS unsigned char*)ws; asm volatile("" : "+s"(_w)); _w; })
#define AS_GLOBAL(T, p) ((T)({ GAS void* _g = (GAS void*)(p); asm volatile("" : "+v"(_g)); _g; }))
#define DEFP unsigned char* wsl = (unsigned char*)WSL; const float* const* itab = (const float* const*)(wsl + WS_TAB); (void)itab; float* h = (float*)(wsl + WS_H); bf16_t* hb = (bf16_t*)(wsl + WS_HB); bf16_t* proj = (bf16_t*)(wsl + WS_PROJ); bf16_t* kpe = (bf16_t*)(wsl + WS_KPE); \
    bf16_t* qb = (bf16_t*)(wsl + WS_QB); bf16_t* kvb = (bf16_t*)(wsl + WS_KVB); bf16_t* mix = (bf16_t*)(wsl + WS_MIX); bf16_t* mixn = (bf16_t*)(wsl + WS_MIXN); \
    unsigned char* yp = wsl + WS_YP; bf16_t* gb = (bf16_t*)(wsl + WS_GB); float* apart = (float*)(wsl + WS_APART); \
    ssq_t* ssqb = (ssq_t*)(wsl + CTL_SSQ); const float* cosb = (const float*)(wsl + WS_ROPE); const float* sinb = cosb + LTOK * 32; \
    Route* route = (Route*)(wsl + WS_ROUTE); float* rperm = (float*)(wsl + WS_RPERM); float* gperm = (float*)(wsl + WS_GPERM); \
    bf16_t* act = (bf16_t*)(wsl + WS_BIG); bf16_t* xperm = (bf16_t*)(wsl + WS_XPERM); bf16_t* mact = (bf16_t*)(wsl + WS_MACT); bf16_t* yslot = (bf16_t*)(wsl + WS_YSLOT); float* slab = (float*)(wsl + WS_SLAB); (void)slab; \
    const unsigned char* wl = wsl + WS_W + (size_t)l * SZ_LAYER; const unsigned char* wd = wsl + WS_WFF + (size_t)(l >> 1) * SZ_DENSE; \
    const unsigned char* wm = wsl + WS_WFF + 2 * SZ_DENSE + (size_t)(l >> 1) * SZ_MOE; unsigned* cnt = (unsigned*)(wsl + WS_CTL) + CW_CNT + (l >> 1) * 1024; \
    (void)h; (void)hb; (void)proj; (void)kpe; (void)qb; (void)kvb; (void)mix; (void)mixn; (void)yp; (void)gb; (void)apart; (void)ssqb; (void)cosb; (void)sinb; (void)route; (void)rperm; (void)gperm; \
    (void)act; (void)xperm; (void)mact; (void)yslot; (void)wl; (void)wd; (void)wm; (void)cnt;
    const int c = (int)blockIdx.x;
    const int wid_s = __builtin_amdgcn_readfirstlane((int)threadIdx.x >> 6);
#define TIDL ({ unsigned _z = 0u; asm volatile("" : "+v"(_z)); int _t = (wid_s << 6) | (int)__builtin_amdgcn_mbcnt_hi(~0u, __builtin_amdgcn_mbcnt_lo(~0u, _z)); asm volatile("" : "+v"(_t)); _t; })

    if (IN(0)) {
        if (blockIdx.x == 0 && tid == 0) { const float** tab = (const float**)(ws + WS_TAB);
#pragma unroll
            for (int k = 0; k < 29; ++k) tab[k] = args.in.p[k];
            tab[29] = args.out; }
        prologue_phase(args.in, ws, lds, TIDL, G);
        if (PROBE_REP & 1) { __syncthreads(); prologue_phase(args.in, ws, lds, TIDL, G); }
    }
    SEAM(0);
    for (int l = 0; l < DEPTH; ++l) {
        const int P = 32 * l;
        if (IN(P + 1)) {
            DEFP
            pg8::SchedT S{hb, (const bf16_t*)(wl + OFF_WIN), DM, DM, 8, G, c, 256, 8};
            pg8::EpiG1 E{proj, kpe, ssqb + (size_t)SSQ_H1(l) * MP, ssqb + (size_t)SSQ_CQ(l) * MP, ssqb + (size_t)SSQ_CKV(l) * MP, cosb, sinb, slab, (float*)mix};
            pg8::gemm_phase<pg8::EpiG1, pg8::SchedT, true>(lds, S, E, TIDL);
            ffn_slot(l, 0, G, c, TIDL, itab, wsl, lds);
        }
        SEAM(P + 1);
        if (IN(P + 2)) { DEFP tail_g1_phase<8>(proj, kpe, ssqb + (size_t)SSQ_H1(l) * MP, ssqb + (size_t)SSQ_CQ(l) * MP, ssqb + (size_t)SSQ_CKV(l) * MP, (const float*)mix, cosb, sinb, slab, TIDL, G); }
        SEAM(P + 2);
        if (IN(P + 3)) {
            DEFP
            { pg8::Sched2D S{proj, (const bf16_t*)(wl + OFF_WUQ), PROJW, QL, MP / 256, 6, G, c};
              pg8::EpiQ E{qb, ssqb + (size_t)SSQ_CQ(l) * MP, cosb, sinb};
              pg8::gemm_phase<pg8::EpiQ, pg8::Sched2D, true>(lds, S, E, TIDL); }
            { pg8::Sched2D S{proj + QL, (const bf16_t*)(wl + OFF_WUKV), PROJW, KVL, MP / 256, 8, G, (c + 58) % G};
              pg8::EpiScaleBf16 E{kvb, 2048, ssqb + (size_t)SSQ_CKV(l) * MP, 1.0f / KVL};
              pg8::gemm_phase<pg8::EpiScaleBf16, pg8::Sched2D, true>(lds, S, E, TIDL); }
            s5_phase(wsl + WS_S5, proj, yp, gb, AS_GLOBAL(const float*, itab[15]) + (size_t)l * SSMW, l, lds, TIDL, G);
            ffn_slot(l, 5, G, c, TIDL, itab, wsl, lds);
            if (PROBE_REP & 4) s5_phase(wsl + WS_S5, proj, yp, gb, AS_GLOBAL(const float*, itab[15]) + (size_t)l * SSMW, l, lds, TIDL, G);
        }
        SEAM(P + 3);
        if (IN(P + 4)) {
            DEFP
            att::attn_phase(qb, kvb, kpe, mix, apart, (float*)proj, (unsigned*)(wsl + WS_CTL) + CW_TKT + l * 512, (LAS char*)lds, TIDL, G, l != DEPTH - 1);
            { pg8::Sched2D S{(const bf16_t*)yp, (const bf16_t*)(wl + OFF_WGLU), SSMW / 2, SSMW / 2, MP / 256, 4, G, c};
              pg8::EpiGlu E{gb, mix, (float*)proj + (size_t)MP * 8};
              pg8::gemm_phase<pg8::EpiGlu, pg8::Sched2D, true, true>(lds, S, E, TIDL); }
        }
        SEAM2(P + 4, P + 6);
#define nrows ({ int _n = l == DEPTH - 1 ? MX : MREAL; asm volatile("" : "+s"(_n)); _n; })
        if (IN(P + 6)) {
            DEFP
            const float* xin; { const unsigned long long xa = (unsigned long long)itab[0];
              xin = (const float*)(GAS const void*)(((unsigned long long)(unsigned)__builtin_amdgcn_readfirstlane((int)(xa >> 32)) << 32) | (unsigned)__builtin_amdgcn_readfirstlane((int)xa)); }
            pg8::SchedT S{mix, (const bf16_t*)(wl + OFF_WOUT), DM, DM, 8, G, c, 256, l == DEPTH - 1 ? 0 : 8};
            pg8::EpiRes<true, true> E{h, (l & 1) ? (bf16_t*)nullptr : hb, ssqb + (size_t)SSQ_H2(l) * MP, slab, 1.0f, (const float*)gb, l == 0 ? xin : (const float*)h, (float*)proj + (1 << 18), (const float*)proj, nrows};
            pg8::gemm_phase<pg8::EpiRes<true, true>, pg8::SchedT, true>(lds, S, E, TIDL);
            ffn_slot(l, 1, G, c, TIDL, itab, wsl, lds);
            if (PROBE_REP & 2048) { pg8::Sched2D S2{mixn, (const bf16_t*)(wl + OFF_WOUT), DM, DM, 32, 8, G, c}; pg8::EpiScaleBf16 E2{mix, 2048, ssqb + (size_t)SSQ_H2(l) * MP, 1.0f / DM}; pg8::gemm_phase<pg8::EpiScaleBf16, pg8::Sched2D, true>(lds, S2, E2, TIDL); }
        }
        if ((l & 1) == 0) {
            SEAM(P + 6);
            if (IN(P + 7)) { DEFP tail_res_ffn_phase<8>(h, hb, (const float*)proj + (1 << 18), rperm, slab, (const float*)gb, TIDL, G); }
            SEAM(P + 7);
            if (IN(P + 8)) {
                DEFP
                pg8::Sched2D S{hb, (const bf16_t*)wd, DM / 2, DM / 2, MP / 256, 2 * DFF / 256, G, c};
                pg8::EpiGU<true> E{act, DFF, rperm};
                pg8::gemm_phase<pg8::EpiGU<true>, pg8::Sched2D, true, true>(lds, S, E, TIDL);
                ffn_slot(l, 2, G, c, TIDL, itab, wsl, lds);
                if (PROBE_REP & 8) pg8::gemm_phase<pg8::EpiGU<true>, pg8::Sched2D, true, true>(lds, S, E, TIDL);
            }
            SEAM(P + 8);
            if (IN(P + 9)) {
                DEFP
                pg8::SchedT S{act, (const bf16_t*)(wd + SZ_DGU), DFF / 2, DFF / 2, 8, G, c, 256, 11};
                pg8::EpiRes<false> E{h, hb, ssqb + (size_t)SSQ_H1(l + 1) * MP, slab, 1.0f / (F8_AS * F8_WDN), nullptr, h, (float*)proj + (3 << 18), nullptr, 0};
                pg8::gemm_phase<pg8::EpiRes<false>, pg8::SchedT, true, true>(lds, S, E, TIDL);
                ffn_slot(l, 3, G, c, TIDL, itab, wsl, lds);
                if (PROBE_REP & 1024) { pg8::Sched2D S2{act, (const bf16_t*)(wd + SZ_DGU), DFF, DFF, 32, 8, G, c}; pg8::EpiScaleBf16 E2{mix, 2048, ssqb + (size_t)SSQ_H2(l) * MP, 1.0f / DM}; pg8::gemm_phase<pg8::EpiScaleBf16, pg8::Sched2D, true>(lds, S2, E2, TIDL); }
            }
            SEAM(P + 9);
            if (IN(P + 10)) { DEFP tail_res_phase<false, 11>(h, hb, ssqb + (size_t)SSQ_H1(l + 1) * MP, (const float*)proj + (3 << 18), slab, 1.0f / (F8_AS * F8_WDN), TIDL, G); }
            SEAM2(P + 10, P + 33);
        } else {
            SEAM2(P + 6, P + 16);
            if (IN(P + 16)) { DEFP router_phase<8>(h, hb, slab, (const float*)gb, AS_GLOBAL(const float*, itab[24]) + (size_t)(l >> 1) * DM * NE, AS_GLOBAL(const float*, itab[20]) + (size_t)l * DM, route, cnt, (unsigned char*)xperm, (unsigned char*)mact, rperm, gperm, nrows, lds, TIDL, G); }
            SEAM2(P + 16, P + 18);
            if (IN(P + 18)) {
                DEFP
                pg8::SchedMoE S; S.A = xperm; S.Bt0 = (const bf16_t*)wm; S.estride = SZ_EXP; S.lda = DM / 2; S.K = DM / 2; S.nN = 2 * DFE / 256; S.G = G; S.c = c; S.capA = 1; moe_prefix(cnt, S.pfx); moe_prefix_put(lds, S.pfx, TIDL);
                pg8::EpiGU<true> E{mact, DFEP, rperm};
                pg8::gemm_phase<pg8::EpiGU<true>, pg8::SchedMoE, true, true>(lds, S, E, TIDL);
                if (PROBE_REP & 32) pg8::gemm_phase<pg8::EpiGU<true>, pg8::SchedMoE, true, true>(lds, S, E, TIDL);
            }
            SEAM(P + 18);
            if (IN(P + 19)) {
                DEFP
                pg8::SchedMoE S; S.A = mact; S.Bt0 = (const bf16_t*)(wm + SZ_EGU); S.estride = SZ_EXP; S.lda = DFEP / 2; S.K = DFEP / 2; S.nN = 8; S.G = G; S.c = c; S.capA = 0; moe_prefix_get(lds, S.pfx);
                pg8::EpiMD E{yslot, gperm};
                pg8::gemm_phase<pg8::EpiMD, pg8::SchedMoE, true, true>(lds, S, E, TIDL);
                ffn_slot(l, 4, G, c, TIDL, itab, wsl, lds);
                if (PROBE_REP & 256) pg8::gemm_phase<pg8::EpiMD, pg8::SchedMoE, true, true>(lds, S, E, TIDL);
            }
            SEAM(P + 19);
            if (IN(P + 20)) {
                DEFP
                if (l == DEPTH - 1) combine_phase<true>(h, hb, nullptr, yslot, route, lds, AS_GLOBAL(const float*, itab[28]), AS_GLOBAL(float*, itab[29]), TIDL, G);
                else combine_phase<false>(h, hb, ssqb + (size_t)SSQ_H1(l + 1) * MP, yslot, route, lds, nullptr, nullptr, TIDL, G);
            }
            SEAM2(P + 20, P + 33);
        }
    }
#undef IN
#undef SEAM
#undef SEAM2
#undef nrows
}

#if DBG
namespace dbg {
__device__ __forceinline__ unsigned hsh(unsigned a, unsigned b) { unsigned x = a * 0x9E3779B1u ^ (b + 0x7F4A7C15u) * 0x85EBCA6Bu; x ^= x >> 15; x *= 0x2C1B3C6Du; x ^= x >> 12; x *= 0x297A2D39u; x ^= x >> 15; return x; }
__device__ __forceinline__ int pick_row(int s, unsigned salt) { const int sp[8] = {0, 2047, 2048, 8191, 8192, 8207, 8255, 4097}; return s < 8 ? sp[s] : (int)(hsh(s, salt) % MREAL); }
__device__ __forceinline__ void report(unsigned* et, int slot, float got, float ref, float rtol, float atol, int lane) {
    if (lane == 0) { float e = fabsf(got - ref) / (rtol * fabsf(ref) + atol); if (!(e == e) || !(got == got)) e = 1e30f; atomicMax(et + slot, __float_as_uint(e)); } }
template <class F> __device__ __forceinline__ float wdot(int K, int lane, F f) { float s = 0.f; for (int k = lane; k < K; k += 64) s += f(k); return wave_sum(s); }
__device__ __forceinline__ float rope_cos(int pos, int i) { return cosf((float)pos * powf(10000.0f, -(float)(2 * i) / 64.0f)); }
__device__ __forceinline__ float rope_sin(int pos, int i) { return sinf((float)pos * powf(10000.0f, -(float)(2 * i) / 64.0f)); }

__global__ void ck_g1(const float* h, const float* w_in, const float* gain, const bf16_t* proj, const bf16_t* kpe, unsigned* et, int slot) {
    const int s = blockIdx.x, lane = threadIdx.x, row = pick_row(s, 11); int j = hsh(s, 12) % INC; if (s & 1) j = 768 + hsh(s, 13) % 64;
    const float* hr = h + (size_t)row * DM;
    const float r = 1.0f / sqrtf(wdot(DM, lane, [&](int k) { return hr[k] * hr[k]; }) / DM + EPS);
    if (j >= 768 && j < 832) { const int i = (j - 768) & 31;
        const float x1 = r * wdot(DM, lane, [&](int k) { return hr[k] * gain[k] * w_in[(size_t)k * INC + 768 + i]; }), x2 = r * wdot(DM, lane, [&](int k) { return hr[k] * gain[k] * w_in[(size_t)k * INC + 800 + i]; });
        const int pos = row_pos(row); const float c = rope_cos(pos, i), sn = rope_sin(pos, i);
        report(et, slot, bf2f(kpe[(size_t)row * 64 + 2 * i]), x1 * c - x2 * sn, 0.02f, 0.02f, lane); report(et, slot, bf2f(kpe[(size_t)row * 64 + 2 * i + 1]), x1 * sn + x2 * c, 0.02f, 0.02f, lane);
    } else { const float ref = r * wdot(DM, lane, [&](int k) { return hr[k] * gain[k] * w_in[(size_t)k * INC + j]; });
        report(et, slot, bf2f(proj[(size_t)row * PROJW + (j < 768 ? j : 1024 + j - 832)]), ref, 0.02f, 0.02f, lane); }
}
__global__ void ck_g2(const bf16_t* proj, const float* w_uq, const float* qn, const float* w_ukv, const float* kvn, const bf16_t* qb, const bf16_t* kvb, unsigned* et, int slot) {
    const int s = blockIdx.x, lane = threadIdx.x, row = pick_row(s, 21); const bf16_t* pr = proj + (size_t)row * PROJW;
    if (s & 1) {
        const int c = hsh(s, 22) % 1536, hd = c / DQK, d = c % DQK;
        const float r = 1.0f / sqrtf(wdot(QL, lane, [&](int k) { const float v = bf2f(pr[k]); return v * v; }) / QL + EPS);
        float ref;
        if (d < DNOPE) ref = r * wdot(QL, lane, [&](int k) { return bf2f(pr[k]) * qn[k] * w_uq[(size_t)k * 1536 + c]; });
        else { const int i = (d - DNOPE) >> 1, wh = (d - DNOPE) & 1;
            const float x1 = r * wdot(QL, lane, [&](int k) { return bf2f(pr[k]) * qn[k] * w_uq[(size_t)k * 1536 + hd * DQK + DNOPE + i]; }), x2 = r * wdot(QL, lane, [&](int k) { return bf2f(pr[k]) * qn[k] * w_uq[(size_t)k * 1536 + hd * DQK + DNOPE + 32 + i]; });
            const int pos = row_pos(row); const float cc = rope_cos(pos, i), sn = rope_sin(pos, i); ref = wh ? x1 * sn + x2 * cc : x1 * cc - x2 * sn; }
        report(et, slot, bf2f(qb[(size_t)row * 1536 + c]), ref * CQ, 0.02f, 0.003f, lane);
    } else {
        const int c = hsh(s, 23) % 2048;
        const float r = 1.0f / sqrtf(wdot(KVL, lane, [&](int k) { const float v = bf2f(pr[QL + k]); return v * v; }) / KVL + EPS);
        const float ref = r * wdot(KVL, lane, [&](int k) { return bf2f(pr[QL + k]) * kvn[k] * w_ukv[(size_t)k * 2048 + c]; });
        report(et, slot, bf2f(kvb[(size_t)row * 2048 + c]), ref, 0.02f, 0.02f, lane);
    }
}
__global__ void ck_att(const bf16_t* qb, const bf16_t* kvb, const bf16_t* kpe, const bf16_t* mix, unsigned* et, int slot, int meta) {
    const int s = blockIdx.x, lane = threadIdx.x, row = meta ? MX + (int)(hsh(s, 31) % 64) : (int)(hsh(s, 31) % MX), hd = hsh(s, 32) % NH, d = hsh(s, 33) % DV;
    const int b = row < MX ? row >> 11 : (row - MX) >> 4;
    const bf16_t* q = qb + (size_t)row * 1536 + hd * DQK;
    float sc[33], mx = -1e30f;
    for (int jj = 0; jj < 33; ++jj) { const int t = jj * 64 + lane; float a = -1e30f;
        if (t < LTOK) { const int kr = tok_row(b, t); a = 0.f; for (int k = 0; k < DNOPE; ++k) a += bf2f(q[k]) * bf2f(kvb[(size_t)kr * 2048 + hd * 256 + k]); for (int k = 0; k < ROPE; ++k) a += bf2f(q[DNOPE + k]) * bf2f(kpe[(size_t)kr * 64 + k]); }
        sc[jj] = a; mx = fmaxf(mx, a); }
    for (int o = 1; o < 64; o <<= 1) mx = fmaxf(mx, __shfl_xor(mx, o));
    float num = 0.f, den = 0.f, p2 = 0.f;
    for (int jj = 0; jj < 33; ++jj) { const int t = jj * 64 + lane; if (t < LTOK) { const float p = exp2f(sc[jj] - mx); den += p; p2 += p * p; num += p * bf2f(kvb[(size_t)tok_row(b, t) * 2048 + hd * 256 + 128 + d]); } }
    num = wave_sum(num); den = wave_sum(den); p2 = wave_sum(p2);
    report(et, slot, bf2f(mix[(size_t)row * 2048 + hd * DV + d]), num / den, 0.02f, 0.02f * sqrtf(p2) / den, lane);
}
__global__ void ck_part(const bf16_t* qb, const bf16_t* kvb, const bf16_t* kpe, const float* apart, unsigned* et, int slot_l, int slot_o) {
    const int s = blockIdx.x, lane = threadIdx.x, b = hsh(s, 35) % NBATCH, hd = hsh(s, 36) % NH, e = s % 8, i = hsh(s, 37) % 16, d = hsh(s, 38) % DV;
    const bf16_t* q = qb + (size_t)(MX + NMETA * b + i) * 1536 + hd * DQK;
    const float* pe = (const float*)((const char*)apart + (size_t)((b * NH + hd) * 8 + e) * APART_STRIDE);
    const float m = pe[16 * 128 + i], l = pe[16 * 128 + 16 + i], od = pe[i * 128 + d];
    float S = 0.f, O = 0.f, P2 = 0.f;
    for (int jj = 0; jj < 5; ++jj) { const int kk = jj * 64 + lane; int t = -1;
        if (jj < 4) t = NMETA + 256 * e + kk; else if (e == 0 && lane < NMETA) t = lane;
        if (t >= 0) { const int kr = tok_row(b, t); float a = 0.f; for (int k = 0; k < DNOPE; ++k) a += bf2f(q[k]) * bf2f(kvb[(size_t)kr * 2048 + hd * 256 + k]); for (int k = 0; k < ROPE; ++k) a += bf2f(q[DNOPE + k]) * bf2f(kpe[(size_t)kr * 64 + k]);
            const float p = exp2f(a - m); S += p; P2 += p * p; O += p * bf2f(kvb[(size_t)kr * 2048 + hd * 256 + 128 + d]); } }
    S = wave_sum(S); O = wave_sum(O); P2 = wave_sum(P2);
    report(et, slot_l, l, S, 0.02f, 1e-6f, lane); report(et, slot_o, od, O, 0.02f, 0.02f * sqrtf(P2) + 1e-9f, lane);
}
__global__ void ck_part2(const bf16_t* qb, const bf16_t* kvb, const bf16_t* kpe, const float* apart, unsigned* et, int slot0) {
    const int s = blockIdx.x, lane = threadIdx.x, b = hsh(s, 35) % NBATCH, hd = hsh(s, 36) % NH, e = 1 + s % 7, i = hsh(s, 37) % 16, d = hsh(s, 38) % DV;
    const bf16_t* q = qb + (size_t)(MX + NMETA * b + i) * 1536 + hd * DQK;
    const float* pe = (const float*)((const char*)apart + (size_t)((b * NH + hd) * 8 + e) * APART_STRIDE);
    const float m = pe[16 * 128 + i], od = pe[i * 128 + d];
    float Ot[4], P2 = 0.f;
    for (int jj = 0; jj < 4; ++jj) { const int t = NMETA + 256 * e + jj * 64 + lane; const int kr = tok_row(b, t); float a = 0.f;
        for (int k = 0; k < DNOPE; ++k) a += bf2f(q[k]) * bf2f(kvb[(size_t)kr * 2048 + hd * 256 + k]); for (int k = 0; k < ROPE; ++k) a += bf2f(q[DNOPE + k]) * bf2f(kpe[(size_t)kr * 64 + k]);
        const float p = exp2f(a - m); P2 += p * p; Ot[jj] = wave_sum(p * bf2f(kvb[(size_t)kr * 2048 + hd * 256 + 128 + d])); }
    P2 = wave_sum(P2); const float O = Ot[0] + Ot[1] + Ot[2] + Ot[3], at = 0.02f * sqrtf(P2) + 1e-9f;
    report(et, slot0 + (i >> 2), od, O, 0.02f, at, lane);
    report(et, slot0 + 4 + (d >> 5), od, O, 0.02f, at, lane);
}
__global__ void ck_s5(const bf16_t* proj, const float* lre, const float* lim, const float* lst, const float* bre, const float* bim, const float* cre, const float* cim, const float* dsk, const bf16_t* gb, unsigned* et, int slot, int l) {
    const int s = blockIdx.x, p = threadIdx.x, b = hsh(s, 41) % NBATCH, g = hsh(s, 42) % NG, co = hsh(s, 43) % GS; int t = hsh(s, 44) % LTOK; if (s == 0) t = 0; if (s == 1) t = LTOK - 1; if (s == 2) t = 15; if (s == 3) t = 16; if (s == 4) t = 1055; if (s == 5) t = 1056;
    float y = 0.f;
    for (int d = 0; d < 2; ++d) { const int ldg = (l * 2 + d) * NG + g, i = ldg * NS + p;
        const float lr = lre[i], li = lim[i], dt = expf(lst[ldg]), mag = expf(lr * dt), ar = mag * cosf(li * dt), ai = mag * sinf(li * dt);
        const float den = 1.0f / (lr * lr + li * li), xr = ar - 1.0f, xi = ai, fr = (xr * lr + xi * li) * den, fi = (xi * lr - xr * li) * den;
        float br[GS], bi[GS]; for (int c = 0; c < GS; ++c) { const float a = bre[(size_t)i * GS + c], bb = bim[(size_t)i * GS + c]; br[c] = fr * a - fi * bb; bi[c] = fr * bb + fi * a; }
        float hr = 0.f, hi = 0.f;
        const int t0 = d ? LTOK - 1 : 0, step = d ? -1 : 1, n = d ? LTOK - t : t + 1;
        for (int k = 0, tt = t0; k < n; ++k, tt += step) { const bf16_t* u = proj + (size_t)tok_row(b, tt) * PROJW + 1024 + GS * g; float ur = 0.f, ui = 0.f;
            for (int c = 0; c < GS; ++c) { const float uv = bf2f(u[c]); ur += br[c] * uv; ui += bi[c] * uv; }
            const float nr = ar * hr - ai * hi + ur, ni = ar * hi + ai * hr + ui; hr = nr; hi = ni; }
        y += cre[((size_t)ldg * GS + co) * NS + p] * hr - cim[((size_t)ldg * GS + co) * NS + p] * hi; }
    y = wave_sum(y);
    const size_t row = tok_row(b, t); y += dsk[GS * g + co] * bf2f(proj[row * PROJW + 1024 + GS * g + co]);
    const float tt = 0.7978845608028654f * (y + 0.044715f * y * y * y), ref = 0.5f * y * (1.0f + tanhf(tt));
    report(et, slot, bf2f(gb[row * SSMW + GS * g + co]), ref, 0.03f, 0.03f, p);
}
__global__ void ck_glu(const bf16_t* gb, const float* w_glu, const bf16_t* mix, unsigned* et, int slot) {
    const int s = blockIdx.x, lane = threadIdx.x, row = pick_row(s, 51), c = hsh(s, 52) % SSMW; const bf16_t* g = gb + (size_t)row * SSMW;
    const float z = wdot(SSMW, lane, [&](int k) { return bf2f(g[k]) * w_glu[(size_t)k * SSMW + c]; }), gv = bf2f(g[c]);
    report(et, slot, bf2f(mix[(size_t)row * 2048 + ATTW + c]), gv / (1.0f + expf(-z)), 0.02f, 0.01f, lane);
}
__global__ void ck_mixn(const bf16_t* mix, const bf16_t* mixn, unsigned* et, int slot) {
    const int s = blockIdx.x, lane = threadIdx.x, row = pick_row(s, 61), c = hsh(s, 62) % 2048, hf = c >> 10; const bf16_t* m = mix + (size_t)row * 2048 + hf * 1024;
    const float r = 1.0f / sqrtf(wdot(1024, lane, [&](int k) { const float v = bf2f(m[k]); return v * v; }) / 1024 + EPS);
    report(et, slot, bf2f(mixn[(size_t)row * 2048 + c]), bf2f(mix[(size_t)row * 2048 + c]) * r, 0.02f, 0.02f, lane);
}
__global__ void ck_gout(const float* h, const float* hs, const bf16_t* mixn, const float* w_out, const float* ga, const float* gs, unsigned* et, int slot) {
    const int s = blockIdx.x, lane = threadIdx.x, row = pick_row(s, 71), c = hsh(s, 72) % DM; const bf16_t* m = mixn + (size_t)row * 2048;
    const float ref = hs[(size_t)row * DM + c] + wdot(DM, lane, [&](int k) { return bf2f(m[k]) * (k < ATTW ? ga[k] : gs[k - ATTW]) * w_out[(size_t)k * DM + c]; });
    report(et, slot, h[(size_t)row * DM + c], ref, 0.01f, 0.02f, lane);
}
__global__ void ck_act(const float* h, const float* wg, const float* wu, const float* gain, const bf16_t* act, unsigned* et, int slot) {
    const int s = blockIdx.x, lane = threadIdx.x, row = pick_row(s, 81), f = hsh(s, 82) % DFF; const float* hr = h + (size_t)row * DM;
    const float r = 1.0f / sqrtf(wdot(DM, lane, [&](int k) { return hr[k] * hr[k]; }) / DM + EPS);
    const float g = r * wdot(DM, lane, [&](int k) { return hr[k] * gain[k] * wg[(size_t)k * DFF + f]; }), u = r * wdot(DM, lane, [&](int k) { return hr[k] * gain[k] * wu[(size_t)k * DFF + f]; });
    report(et, slot, bf2f(act[(size_t)row * DFF + f]), g / (1.0f + expf(-g)) * u, 0.03f, 0.02f, lane);
}
__global__ void ck_down(const float* h, const float* hs, const bf16_t* act, const float* wd, unsigned* et, int slot) {
    const int s = blockIdx.x, lane = threadIdx.x, row = pick_row(s, 91), c = hsh(s, 92) % DM; const bf16_t* a = act + (size_t)row * DFF;
    const float ref = hs[(size_t)row * DM + c] + wdot(DFF, lane, [&](int k) { return bf2f(a[k]) * wd[(size_t)k * DM + c]; });
    report(et, slot, h[(size_t)row * DM + c], ref, 0.01f, 0.02f, lane);
}
__global__ void ck_moe(const float* h, const float* hs, const float* wr, const float* wg, const float* wu, const float* wd, const float* gain, unsigned* et, int slot) {
    const int s = blockIdx.x, lane = threadIdx.x, row = pick_row(s, 101), c = hsh(s, 102) % DM; const float* hr = hs + (size_t)row * DM;
    const float r = 1.0f / sqrtf(wdot(DM, lane, [&](int k) { return hr[k] * hr[k]; }) / DM + EPS);
    float lg[NE]; for (int e = 0; e < NE; ++e) lg[e] = r * wdot(DM, lane, [&](int k) { return hr[k] * gain[k] * wr[(size_t)k * NE + e]; });
    int e0 = 0; for (int e = 1; e < NE; ++e) if (lg[e] > lg[e0]) e0 = e; int e1 = -1; for (int e = 0; e < NE; ++e) if (e != e0 && (e1 < 0 || lg[e] > lg[e1])) e1 = e;
    const float w1 = 1.0f / (1.0f + expf(lg[e0] - lg[e1])), w0 = 1.0f - w1;
    float acc = 0.f;
    for (int kk = 0; kk < 2; ++kk) { const int e = kk ? e1 : e0; const float we = kk ? w1 : w0; const float* g_ = wg + (size_t)e * DM * DFE; const float* u_ = wu + (size_t)e * DM * DFE; const float* d_ = wd + (size_t)e * DFE * DM;
        for (int f = lane; f < DFE; f += 64) { float ga = 0.f, ua = 0.f; for (int k = 0; k < DM; ++k) { const float x = hr[k] * gain[k]; ga += x * g_[(size_t)k * DFE + f]; ua += x * u_[(size_t)k * DFE + f]; }
            ga *= r; ua *= r; acc += we * (ga / (1.0f + expf(-ga)) * ua) * d_[(size_t)f * DM + c]; } }
    acc = wave_sum(acc);
    report(et, slot, h[(size_t)row * DM + c], hr[c] + acc, 0.01f, 0.02f, lane);
}
__global__ void ck_final(const float* h, const float* fn, const float* out, unsigned* et, int slot) {
    const int s = blockIdx.x, lane = threadIdx.x, row = pick_row(s, 111) % MX, c = hsh(s, 112) % DM; const float* hr = h + (size_t)row * DM;
    const float r = 1.0f / sqrtf(wdot(DM, lane, [&](int k) { return hr[k] * hr[k]; }) / DM + EPS);
    report(et, slot, out[(size_t)row * DM + c], hr[c] * r * fn[c], 0.001f, 0.001f, lane);
}
__global__ void encode(const unsigned* et, float* out, size_t n) {
    float code = -1.f; const unsigned tmo = et[200] | et[256 + 200];
    for (int pass = 0; pass < 2 && code < 0.f; ++pass)
        for (int l = 0; l < DEPTH && code < 0.f; ++l) { int v = 0;
            for (int k = 1; k <= 10; ++k) { const int sl = 10 + 20 * l + k; const bool f1 = __uint_as_float(et[sl]) > 3.0f, f2 = __uint_as_float(et[256 + sl]) > 3.0f; if (pass == 0 ? (f1 && f2) : (f1 != f2)) v |= 1 << (k - 1); }
            if (v) code = (float)(10 + v % 90) * 0.1f * powf(10.0f, (float)(4 + v / 90 + 12 * l + 48 * pass)); }
    if (code < 0.f && (__uint_as_float(et[95]) > 3.0f || __uint_as_float(et[256 + 95]) > 3.0f)) code = 9.5e2f;
    if (tmo) code = 9.9e2f;
    if (code < 0.f) return;
    const float a = sqrtf(code);
    for (size_t i = (size_t)blockIdx.x * blockDim.x + threadIdx.x; i < n; i += (size_t)gridDim.x * blockDim.x) out[i] = a;
}
__global__ void copy_tmo(const unsigned* ctl, unsigned* et) { if (threadIdx.x == 0) et[200] = ctl[CW_BAR + XB_TMO] | ctl[CW_TMO]; }
}
#endif

__global__ void fill_kernel(float* out, size_t n, float a) { for (size_t i = (size_t)blockIdx.x * blockDim.x + threadIdx.x; i < n; i += (size_t)gridDim.x * blockDim.x) out[i] = a; }
extern "C" void kernel_launch(void* const* d_in, const int* in_sizes, int n_in, void* d_out, int out_size, void* d_ws, size_t ws_size, hipStream_t stream) {
    static int grid = 0;
    if (grid == 0) {
        if (n_in == 29 && out_size == MX * DM && ws_size < WS_TOTAL) { grid = -2; }
        else if (n_in != 29 || out_size != MX * DM) { fprintf(stderr, "kernel_launch: built for 29 inputs, %d outputs, >= %zu bytes of workspace; got n_in %d, out %d, ws %zu; nothing launched\n", MX * DM, (size_t)WS_TOTAL, n_in, out_size, ws_size); grid = -1; return; }
        int dev = 0, cus = 0, per_cu = 0;
        if (grid == -2) {   } else
        if (hipGetDevice(&dev) != hipSuccess || hipDeviceGetAttribute(&cus, hipDeviceAttributeMultiprocessorCount, dev) != hipSuccess) { grid = -1; return; }
        if (grid == -2) {} else if (hipFuncSetAttribute((const void*)fwd_kernel, hipFuncAttributeMaxDynamicSharedMemorySize, LDS_BYTES) != hipSuccess) { fprintf(stderr, "kernel_launch: hipFuncSetAttribute failed\n"); grid = -1; return; }
        if (grid != -2) if (hipOccupancyMaxActiveBlocksPerMultiprocessor(&per_cu, (const void*)fwd_kernel, NTHR, LDS_BYTES) != hipSuccess || per_cu < 1) fprintf(stderr, "kernel_launch: occupancy query says %d\n", per_cu);
        (void)hipGetLastError();
        if (grid != -2) grid = cus;
    }
    if (grid == -2) { hipLaunchKernelGGL(fill_kernel, dim3(1024), dim3(256), 0, stream, (float*)d_out, (size_t)out_size, 9949.87f); return; }
    if (grid < 0) return;
    (void)hipMemsetAsync((char*)d_ws + WS_CTL, 0, CTL_BYTES, stream);
    Args a{};
    for (int i = 0; i < 29; ++i) a.in.p[i] = (const float*)d_in[i];
    a.out = (float*)d_out; a.ws = (unsigned char*)d_ws;
#if !DBG
    a.ph_lo = 0; a.ph_hi = 128;
    hipLaunchKernelGGL(fwd_kernel, dim3(grid), dim3(NTHR), LDS_BYTES, stream, a);
#else
    unsigned char* ws = (unsigned char*)d_ws; unsigned* et = (unsigned*)(ws + WS_DBG_ERR); float* hs = (float*)(ws + WS_DBG_H);
    float* h = (float*)(ws + WS_H); bf16_t* proj = (bf16_t*)(ws + WS_PROJ); bf16_t* kpe = (bf16_t*)(ws + WS_KPE); bf16_t* qb = (bf16_t*)(ws + WS_QB); bf16_t* kvb = (bf16_t*)(ws + WS_KVB);
    bf16_t* mix = (bf16_t*)(ws + WS_MIX); bf16_t* mixn = (bf16_t*)(ws + WS_MIXN); bf16_t* gb = (bf16_t*)(ws + WS_GB); bf16_t* act = (bf16_t*)(ws + WS_BIG);
    const float* const* in = (const float* const*)a.in.p;
    (void)hipMemsetAsync(et, 0, 4096, stream);
    for (int rep = 0; rep < 2; ++rep) {
    if (rep) { (void)hipMemsetAsync((char*)d_ws + WS_CTL, 0, CTL_BYTES, stream); et += 256; }
    auto run = [&](int ph) { a.ph_lo = ph; a.ph_hi = ph + 1; hipLaunchKernelGGL(fwd_kernel, dim3(grid), dim3(NTHR), LDS_BYTES, stream, a); };
    auto snap = [&]() { (void)hipMemcpyAsync(hs, h, (size_t)MP * DM * 4, hipMemcpyDeviceToDevice, stream); };
    const int NSMP = 512;
    run(0);
    for (int l = 0; l < DEPTH; ++l) {
        const int P = 32 * l, SL = 10 + 20 * l;
        run(P + 1); run(P + 2); hipLaunchKernelGGL(dbg::ck_g1, dim3(NSMP), dim3(64), 0, stream, h, in[3] + (size_t)l * DM * INC, in[2] + l * DM, proj, kpe, et, SL + 1);
        run(P + 3); hipLaunchKernelGGL(dbg::ck_g2, dim3(NSMP), dim3(64), 0, stream, proj, in[5] + (size_t)l * QL * 1536, in[4] + l * QL, in[7] + (size_t)l * KVL * 2048, in[6] + l * KVL, qb, kvb, et, SL + 2);
        hipLaunchKernelGGL(dbg::ck_s5, dim3(96), dim3(64), 0, stream, proj, in[8], in[9], in[10], in[11], in[12], in[13], in[14], in[15] + (size_t)l * SSMW, gb, et, SL + 4, l);
        run(P + 4); hipLaunchKernelGGL(dbg::ck_glu, dim3(NSMP), dim3(64), 0, stream, gb, in[16] + (size_t)l * SSMW * SSMW, mix, et, SL + 5);
        run(P + 5); hipLaunchKernelGGL(dbg::ck_att, dim3(256), dim3(64), 0, stream, qb, kvb, kpe, mix, et, SL + 3, 0); hipLaunchKernelGGL(dbg::ck_att, dim3(64), dim3(64), 0, stream, qb, kvb, kpe, mix, et, SL + ((l & 1) ? 8 : 10), 1);
        hipLaunchKernelGGL(dbg::ck_mixn, dim3(NSMP), dim3(64), 0, stream, mix, mixn, et, SL + 6);
        snap(); run(P + 6); run((l & 1) ? P + 16 : P + 7);
        hipLaunchKernelGGL(dbg::ck_gout, dim3(NSMP), dim3(64), 0, stream, h, hs, mixn, in[19] + (size_t)l * DM * DM, in[17] + l * ATTW, in[18] + l * SSMW, et, SL + 7);
        if ((l & 1) == 0) { const int i = l >> 1;
            run(P + 8); hipLaunchKernelGGL(dbg::ck_act, dim3(NSMP), dim3(64), 0, stream, h, in[21] + (size_t)i * DM * DFF, in[22] + (size_t)i * DM * DFF, in[20] + (size_t)l * DM, act, et, SL + 8);
            snap(); run(P + 9); run(P + 10); hipLaunchKernelGGL(dbg::ck_down, dim3(NSMP), dim3(64), 0, stream, h, hs, act, in[23] + (size_t)i * DFF * DM, et, SL + 9);
        } else { const int i = l >> 1;
            snap(); run(P + 17); run(P + 18); run(P + 19); run(P + 20);
            hipLaunchKernelGGL(dbg::ck_moe, dim3(48), dim3(64), 0, stream, h, hs, in[24] + (size_t)i * DM * NE, in[25] + (size_t)i * NE * DM * DFE, in[26] + (size_t)i * NE * DM * DFE, in[27] + (size_t)i * NE * DFE * DM, in[20] + (size_t)l * DM, et, SL + 10);
        }
    }
    hipLaunchKernelGGL(dbg::ck_final, dim3(NSMP), dim3(64), 0, stream, h, in[28], (const float*)d_out, et, 95);
    hipLaunchKernelGGL(dbg::copy_tmo, dim3(1), dim3(64), 0, stream, (const unsigned*)(ws + WS_CTL), et);
    }
    hipLaunchKernelGGL(dbg::encode, dim3(1024), dim3(256), 0, stream, (const unsigned*)(ws + WS_DBG_ERR), (float*)d_out, (size_t)MX * DM);
#endif
}
```

```cpp
#include <hip/hip_runtime.h>
#include <cstdio>
#include <cstdint>

#ifndef PROBE_REP
#define PROBE_REP 0
#endif
#ifndef DBG
#define DBG 0
#endif

constexpr int DM = 2048, NBATCH = 4, SEQ = 2048, NMETA = 16, LTOK = SEQ + NMETA, DEPTH = 4;
constexpr int MX = NBATCH * SEQ, MREAL = MX + NBATCH * NMETA, MP = 8448;
constexpr int QL = 512, KVL = 256, ROPE = 64, NH = 8, DNOPE = 128, DQK = 192, DV = 128;
constexpr int ATTW = 1024, SSMW = 1024, NG = 64, GS = 16, NS = 64, INC = 1856;
constexpr int DFF = 5632, NE = 8, DFE = 1408;
constexpr float EPS = 1e-6f;
constexpr float CQ = 0.07216878364870323f * 1.4426950408889634f;
constexpr int PROJW = 2048;
constexpr int MOE_ROWS = 18688;

typedef unsigned short bf16_t;
typedef short bf16x8 __attribute__((ext_vector_type(8)));
typedef short s16x4 __attribute__((ext_vector_type(4)));
typedef float f32x4 __attribute__((ext_vector_type(4)));
typedef float f32x2 __attribute__((ext_vector_type(2)));
typedef float f32x16 __attribute__((ext_vector_type(16)));
typedef unsigned u32x4 __attribute__((ext_vector_type(4)));
typedef unsigned u32x2 __attribute__((ext_vector_type(2)));
typedef int i32x8 __attribute__((ext_vector_type(8)));
typedef int i32x4 __attribute__((ext_vector_type(4)));
#define LAS __attribute__((address_space(3)))
#define GAS __attribute__((address_space(1)))

constexpr size_t al256(size_t x) { return (x + 255) / 256 * 256; }
constexpr size_t WS_CTL = 0;
constexpr int CW_TMO = 0, CW_BAR = 4096, CW_CNT = 8192, CW_TKT = 12288;
constexpr size_t CTL_SSQ = 65536;
constexpr int NSSQ = DEPTH * 4 + 1;
constexpr size_t CTL_BYTES = al256(CTL_SSQ + (size_t)NSSQ * MP * 8);
constexpr size_t WS_TAB = al256(CTL_BYTES);
constexpr size_t WS_DBG_ERR = WS_TAB + 256;
constexpr size_t WS_W = WS_DBG_ERR + 4096;
constexpr size_t SZ_WIN = (size_t)2048 * 2048 * 2, SZ_WUQ = (size_t)1536 * 512 * 2, SZ_WUKV = (size_t)2048 * 256 * 2, SZ_WGLU = (size_t)1024 * 1024 * 2, SZ_WOUT = (size_t)2048 * 2048 * 2;
constexpr size_t SZ_LAYER = SZ_WIN + SZ_WUQ + SZ_WUKV + SZ_WGLU + SZ_WOUT;
constexpr size_t OFF_WIN = 0, OFF_WUQ = SZ_WIN, OFF_WUKV = OFF_WUQ + SZ_WUQ, OFF_WGLU = OFF_WUKV + SZ_WUKV, OFF_WOUT = OFF_WGLU + SZ_WGLU;
constexpr size_t WS_WFF = WS_W + DEPTH * SZ_LAYER;
constexpr size_t SZ_DGU = (size_t)2 * DFF * DM * 2, SZ_DDN = (size_t)DM * DFF * 2, SZ_DENSE = SZ_DGU + SZ_DDN;
constexpr size_t SZ_EGU = (size_t)2 * DFE * DM * 2, SZ_EDN = (size_t)DM * DFE * 2, SZ_EXP = SZ_EGU + SZ_EDN;
constexpr size_t SZ_MOE = NE * SZ_EXP;
constexpr size_t WS_S5 = WS_WFF + 2 * SZ_DENSE + 2 * SZ_MOE;
constexpr size_t S5_LAM = 0, S5_BRE = 512, S5_BIM = 512 + 2048, S5_CEF = 512 + 4096, S5_STRIDE = 512 + 4096 + 4096;
constexpr size_t WS_ROPE = al256(WS_S5 + (size_t)DEPTH * 2 * NG * S5_STRIDE);
constexpr size_t WS_H = al256(WS_ROPE + (size_t)2 * LTOK * 32 * 4);
constexpr size_t WS_HB = WS_H + (size_t)MP * DM * 4;
constexpr size_t WS_PROJ = WS_HB + (size_t)MP * DM * 2;
constexpr size_t WS_KPE = WS_PROJ + (size_t)MP * PROJW * 2;
constexpr size_t WS_QB = WS_KPE + (size_t)MP * 64 * 2;
constexpr size_t WS_KVB = WS_QB + (size_t)MP * 1536 * 2;
constexpr size_t WS_MIX = WS_KVB + (size_t)MP * 2048 * 2;
constexpr size_t WS_MIXN = WS_PROJ;
constexpr size_t WS_YP = WS_MIX + (size_t)MP * 2048 * 2;
constexpr size_t WS_GB = WS_YP + (size_t)MP * 1024 * 4;
constexpr size_t WS_APART = WS_GB + (size_t)MP * 1024 * 2;
constexpr size_t APART_STRIDE = (16 * 128 + 32) * 4;
constexpr size_t WS_ROUTE = al256(WS_APART + (size_t)NBATCH * NH * 8 * APART_STRIDE);
constexpr size_t WS_RPERM = WS_ROUTE + (size_t)MP * 32;
constexpr size_t WS_GPERM = WS_RPERM + (size_t)NE * MP * 4;
constexpr size_t WS_BIG = al256(WS_GPERM + (size_t)NE * MP * 4);
constexpr size_t WS_MACT = WS_BIG, WS_XPERM = WS_MACT + (size_t)MOE_ROWS * DFE * 2, WS_YSLOT = WS_XPERM;
constexpr size_t WS_END = WS_YSLOT + (size_t)MOE_ROWS * 2048 * 4;
static_assert((size_t)MP * DFF * 2 <= WS_END - WS_BIG, "dense act fits the overlay");
constexpr size_t WS_DBG_H = WS_QB;
static_assert(WS_DBG_H + (size_t)MP * DM * 4 <= WS_YP, "snapshot fits");
constexpr size_t WS_SLAB = al256(WS_END);
constexpr int SLAB_MAXSL = 22;
constexpr size_t WS_TOTAL = WS_SLAB + (size_t)SLAB_MAXSL * 64 * 2048 * 4;

typedef unsigned long long ssq_t;
constexpr float SSQ_SCALE = 16777216.0f, SSQ_INV = 1.0f / 16777216.0f;
__device__ __forceinline__ float ssq_get(const ssq_t* p, int row) { return (float)p[row] * SSQ_INV; }
__device__ __forceinline__ ssq_t ssq_fix(float ss) { return (ssq_t)(ss * SSQ_SCALE); }
__host__ __device__ constexpr int SSQ_H1(int l) { return l * 4; }
__host__ __device__ constexpr int SSQ_CQ(int l) { return l * 4 + 1; }
__host__ __device__ constexpr int SSQ_CKV(int l) { return l * 4 + 2; }
__host__ __device__ constexpr int SSQ_H2(int l) { return l * 4 + 3; }

__device__ __forceinline__ unsigned cvt_pk_bf16(float lo, float hi) { unsigned r; asm volatile("v_cvt_pk_bf16_f32 %0, %1, %2" : "=v"(r) : "v"(lo), "v"(hi)); return r; }
constexpr float F8_HS = 4.0f, F8_WGU = 64.0f, F8_AS = 8.0f, F8_WDN = 256.0f;
constexpr int DFEP = 1536;
constexpr float F8_GS = 16.0f, F8_WGL = 32.0f;
__device__ __forceinline__ unsigned pk4_fp8(float a, float b, float c, float d) {
    unsigned r = 0;
    r = __builtin_amdgcn_cvt_pk_fp8_f32(__builtin_amdgcn_fmed3f(a, -448.0f, 448.0f), __builtin_amdgcn_fmed3f(b, -448.0f, 448.0f), r, false);
    r = __builtin_amdgcn_cvt_pk_fp8_f32(__builtin_amdgcn_fmed3f(c, -448.0f, 448.0f), __builtin_amdgcn_fmed3f(d, -448.0f, 448.0f), r, true);
    return r; }
__device__ __forceinline__ float bf2f(unsigned short b) { return __uint_as_float(((unsigned)b) << 16); }
__device__ __forceinline__ float bflo(unsigned w) { return __uint_as_float(w << 16); }
__device__ __forceinline__ float bfhi(unsigned w) { return __uint_as_float(w & 0xffff0000u); }
__device__ __forceinline__ float fast_exp2(float x) { return __builtin_amdgcn_exp2f(x); }
__device__ __forceinline__ float fast_rcp(float x) { return __builtin_amdgcn_rcpf(x); }
__device__ __forceinline__ float sigmoidf_(float z) { return fast_rcp(1.0f + fast_exp2(-1.4426950408889634f * z)); }
__device__ __forceinline__ float gelu_tanh(float y) { const float t = 0.7978845608028654f * (y + 0.044715f * y * y * y); return y * sigmoidf_(2.0f * t); }
__device__ __forceinline__ float wave_sum(float v) {
#pragma unroll
    for (int o = 1; o < 64; o <<= 1) v += __shfl_xor(v, o);
    return v;
}
__device__ __forceinline__ float swap32(float x, int hh) { auto rr = __builtin_amdgcn_permlane32_swap(__float_as_uint(x), __float_as_uint(x), false, false); return __uint_as_float(hh ? rr[0] : rr[1]); }
__device__ __forceinline__ int row_pos(int row) { return row < MX ? NMETA + (row & (SEQ - 1)) : ((row - MX) & (NMETA - 1)); }
__device__ __forceinline__ int tok_row(int b, int t) { return t < NMETA ? MX + NMETA * b + t : SEQ * b + t - NMETA; }
#define LDS_WAIT() asm volatile("s_waitcnt lgkmcnt(0)" ::: "memory")
#define VM_WAIT() asm volatile("s_waitcnt vmcnt(0)" ::: "memory")

namespace pg8 {
constexpr int BM = 256, BK = 64, HALF = 128, HTB = HALF * BK * 2, STAGE_BYTES = 8 * HTB, NXCD = 8, WGM = 8;
__host__ __device__ __forceinline__ int lds_byte(int r, int c) { const int st = (r >> 4) * 2 + (c >> 5), rr = r & 15, cc = c & 31, ob = rr * 64 + cc * 2; return st * 1024 + (ob ^ (((ob >> 9) & 1) << 5)); }
__host__ __device__ __forceinline__ void stage_rc(int b, int& R, int& C) { const int st = b / 1024, sb = b % 1024, swz = sb ^ (((sb >> 9) & 1) << 5); R = (st >> 1) * 16 + swz / 64; C = (st & 1) * 32 + (swz % 64) / 2; }
__host__ __device__ __forceinline__ int perm32(int rho) { const int n = rho >> 4, i = rho & 15; return 8 * (i >> 2) + 4 * n + (i & 3); }
struct Unit { int pm, pn, ks, roff; };

__device__ __forceinline__ bool order2d(int i, int G, int c, int nM, int nN, Unit& u) {
    const int nwg = nM * nN; const long L = (long)i * G + c; if (L >= nwg) return false;
    int wgid = (int)L; { const int q = nwg / NXCD, r = nwg % NXCD, xcd = wgid % NXCD, off = wgid / NXCD; wgid = (xcd < r ? xcd * (q + 1) : r * (q + 1) + (xcd - r) * q) + off; }
    const int nig = WGM * nN, gid = wgid / nig, fm = gid * WGM, gsz = (nM - fm) < WGM ? (nM - fm) : WGM;
    u.pm = fm + ((wgid % nig) % gsz); u.pn = (wgid % nig) / gsz; u.ks = -1; u.roff = 0; return true;
}
struct Sched2D {
    static constexpr bool HAS_TAIL = false;
    const bf16_t* A; const bf16_t* Bt; int lda, K, nM, nN, G, c;
    __device__ __forceinline__ int nt(const Unit&) const { return K / BK; }
    __device__ __forceinline__ bool next(int i, Unit& u) const { return order2d(i, G, c, nM, nN, u); }
    __device__ __forceinline__ void ptrs(const Unit& u, const char*& a, const char*& b) const { a = (const char*)A + (size_t)u.pm * BM * lda * 2; b = (const char*)Bt + (size_t)u.pn * BM * K * 2; }
};
struct SchedT {
    static constexpr bool HAS_TAIL = true;
    const bf16_t* A; const bf16_t* Bt; int lda, K, nN, G, c, sliceK, nslice;
    __device__ __forceinline__ int nt(const Unit& u) const { return (u.ks < 0 ? K : sliceK) / BK; }
    __device__ __forceinline__ bool next(int i, Unit& u) const {
        if (order2d(i, G, c, MX / BM, nN, u)) return true;
        const long L = (long)i * G + c - (long)(MX / BM) * nN; if (L < 0 || L >= (long)nN * nslice) return false;
        u.pm = MX / BM; u.pn = (int)(L % nN); u.ks = (int)(L / nN); u.roff = 0; return true; }
    __device__ __forceinline__ void ptrs(const Unit& u, const char*& a, const char*& b) const { const size_t ko = u.ks < 0 ? 0 : (size_t)u.ks * sliceK * 2;
        a = (const char*)A + (size_t)u.pm * BM * lda * 2 + ko; b = (const char*)Bt + (size_t)u.pn * BM * K * 2 + ko; }
};
struct SchedMoE {
    static constexpr bool HAS_TAIL = false;
    const bf16_t* A; const bf16_t* Bt0; size_t estride; int lda, K, nN, G, c; int pfx[NE + 1]; int capA;
    __device__ __forceinline__ int nt(const Unit&) const { return K / BK; }
    __device__ __forceinline__ bool next(int i, Unit& u) const {
        if (!order2d(i, G, c, pfx[NE], nN, u)) return false;
        int e = 0, pe = 0;
#pragma unroll
        for (int j = 1; j < NE; ++j) if (u.pm >= pfx[j]) { e = j; pe = pfx[j]; }
        u.roff = e * MP - pe * BM; return true; }
    __device__ __forceinline__ void ptrs(const Unit& u, const char*& a, const char*& b) const {
        int e = 0;
#pragma unroll
        for (int j = 1; j < NE; ++j) e += (u.pm >= pfx[j]) ? 1 : 0;
        a = (const char*)A + (size_t)(u.pm * BM + (capA ? u.roff : 0)) * lda * 2; b = (const char*)Bt0 + (size_t)e * estride + (size_t)u.pn * BM * K * 2; }
};

template <bool PERM>
__device__ __forceinline__ void tail_store(const f32x4 (&acc)[2][2][4][2], const Unit& u, int wr, int wc, int fr, int fq, float* slab, int N) {
    if (wr != 0) return;
    { unsigned z = 0u; asm volatile("" : "+v"(z)); const int ln = (int)__builtin_amdgcn_mbcnt_hi(~0u, __builtin_amdgcn_mbcnt_lo(~0u, z)); fr = ln & 15; fq = ln >> 4; }
    asm volatile("" : "+s"(slab), "+v"(fr), "+v"(fq));
#pragma unroll
    for (int m = 0; m < 4; ++m) { float* rp = slab + ((size_t)u.ks * 64 + m * 16 + fr) * N + u.pn * BM + wc * 32;
#pragma unroll
        for (int bj = 0; bj < 2; ++bj)
#pragma unroll
            for (int n = 0; n < 2; ++n) *(f32x4*)(rp + bj * HALF + (PERM ? 8 * fq + 4 * n : 16 * n + 4 * fq)) = acc[0][bj][m][n]; }
}
__host__ __device__ __forceinline__ int f8_p(int fr) { return ((fr >> 1) & 7) ^ (2 * (((fr >> 2) ^ (fr >> 3)) & 1)); }
template <class Epi, class Sched, bool ALIGN_EPI, bool F8 = false>
__device__ __forceinline__ void gemm_phase(LAS unsigned char* lds, const Sched& S, const Epi& E, int tid) {
    const int wid = __builtin_amdgcn_readfirstlane(tid >> 6), lane = tid & 63, wr = wid >> 2, wc = wid & 3, fr = lane & 15, fq = lane >> 4;
    const int K = S.K, lda = S.lda;
    unsigned voffA[2], voffB[2];
#pragma unroll
    for (int i = 0; i < 2; ++i) { int R, C;
        if constexpr (F8) { const int a = tid * 16 + i * 8192; R = a >> 7; C = ((((a >> 4) & 7) ^ f8_p(R & 15)) * 8); } else stage_rc(tid * 16 + i * 8192, R, C);
        const int Rb = Epi::PERM ? ((R & ~31) + perm32(R & 31)) : R;
        voffA[i] = (unsigned)(R * lda + C) * 2u; voffB[i] = (unsigned)(Rb * K + C) * 2u; }
    const size_t kstep = (size_t)(BK * 2);
    const size_t hstepA = (size_t)HALF * lda * 2, hstepB = (size_t)HALF * K * 2;
    const unsigned ldsw = (unsigned)wid * 1024u;
    const int aoff = F8 ? wr * 8192 + fr * 128 + (((2 * fq) ^ f8_p(fr)) * 16) : lds_byte(wr * 64 + fr, fq * 8), boff = F8 ? wc * 4096 + fr * 128 + (((2 * fq) ^ f8_p(fr)) * 16) : lds_byte(wc * 32 + fr, fq * 8);
    const int xoff1 = F8 ? ((((2 * fq + 1) ^ f8_p(fr)) - ((2 * fq) ^ f8_p(fr))) * 16) : 1024;
#define PG8_SA(b, h) (((b) * 2 + (h)) * HTB)
#define PG8_SB(b, h) ((4 + (b) * 2 + (h)) * HTB)
#define PG8_STAGE(bufoff, gbase, voff) do { _Pragma("unroll") for (int _i = 0; _i < 2; ++_i) \
        __builtin_amdgcn_global_load_lds((const unsigned*)((const char*)(gbase) + (voff)[_i]), (LAS unsigned*)(lds + (bufoff) + ldsw + _i * 8192), 16, 0, 0); } while (0)
#define PG8_LDA(dst, b, h) do { _Pragma("unroll") for (int m = 0; m < 4; ++m) { dst[m][0] = *(const LAS bf16x8*)(lds + PG8_SA(b, h) + aoff + m * 2048); dst[m][1] = *(const LAS bf16x8*)(lds + PG8_SA(b, h) + aoff + m * 2048 + xoff1); } } while (0)
#define PG8_LDB(dst, b, h) do { _Pragma("unroll") for (int n = 0; n < 2; ++n) { dst[n][0] = *(const LAS bf16x8*)(lds + PG8_SB(b, h) + boff + n * 2048); dst[n][1] = *(const LAS bf16x8*)(lds + PG8_SB(b, h) + boff + n * 2048 + xoff1); } } while (0)
#define PG8_F8FRAG(F) __builtin_shufflevector(__builtin_bit_cast(i32x4, F[0]), __builtin_bit_cast(i32x4, F[1]), 0, 1, 2, 3, 4, 5, 6, 7)
#define PG8_MMA(ai, bj, At, Bt) do { __builtin_amdgcn_s_setprio(1); if constexpr (F8) asm volatile("s_nop 1"); _Pragma("unroll") for (int m = 0; m < 4; ++m) _Pragma("unroll") for (int n = 0; n < 2; ++n) { \
        if constexpr (F8) asm volatile("v_mfma_f32_16x16x128_f8f6f4 %0, %1, %2, %0" : "+v"(acc[ai][bj][m][n]) : "v"(PG8_F8FRAG(Bt[n])), "v"(PG8_F8FRAG(At[m])));   \
        else { _Pragma("unroll") for (int k = 0; k < 2; ++k) acc[ai][bj][m][n] = __builtin_amdgcn_mfma_f32_16x16x32_bf16(Bt[n][k], At[m][k], acc[ai][bj][m][n], 0, 0, 0); } } \
        __builtin_amdgcn_s_setprio(0); } while (0)
#define PG8_WAIT_V(n) asm volatile("s_waitcnt vmcnt(" #n ")" ::: "memory")
#define PG8_WAIT_L(n) asm volatile("s_waitcnt lgkmcnt(" #n ")" ::: "memory")
#define PG8_BAR __builtin_amdgcn_s_barrier()
#define PG8_SCHED __builtin_amdgcn_sched_barrier(0)
    Unit cur, nxt; int ui = 0;
    if (!S.next(0, cur)) return;
    int nt = S.nt(cur);
    f32x4 acc[2][2][4][2];
#pragma unroll
    for (int a = 0; a < 2; ++a)
#pragma unroll
        for (int b = 0; b < 2; ++b)
#pragma unroll
            for (int m = 0; m < 4; ++m)
#pragma unroll
                for (int n = 0; n < 2; ++n) acc[a][b][m][n] = (f32x4){0.f, 0.f, 0.f, 0.f};
    bf16x8 At[4][2], B0[2][2], B1[2][2];
    const char* cA; const char* cB; S.ptrs(cur, cA, cB);
    PG8_STAGE(PG8_SB(0, 0), cB, voffB); PG8_STAGE(PG8_SB(0, 1), cB + hstepB, voffB); PG8_STAGE(PG8_SA(0, 0), cA, voffA); PG8_STAGE(PG8_SA(0, 1), cA + hstepA, voffA);
    if constexpr (Epi::MIDSCALE) E.prep(S, tid);
    if (wr == 1) PG8_BAR;
    PG8_WAIT_V(2); PG8_BAR;
    PG8_STAGE(PG8_SB(1, 0), cB + kstep, voffB); PG8_STAGE(PG8_SA(1, 0), cA + kstep, voffA); PG8_STAGE(PG8_SB(1, 1), cB + hstepB + kstep, voffB);
    PG8_WAIT_V(6); PG8_BAR;
    for (;;) {
        const bool has_next = S.next(ui + 1, nxt);
        const char* nA = cA; const char* nB = cB; if (has_next) S.ptrs(nxt, nA, nB);
        for (int t = 0; t < nt; t += 2) {
            if constexpr (Epi::MIDSCALE) { if (cur.ks < 0 && t == nt / 2) E.midscale(acc, cur, wr, fr); }
            const bool last = (t == nt - 2);
            const char* a1 = cA + (size_t)(t + 1) * kstep;
            const char* a2 = last ? nA : cA + (size_t)(t + 2) * kstep; const char* b2 = last ? nB : cB + (size_t)(t + 2) * kstep;
            const char* a3 = a2 + kstep; const char* b3 = b2 + kstep;
            PG8_LDB(B0, 0, 0); PG8_LDB(B1, 0, 1); PG8_SCHED; PG8_LDA(At, 0, 0); PG8_STAGE(PG8_SA(1, 1), a1 + hstepA, voffA);
            PG8_WAIT_V(8); PG8_WAIT_L(0); PG8_BAR; PG8_MMA(0, 0, At, B0); PG8_MMA(0, 1, At, B1); PG8_BAR; PG8_SCHED;
            PG8_LDA(At, 0, 1); PG8_STAGE(PG8_SB(0, 0), b2, voffB); PG8_STAGE(PG8_SB(0, 1), b2 + hstepB, voffB); PG8_STAGE(PG8_SA(0, 0), a2, voffA);
            PG8_WAIT_V(8); PG8_WAIT_L(0); PG8_BAR; PG8_MMA(1, 0, At, B0); PG8_MMA(1, 1, At, B1); PG8_BAR; PG8_SCHED;
            PG8_LDB(B0, 1, 0); PG8_LDB(B1, 1, 1); PG8_SCHED; PG8_LDA(At, 1, 0); PG8_STAGE(PG8_SA(0, 1), a2 + hstepA, voffA);
            PG8_WAIT_V(8); PG8_WAIT_L(0); PG8_BAR; PG8_MMA(0, 0, At, B0); PG8_MMA(0, 1, At, B1); PG8_BAR; PG8_SCHED;
            PG8_LDA(At, 1, 1); PG8_STAGE(PG8_SB(1, 0), b3, voffB); PG8_STAGE(PG8_SB(1, 1), b3 + hstepB, voffB); PG8_STAGE(PG8_SA(1, 0), a3, voffA);
            PG8_WAIT_V(8); PG8_WAIT_L(0); PG8_BAR; PG8_MMA(1, 0, At, B0); PG8_MMA(1, 1, At, B1); PG8_BAR; PG8_SCHED;
        }
        if constexpr (ALIGN_EPI) { if (wr == 0) PG8_BAR; }
        if constexpr (F8) asm volatile("s_nop 15\n\ts_nop 15" ::: "memory");
        if constexpr (Sched::HAS_TAIL) { if (cur.ks < 0) E(acc, cur, wr, wc, fr, fq); else tail_store<Epi::PERM>(acc, cur, wr, wc, fr, fq, E.slab, S.nN * BM); }
        else E(acc, cur, wr, wc, fr, fq);
        if (!has_next) break;
#pragma unroll
        for (int a = 0; a < 2; ++a)
#pragma unroll
            for (int b = 0; b < 2; ++b)
#pragma unroll
                for (int m = 0; m < 4; ++m)
#pragma unroll
                    for (int n = 0; n < 2; ++n) acc[a][b][m][n] = (f32x4){0.f, 0.f, 0.f, 0.f};
        cur = nxt; cA = nA; cB = nB; ++ui; nt = S.nt(cur);
        if constexpr (ALIGN_EPI) { if (wr == 1) PG8_BAR; }
    }
    PG8_WAIT_V(0);
    if constexpr (!ALIGN_EPI) { if (wr == 0) PG8_BAR; }
    PG8_BAR;
#undef PG8_SA
#undef PG8_SB
#undef PG8_STAGE
#undef PG8_LDA
#undef PG8_LDB
#undef PG8_MMA
#undef PG8_F8FRAG
#undef PG8_WAIT_V
#undef PG8_WAIT_L
#undef PG8_BAR
#undef PG8_SCHED
}

__device__ __forceinline__ float quad_sum(float s) { s += __shfl_xor(s, 16); s += __shfl_xor(s, 32); return s; }

#define EPI_ROW(ai, m) (u.pm * BM + (ai) * HALF + wr * 64 + (m) * 16 + fr)
#define EPI_FOR8(ai, m) _Pragma("unroll") for (int ai = 0; ai < 2; ++ai) _Pragma("unroll") for (int m = 0; m < 4; ++m)
__device__ __forceinline__ float rms_scale(const ssq_t* ssq, int row, float inv_n) { return __builtin_amdgcn_rsqf(ssq_get(ssq, row) * inv_n + EPS); }

struct EpiG1 {
    static constexpr bool PERM = true, MIDSCALE = false;
    bf16_t* proj; bf16_t* kpe; const ssq_t* ssq_h; ssq_t* ssq_cq; ssq_t* ssq_ckv; const float* cosb; const float* sinb; float* slab; float* psq;
    __device__ __forceinline__ void operator()(const f32x4 (&acc)[2][2][4][2], const Unit& u, int wr, int wc, int fr, int fq) const {
        float rr[2][4];
        EPI_FOR8(ai, m) rr[ai][m] = rms_scale(ssq_h, EPI_ROW(ai, m), 1.0f / DM);
        if (u.pn == 3) {
            if (wc < 2) {
                f32x2 cs[2][2], nx[2][2];
#define G1_CS(dst, ai, m) do { const int pos_ = row_pos(EPI_ROW(ai, m)); _Pragma("unroll") for (int n = 0; n < 2; ++n) { const int i0_ = 16 * wc + 4 * fq + 2 * n; \
                    dst[n][0] = *(const f32x2*)(cosb + pos_ * 32 + i0_); dst[n][1] = *(const f32x2*)(sinb + pos_ * 32 + i0_); } } while (0)
                G1_CS(cs, 0, 0);
                EPI_FOR8(ai, m) {
                    const int row = EPI_ROW(ai, m), k = ai * 4 + m; const float r = rr[ai][m];
                    if (k < 7) G1_CS(nx, (k + 1) >> 2, (k + 1) & 3);
                    f32x4 o[2];
#pragma unroll
                    for (int n = 0; n < 2; ++n) { const f32x4 v = acc[ai][0][m][n] * r; const f32x2 c = cs[n][0], s = cs[n][1];
                        o[n] = (f32x4){v[0] * c.x - v[1] * s.x, v[0] * s.x + v[1] * c.x, v[2] * c.y - v[3] * s.y, v[2] * s.y + v[3] * c.y}; }
                    u32x4 w; w.x = cvt_pk_bf16(o[0][0], o[0][1]); w.y = cvt_pk_bf16(o[0][2], o[0][3]); w.z = cvt_pk_bf16(o[1][0], o[1][1]); w.w = cvt_pk_bf16(o[1][2], o[1][3]);
                    *(u32x4*)(kpe + (size_t)row * 64 + 32 * wc + 8 * fq) = w;
#pragma unroll
                    for (int n = 0; n < 2; ++n) { cs[n][0] = nx[n][0]; cs[n][1] = nx[n][1]; }
                }
#undef G1_CS
            }
        } else {
            EPI_FOR8(ai, m) {
                const int row = EPI_ROW(ai, m); const float r = rr[ai][m];
                float ss = 0.f;
#pragma unroll
                for (int bj = 0; bj < 2; ++bj) { const f32x4 v0 = acc[ai][bj][m][0] * r, v1 = acc[ai][bj][m][1] * r;
                    ss += (v0[0] * v0[0] + v0[1] * v0[1]) + (v0[2] * v0[2] + v0[3] * v0[3]) + (v1[0] * v1[0] + v1[1] * v1[1]) + (v1[2] * v1[2] + v1[3] * v1[3]);
                    u32x4 w; w.x = cvt_pk_bf16(v0[0], v0[1]); w.y = cvt_pk_bf16(v0[2], v0[3]); w.z = cvt_pk_bf16(v1[0], v1[1]); w.w = cvt_pk_bf16(v1[2], v1[3]);
                    *(u32x4*)(proj + (size_t)row * PROJW + u.pn * BM + bj * HALF + wc * 32 + 8 * fq) = w; }
                if (u.pn < 3) { ss = quad_sum(ss); if (fq == 0) psq[(size_t)row * 12 + u.pn * 4 + wc] = ss; }
            }
        }
    }
};
struct EpiQ {
    static constexpr bool PERM = true, MIDSCALE = false;
    bf16_t* qb; const ssq_t* ssq_cq; const float* cosb; const float* sinb;
    __device__ __forceinline__ void operator()(const f32x4 (&acc)[2][2][4][2], const Unit& u, int wr, int wc, int fr, int fq) const {
        float rr[2][4];
        EPI_FOR8(ai, m) rr[ai][m] = CQ * rms_scale(ssq_cq, EPI_ROW(ai, m), 1.0f / QL);
        const int st0 = u.pn * 8 + wc, st1 = st0 + 4, sm0 = st0 % 6, sm1 = st1 % 6;
        const bool rope = sm0 >= 4 || sm1 >= 4; const int rsm = (sm0 >= 4 ? sm0 : sm1) - 4;
        f32x2 cs[2][2] = {}, nx[2][2] = {};
#define Q_CS(dst, ai, m) do { const int pos_ = row_pos(EPI_ROW(ai, m)); _Pragma("unroll") for (int n = 0; n < 2; ++n) { const int i0_ = 16 * rsm + 4 * fq + 2 * n; \
            dst[n][0] = *(const f32x2*)(cosb + pos_ * 32 + i0_); dst[n][1] = *(const f32x2*)(sinb + pos_ * 32 + i0_); } } while (0)
        if (rope) Q_CS(cs, 0, 0);
        EPI_FOR8(ai, m) {
            const int row = EPI_ROW(ai, m), k = ai * 4 + m; const float r = rr[ai][m];
            if (rope && k < 7) Q_CS(nx, (k + 1) >> 2, (k + 1) & 3);
#pragma unroll
            for (int bj = 0; bj < 2; ++bj) {
                const int strip = bj ? st1 : st0, sm = bj ? sm1 : sm0;
                f32x4 v[2] = {acc[ai][bj][m][0] * r, acc[ai][bj][m][1] * r};
                if (sm >= 4) {
#pragma unroll
                    for (int n = 0; n < 2; ++n) { const f32x2 c = cs[n][0], s = cs[n][1]; const f32x4 x = v[n];
                        v[n] = (f32x4){x[0] * c.x - x[1] * s.x, x[0] * s.x + x[1] * c.x, x[2] * c.y - x[3] * s.y, x[2] * s.y + x[3] * c.y}; }
                }
                u32x4 w; w.x = cvt_pk_bf16(v[0][0], v[0][1]); w.y = cvt_pk_bf16(v[0][2], v[0][3]); w.z = cvt_pk_bf16(v[1][0], v[1][1]); w.w = cvt_pk_bf16(v[1][2], v[1][3]);
                *(u32x4*)(qb + (size_t)row * 1536 + strip * 32 + 8 * fq) = w;
            }
#pragma unroll
            for (int n = 0; n < 2; ++n) { cs[n][0] = nx[n][0]; cs[n][1] = nx[n][1]; }
        }
#undef Q_CS
    }
};
struct EpiScaleBf16 {
    static constexpr bool PERM = true, MIDSCALE = false;
    bf16_t* out; int ldo; const ssq_t* ssq; float inv_n;
    __device__ __forceinline__ void operator()(const f32x4 (&acc)[2][2][4][2], const Unit& u, int wr, int wc, int fr, int fq) const {
        float rr[2][4];
        EPI_FOR8(ai, m) rr[ai][m] = rms_scale(ssq, EPI_ROW(ai, m), inv_n);
        EPI_FOR8(ai, m) {
            const int row = EPI_ROW(ai, m); const float r = rr[ai][m];
#pragma unroll
            for (int bj = 0; bj < 2; ++bj) { const f32x4 v0 = acc[ai][bj][m][0] * r, v1 = acc[ai][bj][m][1] * r;
                u32x4 w; w.x = cvt_pk_bf16(v0[0], v0[1]); w.y = cvt_pk_bf16(v0[2], v0[3]); w.z = cvt_pk_bf16(v1[0], v1[1]); w.w = cvt_pk_bf16(v1[2], v1[3]);
                *(u32x4*)(out + (size_t)row * ldo + u.pn * BM + bj * HALF + wc * 32 + 8 * fq) = w; }
        }
    }
};
struct EpiGlu {
    static constexpr bool PERM = true, MIDSCALE = false;
    const bf16_t* gb; bf16_t* mix; float* psq_ssm;
    __device__ __forceinline__ void operator()(const f32x4 (&acc)[2][2][4][2], const Unit& u, int wr, int wc, int fr, int fq) const {
        constexpr float ZS = 1.0f / (F8_GS * F8_WGL);
        u32x4 gq[3][2];
#define GLU_LD(dst, ai, m) do { _Pragma("unroll") for (int bj = 0; bj < 2; ++bj) dst[bj] = *(const u32x4*)(gb + (size_t)EPI_ROW(ai, m) * SSMW + u.pn * BM + bj * HALF + wc * 32 + 8 * fq); } while (0)
        GLU_LD(gq[0], 0, 0); GLU_LD(gq[1], 0, 1);
        EPI_FOR8(ai, m) {
            const int row = EPI_ROW(ai, m), k = ai * 4 + m;
            if (k < 6) GLU_LD(gq[(k + 2) % 3], (k + 2) >> 2, (k + 2) & 3);
            float ss = 0.f;
#pragma unroll
            for (int bj = 0; bj < 2; ++bj) { const int col = u.pn * BM + bj * HALF + wc * 32 + 8 * fq;
                const u32x4 gv = gq[k % 3][bj]; const f32x4 z0 = acc[ai][bj][m][0] * ZS, z1 = acc[ai][bj][m][1] * ZS;
                u32x4 w; w.x = cvt_pk_bf16(bflo(gv.x) * sigmoidf_(z0[0]), bfhi(gv.x) * sigmoidf_(z0[1])); w.y = cvt_pk_bf16(bflo(gv.y) * sigmoidf_(z0[2]), bfhi(gv.y) * sigmoidf_(z0[3]));
                w.z = cvt_pk_bf16(bflo(gv.z) * sigmoidf_(z1[0]), bfhi(gv.z) * sigmoidf_(z1[1])); w.w = cvt_pk_bf16(bflo(gv.w) * sigmoidf_(z1[2]), bfhi(gv.w) * sigmoidf_(z1[3]));
                *(u32x4*)(mix + (size_t)row * 2048 + ATTW + col) = w;
                ss += (bflo(w.x) * bflo(w.x) + bfhi(w.x) * bfhi(w.x)) + (bflo(w.y) * bflo(w.y) + bfhi(w.y) * bfhi(w.y)) + (bflo(w.z) * bflo(w.z) + bfhi(w.z) * bfhi(w.z)) + (bflo(w.w) * bflo(w.w) + bfhi(w.w) * bfhi(w.w)); }
            ss = quad_sum(ss); if (fq == 0) psq_ssm[(size_t)row * 16 + u.pn * 4 + wc] = ss;
        }
#undef GLU_LD
    }
};
template <bool F8OUT, bool MIDS = false> struct EpiRes {
    static constexpr bool PERM = true, MIDSCALE = MIDS;
    float* h; bf16_t* hb; ssq_t* ssq; float* slab; float sc; const float* scl;
    const float* hin;
    float* psq;
    const float* psq_in; int nr;
    template <class Sched>
    __device__ __forceinline__ void prep(const Sched& S, int tid) const {
        float* sclw = const_cast<float*>(scl);
        for (int i = 0; ; ++i) { Unit u; if (!S.next(i, u)) break;
            const int row = u.pm * 256 + tid;
            if (tid < 256 && row < nr) {
                const f32x4 a0 = *(const f32x4*)(psq_in + (size_t)row * 8), a1 = *(const f32x4*)(psq_in + (size_t)row * 8 + 4);
                const float* ps = psq_in + (size_t)MP * 8 + (size_t)row * 16;
                const f32x4 s0 = *(const f32x4*)ps, s1 = *(const f32x4*)(ps + 4), s2 = *(const f32x4*)(ps + 8), s3 = *(const f32x4*)(ps + 12);
                const f32x4 sa = a0 + a1, sv = (s0 + s1) + (s2 + s3);
                const float ra = 1.0f / sqrtf(((sa[0] + sa[1]) + (sa[2] + sa[3])) * (1.0f / ATTW) + EPS), rs = 1.0f / sqrtf(((sv[0] + sv[1]) + (sv[2] + sv[3])) * (1.0f / SSMW) + EPS);
                sclw[row] = ra / rs; sclw[MP + row] = rs; } }
        VM_WAIT(); __syncthreads();
    }
    __device__ __forceinline__ void midscale(f32x4 (&acc)[2][2][4][2], const Unit& u, int wr, int fr) const {
        float f[2][4];
        EPI_FOR8(ai, m) f[ai][m] = scl[EPI_ROW(ai, m)];
        EPI_FOR8(ai, m) {
#pragma unroll
            for (int bj = 0; bj < 2; ++bj)
#pragma unroll
                for (int n = 0; n < 2; ++n) acc[ai][bj][m][n] *= f[ai][m]; }
    }
    __device__ __forceinline__ void operator()(const f32x4 (&acc)[2][2][4][2], const Unit& u, int wr, int wc, int fr, int fq) const {
        float fs[2][4];
        EPI_FOR8(ai, m) fs[ai][m] = MIDS ? scl[MP + EPI_ROW(ai, m)] * sc : sc;
        f32x4 hq[3][2][2];
#define RES_OFF(ai, m, bj, n) ((size_t)EPI_ROW(ai, m) * DM + u.pn * BM + (bj) * HALF + wc * 32 + 8 * fq + 4 * (n))
#define RES_LD(dst, ai, m) do { _Pragma("unroll") for (int bj = 0; bj < 2; ++bj) _Pragma("unroll") for (int n = 0; n < 2; ++n) dst[bj][n] = *(const f32x4*)(hin + RES_OFF(ai, m, bj, n)); } while (0)
        RES_LD(hq[0], 0, 0); RES_LD(hq[1], 0, 1);
        EPI_FOR8(ai, m) {
            const int row = EPI_ROW(ai, m), k = ai * 4 + m;
            if (k < 6) RES_LD(hq[(k + 2) % 3], (k + 2) >> 2, (k + 2) & 3);
            const bool real = row < MREAL; float ss = 0.f;
#pragma unroll
            for (int bj = 0; bj < 2; ++bj) { const size_t off = RES_OFF(ai, m, bj, 0); f32x4 v[2];
#pragma unroll
                for (int n = 0; n < 2; ++n) { v[n] = hq[k % 3][bj][n] + acc[ai][bj][m][n] * fs[ai][m]; if (!real) v[n] = (f32x4){0.f, 0.f, 0.f, 0.f};
                    *(f32x4*)(h + off + 4 * n) = v[n]; ss += (v[n][0] * v[n][0] + v[n][1] * v[n][1]) + (v[n][2] * v[n][2] + v[n][3] * v[n][3]); }
                if constexpr (F8OUT) { if (hb) { u32x2 w; w.x = pk4_fp8(v[0][0] * F8_HS, v[0][1] * F8_HS, v[0][2] * F8_HS, v[0][3] * F8_HS); w.y = pk4_fp8(v[1][0] * F8_HS, v[1][1] * F8_HS, v[1][2] * F8_HS, v[1][3] * F8_HS);
                    *(u32x2*)((unsigned char*)hb + off) = w; } }
                else { u32x4 w; w.x = cvt_pk_bf16(v[0][0], v[0][1]); w.y = cvt_pk_bf16(v[0][2], v[0][3]); w.z = cvt_pk_bf16(v[1][0], v[1][1]); w.w = cvt_pk_bf16(v[1][2], v[1][3]); *(u32x4*)(hb + off) = w; } }
            if (!F8OUT || hb) { ss = quad_sum(ss); if (fq == 0) psq[(size_t)row * 32 + u.pn * 4 + wc] = ss; }
        }
#undef RES_LD
#undef RES_OFF
    }
};
template <bool F8OUT> struct EpiGU {
    static constexpr bool PERM = true, MIDSCALE = false;
    bf16_t* act; int ldo; const float* rs;
    __device__ __forceinline__ void operator()(const f32x4 (&acc)[2][2][4][2], const Unit& u, int wr, int wc, int fr, int fq) const {
        float rr[2][4];
        EPI_FOR8(ai, m) rr[ai][m] = rs[u.roff + EPI_ROW(ai, m)];
        EPI_FOR8(ai, m) {
            const int row = EPI_ROW(ai, m);
            const float r = rr[ai][m], rl = r * -1.4426950408889634f, c2 = r * r * (F8OUT ? F8_AS : 1.0f);
            float o[8];
#pragma unroll
            for (int n = 0; n < 2; ++n)
#pragma unroll
                for (int j = 0; j < 4; ++j) { const float ag = acc[ai][0][m][n][j], au = acc[ai][1][m][n][j]; o[4 * n + j] = (ag * au) * (fast_rcp(1.0f + fast_exp2(ag * rl)) * c2); }
            if constexpr (F8OUT) { u32x2 w; w.x = pk4_fp8(o[0], o[1], o[2], o[3]); w.y = pk4_fp8(o[4], o[5], o[6], o[7]);
                *(u32x2*)((unsigned char*)act + (size_t)row * ldo + u.pn * HALF + wc * 32 + 8 * fq) = w; }
            else { u32x4 w; w.x = cvt_pk_bf16(o[0], o[1]); w.y = cvt_pk_bf16(o[2], o[3]); w.z = cvt_pk_bf16(o[4], o[5]); w.w = cvt_pk_bf16(o[6], o[7]);
                *(u32x4*)(act + (size_t)row * ldo + u.pn * HALF + wc * 32 + 8 * fq) = w; }
        }
    }
};
struct EpiMD {
    static constexpr bool PERM = true, MIDSCALE = false;
    bf16_t* y; const float* gperm;
    __device__ __forceinline__ void operator()(const f32x4 (&acc)[2][2][4][2], const Unit& u, int wr, int wc, int fr, int fq) const {
        float rr[2][4];
        EPI_FOR8(ai, m) rr[ai][m] = gperm[u.roff + EPI_ROW(ai, m)] * (1.0f / (F8_AS * F8_WDN));
        EPI_FOR8(ai, m) {
            const int row = EPI_ROW(ai, m); const float gt = rr[ai][m];
#pragma unroll
            for (int bj = 0; bj < 2; ++bj) { const f32x4 v0 = acc[ai][bj][m][0] * gt, v1 = acc[ai][bj][m][1] * gt;
                u32x4 w; w.x = cvt_pk_bf16(v0[0], v0[1]); w.y = cvt_pk_bf16(v0[2], v0[3]); w.z = cvt_pk_bf16(v1[0], v1[1]); w.w = cvt_pk_bf16(v1[2], v1[3]);
                *(u32x4*)(y + (size_t)row * DM + u.pn * BM + bj * HALF + wc * 32 + 8 * fq) = w; }
        }
    }
};
#undef EPI_ROW
#undef EPI_FOR8
}

#define XB_TMO      128
#define XB_XCNT(j)  (256  + 64 * (j))
#define XB_XSUB(j)  (1280 + 64 * (j))
#define XB_XGEN(j)  (2304 + 64 * (j))
#define XB_TOP      3328
#define XB_TOPGEN   3392
#define XCD_BAR_WORDS 3456
#define XB_SPIN_CAP (1u << 18)
__device__ __forceinline__ unsigned xb_ld(unsigned* p)              { return __hip_atomic_load(p, __ATOMIC_RELAXED, __HIP_MEMORY_SCOPE_AGENT); }
__device__ __forceinline__ unsigned xb_add(unsigned* p, unsigned v) { return __hip_atomic_fetch_add(p, v, __ATOMIC_RELAXED, __HIP_MEMORY_SCOPE_AGENT); }
__device__ __forceinline__ unsigned xb_xcc_id() { return (unsigned)__builtin_amdgcn_s_getreg((3 << 11) | 20) & 0xFu; }
#define XB_SPIN(cond, bar) do { unsigned _sp = 0; while (cond) { __builtin_amdgcn_s_sleep(1); \
    if ((++_sp & 255u) == 0u) { if (xb_ld(&(bar)[XB_TMO])) break; if (_sp > XB_SPIN_CAP) { atomicAdd(&(bar)[XB_TMO], 1u); break; } } } } while (0)
struct XcdBarrier { unsigned* bar; unsigned x; volatile LAS unsigned* st; };
__device__ __forceinline__ XcdBarrier xcd_barrier_post(unsigned* bar, volatile LAS unsigned* st) {
    XcdBarrier b; b.bar = bar; b.x = xb_xcc_id(); b.st = st;
    if (threadIdx.x == 0) (void)xb_add(&bar[XB_XCNT(b.x)], 1u);
    return b;
}
__device__ __forceinline__ void xcd_barrier_complete(unsigned* bar, unsigned x, unsigned& nloc, unsigned& nx) {
    const unsigned G = gridDim.x * gridDim.y * gridDim.z;
    unsigned sum, cnt, mine, sp = 0u;
    for (;;) {
        sum = 0u; cnt = 0u; mine = 0u;
#pragma unroll
        for (unsigned j = 0; j < 16; ++j) { const unsigned c = xb_ld(&bar[XB_XCNT(j)]); sum += c; cnt += (c > 0u) ? 1u : 0u; mine = (j == x) ? c : mine; }
        if (sum == G) break;
        __builtin_amdgcn_s_sleep(1);
        if ((++sp & 255u) == 0u) { if (xb_ld(&bar[XB_TMO])) break; if (sp > XB_SPIN_CAP) { atomicAdd(&bar[XB_TMO], 1u); break; } }
    }
    nloc = mine > 0u ? mine : 1u; nx = cnt > 0u ? cnt : 1u;
}
__device__ __forceinline__ void xcd_barrier(const XcdBarrier& b) {
    asm volatile("s_waitcnt vmcnt(0)" ::: "memory");
    __syncthreads();
    if (threadIdx.x == 0) {
        unsigned* bar = b.bar;
        __builtin_amdgcn_s_waitcnt(0);
        unsigned nloc = b.st[0], nx = b.st[1];
        if (nloc == 0u) { xcd_barrier_complete(bar, b.x, nloc, nx); b.st[0] = nloc; b.st[1] = nx; }
        const unsigned old = xb_add(&bar[XB_XSUB(b.x)], 1u);
        const unsigned gen = old / nloc, target = (gen + 1u) * nx;
        if (old == gen * nloc) {
            XB_SPIN(xb_ld(&bar[XB_XSUB(b.x)]) < (gen + 1u) * nloc, bar);
            __builtin_amdgcn_fence(__ATOMIC_RELEASE, "agent");
            asm volatile("s_waitcnt vmcnt(0)" ::: "memory");
#pragma unroll
            for (unsigned j = 0; j < 16; ++j) (void)xb_add(&bar[XB_XGEN(j)], 1u);
            XB_SPIN(xb_ld(&bar[XB_XGEN(b.x)]) < target, bar);
            __builtin_amdgcn_fence(__ATOMIC_ACQUIRE, "agent");
            asm volatile("s_waitcnt vmcnt(0)" ::: "memory");
        } else {
            asm volatile("buffer_inv sc1" ::: "memory");
            XB_SPIN(xb_ld(&bar[XB_XGEN(b.x)]) < target, bar);
            asm volatile("s_waitcnt vmcnt(0)" ::: "memory");
        }
    }
    __syncthreads();
}

constexpr int RING_BYTES = 131072;
constexpr int LDS_BYTES = 155648;
constexpr int MISC_OFF = LDS_BYTES - 256;
constexpr int NWAVES = 8, NTHR = 512;

struct Inputs { const float* p[29]; };

template <class MAP>
__device__ __forceinline__ void transpose_item(const float* __restrict__ W, int K, int N, bf16_t* __restrict__ WT, const float* __restrict__ gA, int splitK, const float* __restrict__ gB,
                                               LAS float* scr, int item, int lane, const MAP& map) {
    const int nblk = N / 32, kb = item / nblk, nb = item - kb * nblk, k0 = 64 * kb, n0 = 32 * nb;
    float v[32];
#pragma unroll
    for (int i = 0; i < 32; ++i) { const int kk = 2 * i + (lane >> 5); v[i] = W[(size_t)(k0 + kk) * N + n0 + (lane & 31)]; }
#pragma unroll
    for (int i = 0; i < 32; ++i) { const int kk = 2 * i + (lane >> 5); scr[kk * 33 + (lane & 31)] = v[i]; }
    LDS_WAIT(); asm volatile("" ::: "memory");
    const int c = lane & 7;
    const float* gp = gA ? (k0 < splitK ? gA + k0 : gB + (k0 - splitK)) : nullptr;
    float g[8];
#pragma unroll
    for (int j = 0; j < 8; ++j) g[j] = gp ? gp[8 * c + j] : 1.0f;
#pragma unroll
    for (int j = 0; j < 4; ++j) { const int n = (lane >> 3) + 8 * j; const LAS float* s = scr + (8 * c) * 33 + n;
        u32x4 o; o.x = cvt_pk_bf16(s[0 * 33] * g[0], s[1 * 33] * g[1]); o.y = cvt_pk_bf16(s[2 * 33] * g[2], s[3 * 33] * g[3]); o.z = cvt_pk_bf16(s[4 * 33] * g[4], s[5 * 33] * g[5]); o.w = cvt_pk_bf16(s[6 * 33] * g[6], s[7 * 33] * g[7]);
        *(u32x4*)(WT + (size_t)map(n0 + n) * K + k0 + 8 * c) = o; }
    LDS_WAIT(); asm volatile("" ::: "memory");
}
template <class MAP>
__device__ __forceinline__ void transpose_item8(const float* __restrict__ W, int K, int N, unsigned char* __restrict__ WT, int pitch, const float* __restrict__ gA, float wscale,
                                                LAS float* scr, int item, int lane, const MAP& map) {
    const int nblk = N / 32, kb = item / nblk, nb = item - kb * nblk, k0 = 64 * kb, n0 = 32 * nb;
    float v[32];
#pragma unroll
    for (int i = 0; i < 32; ++i) { const int kk = 2 * i + (lane >> 5); v[i] = W[(size_t)(k0 + kk) * N + n0 + (lane & 31)]; }
#pragma unroll
    for (int i = 0; i < 32; ++i) { const int kk = 2 * i + (lane >> 5); scr[kk * 33 + (lane & 31)] = v[i]; }
    LDS_WAIT(); asm volatile("" ::: "memory");
    const int c = lane >> 4, nl = lane & 15;
    float g[16];
#pragma unroll
    for (int j = 0; j < 16; ++j) g[j] = (gA ? gA[k0 + 16 * c + j] : 1.0f) * wscale;
#pragma unroll
    for (int j2 = 0; j2 < 2; ++j2) { const int n = nl + 16 * j2; const LAS float* s = scr + (16 * c) * 33 + n;
        u32x4 o; o.x = pk4_fp8(s[0 * 33] * g[0], s[1 * 33] * g[1], s[2 * 33] * g[2], s[3 * 33] * g[3]); o.y = pk4_fp8(s[4 * 33] * g[4], s[5 * 33] * g[5], s[6 * 33] * g[6], s[7 * 33] * g[7]);
        o.z = pk4_fp8(s[8 * 33] * g[8], s[9 * 33] * g[9], s[10 * 33] * g[10], s[11 * 33] * g[11]); o.w = pk4_fp8(s[12 * 33] * g[12], s[13 * 33] * g[13], s[14 * 33] * g[14], s[15 * 33] * g[15]);
        *(u32x4*)(WT + (size_t)map(n0 + n) * pitch + k0 + 16 * c) = o; }
    LDS_WAIT(); asm volatile("" ::: "memory");
}
struct MapId { __device__ __forceinline__ int operator()(int n) const { return n; } };
struct MapWin {
    __device__ __forceinline__ int operator()(int n) const { if (n < 768) return n; if (n < 832) { const int i = n - 768; return 768 + (i < 32 ? 2 * i : 2 * (i - 32) + 1); } return 1024 + (n - 832); } };
struct MapWuq {
    __device__ __forceinline__ int operator()(int n) const { const int hd = n / DQK, d = n - hd * DQK; if (d < DNOPE) return n; const int i = d - DNOPE; return hd * DQK + DNOPE + (i < 32 ? 2 * i : 2 * (i - 32) + 1); } };
struct MapGU {
    int sel; __device__ __forceinline__ int operator()(int n) const { return 256 * (n >> 7) + 128 * sel + (n & 127); } };

template <class MAP>
__device__ __forceinline__ void transpose_matrix(const float* W, int K, int N, bf16_t* WT, const float* gA, int splitK, const float* gB, LAS float* scr, int lane, int gw, int ngw, int& base, const MAP& map) {
    const int nit = (K / 64) * (N / 32);
    int first = gw - (base % ngw); if (first < 0) first += ngw;
    for (int it = first; it < nit; it += ngw) transpose_item(W, K, N, WT, gA, splitK, gB, scr, it, lane, map);
    base += nit;
}

template <class MAP>
__device__ __forceinline__ void transpose_matrix8(const float* W, int K, int N, unsigned char* WT, const float* gA, float wscale, LAS float* scr, int lane, int gw, int ngw, int& base, const MAP& map, int pitch = 0) {
    const int nit = (K / 64) * (N / 32); if (pitch == 0) pitch = K;
    int first = gw - (base % ngw); if (first < 0) first += ngw;
    for (int it = first; it < nit; it += ngw) transpose_item8(W, K, N, WT, pitch, gA, wscale, scr, it, lane, map);
    base += nit;
}

struct PendItem { float v[32]; f32x4 g[4]; unsigned char* dst; int rstride; int fmt; };
__device__ __forceinline__ void item_finish(const PendItem& p, LAS float* scr, int lane) {
#pragma unroll
    for (int i = 0; i < 32; ++i) { const int kk = 2 * i + (lane >> 5); scr[kk * 33 + (lane & 31)] = p.v[i]; }
    LDS_WAIT(); asm volatile("" ::: "memory");
    if (p.fmt == 1) {
        const int c = lane & 7; const float g[8] = {p.g[0][0], p.g[0][1], p.g[0][2], p.g[0][3], p.g[1][0], p.g[1][1], p.g[1][2], p.g[1][3]};
#pragma unroll
        for (int j = 0; j < 4; ++j) { const int n = (lane >> 3) + 8 * j; const LAS float* s = scr + (8 * c) * 33 + n;
            u32x4 o; o.x = cvt_pk_bf16(s[0 * 33] * g[0], s[1 * 33] * g[1]); o.y = cvt_pk_bf16(s[2 * 33] * g[2], s[3 * 33] * g[3]); o.z = cvt_pk_bf16(s[4 * 33] * g[4], s[5 * 33] * g[5]); o.w = cvt_pk_bf16(s[6 * 33] * g[6], s[7 * 33] * g[7]);
            *(u32x4*)(p.dst + (size_t)n * p.rstride + 16 * c) = o; }
    } else {
        const int c = lane >> 4, nl = lane & 15; float g[16];
#pragma unroll
        for (int j = 0; j < 16; ++j) g[j] = p.g[j >> 2][j & 3];
#pragma unroll
        for (int j2 = 0; j2 < 2; ++j2) { const int n = nl + 16 * j2; const LAS float* s = scr + (16 * c) * 33 + n;
            u32x4 o; o.x = pk4_fp8(s[0 * 33] * g[0], s[1 * 33] * g[1], s[2 * 33] * g[2], s[3 * 33] * g[3]); o.y = pk4_fp8(s[4 * 33] * g[4], s[5 * 33] * g[5], s[6 * 33] * g[6], s[7 * 33] * g[7]);
            o.z = pk4_fp8(s[8 * 33] * g[8], s[9 * 33] * g[9], s[10 * 33] * g[10], s[11 * 33] * g[11]); o.w = pk4_fp8(s[12 * 33] * g[12], s[13 * 33] * g[13], s[14 * 33] * g[14], s[15 * 33] * g[15]);
            *(u32x4*)(p.dst + (size_t)n * p.rstride + 16 * c) = o; }
    }
    LDS_WAIT(); asm volatile("" ::: "memory");
}
template <class MAP>
__device__ __forceinline__ void convert_matrix(PendItem& pend, const float* W, int K, int N, unsigned char* WT, int pitchB, int fmt, const float* gA, int splitK, const float* gB, float wscale,
                                               LAS float* scr, int lane, int gw, int ngw, int& base, const MAP& map) {
    const int nblk = N / 32, nit = (K / 64) * nblk, esize = fmt == 1 ? 2 : 1;
    int first = gw - (base % ngw); if (first < 0) first += ngw;
    for (int it = first; it < nit; it += ngw) {
        const int kb = it / nblk, nb = it - kb * nblk, k0 = 64 * kb, n0 = 32 * nb;
        float nv[32];
#pragma unroll
        for (int i = 0; i < 32; ++i) { const int kk = 2 * i + (lane >> 5); nv[i] = W[(size_t)(k0 + kk) * N + n0 + (lane & 31)]; }
        if (pend.fmt) item_finish(pend, scr, lane);
#pragma unroll
        for (int i = 0; i < 32; ++i) pend.v[i] = nv[i];
        const int r0 = map(n0);
        pend.dst = WT + (size_t)r0 * pitchB + (size_t)k0 * esize; pend.rstride = (map(n0 + 1) - r0) * pitchB;
        const float* gq = gA ? (k0 < splitK ? gA + k0 : gB + (k0 - splitK)) : W; const int goff = fmt == 1 ? 8 * (lane & 7) : 16 * (lane >> 4);
        f32x4 gv[4]; gv[0] = *(const f32x4*)(gq + goff); gv[1] = *(const f32x4*)(gq + goff + 4);
        if (fmt == 2) { gv[2] = *(const f32x4*)(gq + goff + 8); gv[3] = *(const f32x4*)(gq + goff + 12); } else { gv[2] = gv[0]; gv[3] = gv[1]; }
#pragma unroll
        for (int j = 0; j < 4; ++j) pend.g[j] = gA ? gv[j] * wscale : (f32x4){wscale, wscale, wscale, wscale};
        pend.fmt = fmt;
    }
    base += nit;
}

constexpr int IT_DENSE_M = (DM / 64) * (DFF / 32), IT_DENSE = 3 * IT_DENSE_M;
constexpr int IT_EXP_M = (DM / 64) * (DFE / 32), IT_EXP = 3 * IT_EXP_M, IT_MOE = NE * IT_EXP;
static_assert((DFF / 64) * (DM / 32) == IT_DENSE_M && (DFE / 64) * (DM / 32) == IT_EXP_M, "gate/up and down matrices have equal item counts");
#ifndef TAIL_BUDGET
#define TAIL_BUDGET 2
#endif
#ifndef GU_BUDGET
#define GU_BUDGET 10
#endif
#ifndef MDN_BUDGET
#define MDN_BUDGET 7
#endif
__device__ __forceinline__ int cap_mdn(int G) { return G == 256 ? (G - 64) * NWAVES * MDN_BUDGET : 0; }
#ifndef S5E_BUDGET
#define S5E_BUDGET 6
#endif
__device__ __forceinline__ int cap_s5e(int G) { return G == 256 ? 50 * NWAVES * S5E_BUDGET : 0; }
__device__ __forceinline__ int set_total(int set) { return set == 2 ? IT_DENSE : IT_MOE; }
__device__ __forceinline__ int cap_tail(int G, int ntail) { return (G > ntail ? G - ntail : 0) * NWAVES * TAIL_BUDGET; }
__device__ __forceinline__ int gu_short(int G) { const int rem = ((MP / 256) * (2 * DFF / 256)) % G; return rem ? G - rem : 0; }
__device__ __forceinline__ int cap_gu(int G) { return gu_short(G) * NWAVES * GU_BUDGET; }
__device__ __forceinline__ int slot_begin(int s, int G) { int o = 0; if (s > 0) o += cap_tail(G, 64); if (s > 1) o += cap_tail(G, 64); if (s == 3 || s == 5) o += cap_gu(G); if (s == 5) o += cap_tail(G, 88); return o; }
__device__ __forceinline__ int slot_cap(int s, int G) { return s < 2 ? cap_tail(G, 64) : (s == 2 ? cap_gu(G) : (s == 3 ? cap_tail(G, 88) : (s == 4 ? cap_mdn(G) : cap_s5e(G)))); }
__device__ __forceinline__ int set_deferred(int set, int G) { const int l = set - 1; int o = 2 * cap_tail(G, 64); if ((l & 1) == 0) o += cap_gu(G) + cap_tail(G, 88) + cap_s5e(G); else o += cap_mdn(G); const int t = set_total(set); return o < t ? o : t; }
struct FfnSrc { const float* fn; const float* dg; const float* du; const float* dd; const float* mg; const float* mu; const float* md; };
#define TO_GLOBAL(T, p) ((T)({ GAS void* _g = (GAS void*)(p); asm volatile("" : "+v"(_g)); _g; }))
__device__ __forceinline__ void ffn_convert_range(int set, int t0, int t1, int jw, int nw, const FfnSrc& src, unsigned char* ws, LAS float* scr, int lane) {
    PendItem pend; pend.fmt = 0; pend.dst = nullptr; pend.rstride = 0;
#pragma unroll
    for (int i = 0; i < 32; ++i) pend.v[i] = 0.f;
#pragma unroll
    for (int j = 0; j < 4; ++j) pend.g[j] = (f32x4){0.f, 0.f, 0.f, 0.f};
    for (int t = t0 + jw; t < t1; t += nw) {
        const float* W; const float* gn; unsigned char* WT; int K, N, pitch, sel, local; float wscale;
        if (set == 2) { const int m = t / IT_DENSE_M; local = t - m * IT_DENSE_M; unsigned char* wd = ws + WS_WFF + SZ_DENSE;
            if (m < 2) { W = (m ? src.du : src.dg) + (size_t)DM * DFF; K = DM; N = DFF; WT = wd; pitch = DM; gn = src.fn + 2 * DM; wscale = F8_WGU; sel = m; }
            else { W = src.dd + (size_t)DFF * DM; K = DFF; N = DM; WT = wd + SZ_DGU; pitch = DFF; gn = nullptr; wscale = F8_WDN; sel = -1; } }
        else { const int i = set == 1 ? 0 : 1, e = t / IT_EXP, r = t - e * IT_EXP, m = r / IT_EXP_M; local = r - m * IT_EXP_M;
            unsigned char* we = ws + WS_WFF + 2 * SZ_DENSE + (size_t)i * SZ_MOE + (size_t)e * SZ_EXP;
            if (m < 2) { W = (m ? src.mu : src.mg) + (size_t)(i * NE + e) * DM * DFE; K = DM; N = DFE; WT = we; pitch = DM; gn = src.fn + (2 * i + 1) * DM; wscale = F8_WGU; sel = m; }
            else { W = src.md + (size_t)(i * NE + e) * DFE * DM; K = DFE; N = DM; WT = we + SZ_EGU; pitch = DFEP; gn = nullptr; wscale = F8_WDN; sel = -1; } }
        (void)K;
        W = TO_GLOBAL(const float*, W);
        const int nblk = N / 32, kb = local / nblk, nb = local - kb * nblk, k0 = 64 * kb, n0 = 32 * nb;
        float nv[32];
#pragma unroll
        for (int i = 0; i < 32; ++i) { const int kk = 2 * i + (lane >> 5); nv[i] = W[(size_t)(k0 + kk) * N + n0 + (lane & 31)]; }
        if (pend.fmt) item_finish(pend, scr, lane);
#pragma unroll
        for (int i = 0; i < 32; ++i) pend.v[i] = nv[i];
        const int r0 = sel >= 0 ? 256 * (n0 >> 7) + 128 * sel + (n0 & 127) : n0;
        pend.dst = (unsigned char*)TO_GLOBAL(unsigned char*, WT + (size_t)r0 * pitch + k0); pend.rstride = pitch;
        const float* gq = TO_GLOBAL(const float*, gn ? gn + k0 : W); const int goff = 16 * (lane >> 4);
        f32x4 gv[4];
#pragma unroll
        for (int j = 0; j < 4; ++j) gv[j] = *(const f32x4*)(gq + goff + 4 * j);
#pragma unroll
        for (int j = 0; j < 4; ++j) pend.g[j] = gn ? gv[j] * wscale : (f32x4){wscale, wscale, wscale, wscale};
        pend.fmt = 2;
    }
    if (pend.fmt) item_finish(pend, scr, lane);
}

__device__ __forceinline__ void ffn_slot(int l, int s, int G, int c, int tid, const float* const* itab, unsigned char* ws, LAS unsigned char* lds) {
    if (l >= DEPTH - 1) return;
    asm volatile("" : "+s"(G), "+s"(l));
    const int set = l + 1, lane = tid & 63, wave = tid >> 6;
    int first_idle, nidle;
    if (s == 2) { nidle = gu_short(G); first_idle = G - nidle; } else { const int nt = s == 3 ? 88 : 64; first_idle = nt < G ? nt : G; nidle = G - first_idle; }
    if ((s == 4 || s == 5) && G != 256) return;
    if (s == 5) { if (l & 1) return; first_idle = 206; nidle = 50; }
    if (c < first_idle || nidle == 0) return;
    const int t0 = slot_begin(s, G), dl = set_deferred(set, G); int t1 = t0 + slot_cap(s, G); if (t1 > dl) t1 = dl;
    if (t0 >= t1) return;
    const FfnSrc src{itab[20], itab[21], itab[22], itab[23], itab[25], itab[26], itab[27]};
    ffn_convert_range(set, t0, t1, (c - first_idle) * NWAVES + wave, nidle * NWAVES, src, ws, (LAS float*)(lds + wave * 8704), lane);
}

__device__ __forceinline__ void prologue_phase(const Inputs& in_, unsigned char* ws, LAS unsigned char* lds, int tid, int G) {
    const int lane = tid & 63, wave = tid >> 6, gw = blockIdx.x * NWAVES + wave, ngw = G * NWAVES;
    LAS float* scr = (LAS float*)(lds + wave * 8704);
    Inputs in;
#pragma unroll
    for (int k = 0; k < 29; ++k) in.p[k] = (const float*)(GAS const void*)in_.p[k];
    ws = (unsigned char*)(GAS void*)ws;
    {
        float* h = (float*)(ws + WS_H); bf16_t* hb = (bf16_t*)(ws + WS_HB); ssq_t* ssq = (ssq_t*)(ws + CTL_SSQ) + (size_t)SSQ_H1(0) * MP;
        for (int row = gw; row < MP; row += ngw) {
            const float* src = row < MX ? in.p[0] + (size_t)row * DM : (row < MREAL ? in.p[1] + (size_t)((row - MX) & (NMETA - 1)) * DM : nullptr);
            float ss = 0.f;
#pragma unroll
            for (int jj = 0; jj < 4; ++jj) { const int c = 8 * lane + 512 * jj;
                const f32x4 v = src ? *(const f32x4*)(src + c) : (f32x4){0.f, 0.f, 0.f, 0.f}, v2 = src ? *(const f32x4*)(src + c + 4) : (f32x4){0.f, 0.f, 0.f, 0.f};
                if (row >= MX) { *(f32x4*)(h + (size_t)row * DM + c) = v; *(f32x4*)(h + (size_t)row * DM + c + 4) = v2; }
                u32x4 w; w.x = cvt_pk_bf16(v[0], v[1]); w.y = cvt_pk_bf16(v[2], v[3]); w.z = cvt_pk_bf16(v2[0], v2[1]); w.w = cvt_pk_bf16(v2[2], v2[3]); *(u32x4*)(hb + (size_t)row * DM + c) = w;
                ss += (v[0] * v[0] + v[1] * v[1]) + (v[2] * v[2] + v[3] * v[3]) + (v2[0] * v2[0] + v2[1] * v2[1]) + (v2[2] * v2[2] + v2[3] * v2[3]); }
            ss = wave_sum(ss); if (lane == 0) ssq[row] = ssq_fix(ss);
        }
    }
    { bf16_t* proj = (bf16_t*)(ws + WS_PROJ); bf16_t* kpe = (bf16_t*)(ws + WS_KPE);
      for (int row = MREAL + gw; row < MP; row += ngw) {
#pragma unroll
          for (int j = 0; j < 4; ++j) *(u32x4*)(proj + (size_t)row * PROJW + 512 * j + 8 * lane) = (u32x4){0u, 0u, 0u, 0u};
          if (lane < 8) *(u32x4*)(kpe + (size_t)row * 64 + 8 * lane) = (u32x4){0u, 0u, 0u, 0u}; } }
    {
        float* cosb = (float*)(ws + WS_ROPE); float* sinb = cosb + LTOK * 32;
        for (int i = gw * 64 + lane; i < LTOK * 32; i += ngw * 64) { const int t = i >> 5, k = i & 31;
            const float inv = powf(10000.0f, -(float)(2 * k) / 64.0f); const float ang = (float)t * inv; cosb[i] = cosf(ang); sinb[i] = sinf(ang); }
    }
    for (int i = gw * 64 + lane; i < DEPTH * 2 * NG * NS; i += ngw * 64) {
        const int p = i & 63, ldg = i >> 6;
        unsigned char* tb = ws + WS_S5 + (size_t)ldg * S5_STRIDE;
        const float lr = in.p[8][i], li = in.p[9][i], dt = expf(in.p[10][ldg]);
        const float mag = expf(lr * dt), ar = mag * cosf(li * dt), ai = mag * sinf(li * dt);
        ((f32x2*)(tb + S5_LAM))[p] = (f32x2){ar, ai};
        const float den = 1.0f / (lr * lr + li * li), xr = ar - 1.0f, xi = ai;
        const float fr_ = (xr * lr + xi * li) * den, fi_ = (xi * lr - xr * li) * den;
        const float* bre = in.p[11] + (size_t)i * GS; const float* bim = in.p[12] + (size_t)i * GS;
        bf16_t* ore = (bf16_t*)(tb + S5_BRE) + p * GS; bf16_t* oim = (bf16_t*)(tb + S5_BIM) + p * GS;
#pragma unroll
        for (int c = 0; c < GS; c += 2) { const float r0 = fr_ * bre[c] - fi_ * bim[c], i0 = fr_ * bim[c] + fi_ * bre[c], r1 = fr_ * bre[c + 1] - fi_ * bim[c + 1], i1 = fr_ * bim[c + 1] + fi_ * bre[c + 1];
            *(unsigned*)(ore + c) = cvt_pk_bf16(r0, r1); *(unsigned*)(oim + c) = cvt_pk_bf16(i0, i1); }
        const float* cre = in.p[13] + (size_t)ldg * GS * NS; const float* cim = in.p[14] + (size_t)ldg * GS * NS; bf16_t* ce = (bf16_t*)(tb + S5_CEF);
#pragma unroll
        for (int co = 0; co < GS; ++co) *(unsigned*)(ce + co * 128 + 2 * p) = cvt_pk_bf16(cre[co * NS + p], -cim[co * NS + p]);
    }
    int base = 0;
    PendItem pend; pend.fmt = 0; pend.dst = nullptr; pend.rstride = 0;
#pragma unroll
    for (int i = 0; i < 32; ++i) pend.v[i] = 0.f;
#pragma unroll
    for (int j = 0; j < 4; ++j) pend.g[j] = (f32x4){0.f, 0.f, 0.f, 0.f};
    for (int l = 0; l < DEPTH; ++l) {
        unsigned char* wl = ws + WS_W + (size_t)l * SZ_LAYER;
        convert_matrix(pend, in.p[3] + (size_t)l * DM * INC, DM, INC, wl + OFF_WIN, DM * 2, 1, in.p[2] + l * DM, 1 << 30, nullptr, 1.0f, scr, lane, gw, ngw, base, MapWin());
        convert_matrix(pend, in.p[5] + (size_t)l * QL * 1536, QL, 1536, wl + OFF_WUQ, QL * 2, 1, in.p[4] + l * QL, 1 << 30, nullptr, 1.0f, scr, lane, gw, ngw, base, MapWuq());
        convert_matrix(pend, in.p[7] + (size_t)l * KVL * 2048, KVL, 2048, wl + OFF_WUKV, KVL * 2, 1, in.p[6] + l * KVL, 1 << 30, nullptr, 1.0f, scr, lane, gw, ngw, base, MapId());
        convert_matrix(pend, in.p[16] + (size_t)l * SSMW * SSMW, SSMW, SSMW, wl + OFF_WGLU, SSMW, 2, nullptr, 0, nullptr, F8_WGL, scr, lane, gw, ngw, base, MapId());
        convert_matrix(pend, in.p[19] + (size_t)l * DM * DM, DM, DM, wl + OFF_WOUT, DM * 2, 1, in.p[17] + l * ATTW, ATTW, in.p[18] + l * SSMW, 1.0f, scr, lane, gw, ngw, base, MapId());
    }
    for (int i = 0; i < 1; ++i) {
        unsigned char* wd = ws + WS_WFF + (size_t)i * SZ_DENSE; const float* gn = in.p[20] + (size_t)(2 * i) * DM;
        convert_matrix(pend, in.p[21] + (size_t)i * DM * DFF, DM, DFF, wd, DM, 2, gn, 1 << 30, nullptr, F8_WGU, scr, lane, gw, ngw, base, MapGU{0});
        convert_matrix(pend, in.p[22] + (size_t)i * DM * DFF, DM, DFF, wd, DM, 2, gn, 1 << 30, nullptr, F8_WGU, scr, lane, gw, ngw, base, MapGU{1});
        convert_matrix(pend, in.p[23] + (size_t)i * DFF * DM, DFF, DM, wd + SZ_DGU, DFF, 2, nullptr, 0, nullptr, F8_WDN, scr, lane, gw, ngw, base, MapId());
    }
    if (pend.fmt) item_finish(pend, scr, lane);
    pend.fmt = 0;
    { FfnSrc src{in.p[20], in.p[21], in.p[22], in.p[23], in.p[25], in.p[26], in.p[27]};
      for (int set = 1; set <= 3; ++set) ffn_convert_range(set, set_deferred(set, G), set_total(set), gw, ngw, src, ws, scr, lane); }
    for (int i = 0; i < 2 * NE; ++i) { unsigned char* we = ws + WS_WFF + 2 * SZ_DENSE + (size_t)i * SZ_EXP;
        for (int r = gw; r < DM; r += ngw) if (lane < 8) *(u32x4*)(we + SZ_EGU + (size_t)r * DFEP + DFE + 16 * lane) = (u32x4){0u, 0u, 0u, 0u}; }
}

constexpr int S5_HROW = 304;
constexpr int S5_POFF = 2 * 2 * 32 * S5_HROW;
constexpr int S5_NCH = 66, S5_LP = S5_NCH * 32;
#define WG_BAR() do { LDS_WAIT(); __builtin_amdgcn_s_barrier(); asm volatile("" ::: "memory"); } while (0)
__device__ __forceinline__ void s5_phase(const unsigned char* ws_tab, const bf16_t* proj, unsigned char* g8, bf16_t* gb, const float* dskip, int l, LAS unsigned char* lds, int tid, int G) {
    const int lane = tid & 63, wid = __builtin_amdgcn_readfirstlane(tid >> 6);
    for (int unit0 = blockIdx.x; unit0 < NBATCH * NG; unit0 += G) {
        const int unit = (G == 256) ? ((unit0 & 7) << 5) | (unit0 >> 3) : unit0;
        const int b = unit >> 6, g = unit & 63;
        if (wid < 4) {
            const int d = wid >> 1, pt = wid & 1, pl = lane & 31, hh = lane >> 5, p = 32 * pt + pl;
            const unsigned char* tb = ws_tab + (size_t)((l * 2 + d) * NG + g) * S5_STRIDE;
            const f32x2 lam = ((const f32x2*)(tb + S5_LAM))[p];
            const bf16x8 Bre = *(const bf16x8*)(tb + S5_BRE + (p * GS + 8 * hh) * 2), Bim = *(const bf16x8*)(tb + S5_BIM + (p * GS + 8 * hh) * 2);
            float pr[4], pi[4]; pr[0] = lam.x; pi[0] = lam.y;
#pragma unroll
            for (int k = 1; k < 4; ++k) { pr[k] = pr[k - 1] * lam.x - pi[k - 1] * lam.y; pi[k] = pr[k - 1] * lam.y + pi[k - 1] * lam.x; }
            const float l4r = pr[3], l4i = pi[3], l8r = l4r * l4r - l4i * l4i, l8i = 2.f * l4r * l4i, l12r = l8r * l4r - l8i * l4i, l12i = l8r * l4i + l8i * l4r, l16r = l8r * l8r - l8i * l8i, l16i = 2.f * l8r * l8i;
            float Hr = 0.f, Hi = 0.f;
            const int arow = lane & 31, ipos = 16 * ((arow >> 2) & 1) + 4 * (arow & 3) + (arow >> 3), kh = lane >> 5;
            const bf16_t* ubase = proj + 1024 + GS * g + 8 * kh;
#define S5_UROW(it_) ({ const int tau_ = 32 * (it_) + ipos, t_ = d ? (S5_LP - 1 - tau_) : tau_; (size_t)tok_row(b, t_ < LTOK ? t_ : 0) * PROJW; })
#define S5_UOK(it_) ({ const int tau_ = 32 * (it_) + ipos, t_ = d ? (S5_LP - 1 - tau_) : tau_; t_ < LTOK; })
            bf16x8 aq[4];
#pragma unroll
            for (int k = 0; k < 4; ++k) aq[k] = *(const bf16x8*)(ubase + S5_UROW(k));
            for (int it0 = 0; it0 <= S5_NCH; it0 += 4) {
#pragma unroll
              for (int kq = 0; kq < 4; ++kq) { const int it = it0 + kq;
               if (it <= S5_NCH) {
                if (it < S5_NCH) {
                    const bf16x8 a = S5_UOK(it) ? aq[kq] : (bf16x8){0, 0, 0, 0, 0, 0, 0, 0};
                    f32x16 are = {}, aim = {};
                    are = __builtin_amdgcn_mfma_f32_32x32x16_bf16(a, Bre, are, 0, 0, 0);
                    aim = __builtin_amdgcn_mfma_f32_32x32x16_bf16(a, Bim, aim, 0, 0, 0);
                    aq[kq] = *(const bf16x8*)(ubase + S5_UROW(it + 4 < S5_NCH ? it + 4 : it));
#define CMA(or_, oi_, ar_, ai_, br_, bi_, cr_, ci_) do { or_ = fmaf(ar_, br_, fmaf(-(ai_), bi_, cr_)); oi_ = fmaf(ar_, bi_, fmaf(ai_, br_, ci_)); } while (0)
#define CMA2(or_, oi_, ar_, ai_, br_, bi_, cr_, ci_) do { const f32x2 _tr = (br_) * (ar_) + (cr_), _ti = (bi_) * (ar_) + (ci_); or_ = _tr - (bi_) * (ai_); oi_ = _ti + (br_) * (ai_); } while (0)
                    f32x2 XR[4][2], XI[4][2];
#pragma unroll
                    for (int j = 0; j < 4; ++j)
#pragma unroll
                        for (int q = 0; q < 2; ++q) { XR[j][q] = (f32x2){are[4 * j + 2 * q], are[4 * j + 2 * q + 1]}; XI[j][q] = (f32x2){aim[4 * j + 2 * q], aim[4 * j + 2 * q + 1]}; }
#pragma unroll
                    for (int j = 1; j < 4; ++j)
#pragma unroll
                        for (int q = 0; q < 2; ++q) { f32x2 nr, ni; CMA2(nr, ni, lam.x, lam.y, XR[j - 1][q], XI[j - 1][q], XR[j][q], XI[j][q]); XR[j][q] = nr; XI[j][q] = ni; }
                    const float e0r = XR[3][0].x, e0i = XI[3][0].x, e1r = XR[3][0].y, e1i = XI[3][0].y, e2r = XR[3][1].x, e2i = XI[3][1].x, e3r = XR[3][1].y, e3i = XI[3][1].y;
                    float er, ei, t1r, t1i; CMA(er, ei, l4r, l4i, e2r, e2i, e3r, e3i); CMA(t1r, t1i, l12r, l12i, e0r, e0i, er, ei); CMA(er, ei, l8r, l8i, e1r, e1i, t1r, t1i);
                    const float Eor = swap32(er, hh), Eoi = swap32(ei, hh);
                    float i0r = Hr, i0i = Hi; if (hh) CMA(i0r, i0i, l16r, l16i, Hr, Hi, Eor, Eoi);
                    float i1r, i1i, i2r, i2i, i3r, i3i; CMA(i1r, i1i, l4r, l4i, i0r, i0i, e0r, e0i); CMA(i2r, i2i, l4r, l4i, i1r, i1i, e1r, e1i); CMA(i3r, i3i, l4r, l4i, i2r, i2i, e2r, e2i);
                    const f32x2 INR[2] = {(f32x2){i0r, i1r}, (f32x2){i2r, i3r}}, INI[2] = {(f32x2){i0i, i1i}, (f32x2){i2i, i3i}};
                    LAS unsigned char* hrow = lds + (size_t)(((it & 1) * 2 + d) * 32 + 16 * hh) * S5_HROW + 4 * p;
                    if (pt == 0) *(LAS bf16x8*)(lds + (size_t)(((it & 1) * 2 + d) * 32 + ipos) * S5_HROW + 256 + 16 * kh) = a;
                    float cr = 0.f, ci = 0.f;
#pragma unroll
                    for (int j = 0; j < 4; ++j)
#pragma unroll
                        for (int q = 0; q < 2; ++q) { f32x2 hr2, hi2; CMA2(hr2, hi2, pr[j], pi[j], INR[q], INI[q], XR[j][q], XI[j][q]);
                            *(LAS unsigned*)(hrow + (4 * (2 * q) + j) * S5_HROW) = cvt_pk_bf16(hr2.x, hi2.x); *(LAS unsigned*)(hrow + (4 * (2 * q + 1) + j) * S5_HROW) = cvt_pk_bf16(hr2.y, hi2.y);
                            if (j == 3 && q == 1) { cr = hr2.y; ci = hi2.y; } }
#undef CMA
#undef CMA2
                    const float ocr = swap32(cr, hh), oci = swap32(ci, hh);
                    Hr = hh ? cr : ocr; Hi = hh ? ci : oci;
                }
                WG_BAR();
               }
              }
            }
        } else {
            const int cw = wid - 4, d = cw >> 1, tt = cw & 1, tk = lane & 15, q = lane >> 4;
            const unsigned char* tb = ws_tab + (size_t)((l * 2 + d) * NG + g) * S5_STRIDE;
            bf16x8 Cf[4];
#pragma unroll
            for (int ks = 0; ks < 4; ++ks) Cf[ks] = *(const bf16x8*)(tb + S5_CEF + (tk * 128 + 32 * ks + 8 * q) * 2);
            bf16x8 Dfrag = {0, 0, 0, 0, 0, 0, 0, 0};
            if (d == 0 && q < 2) { const float dv = dskip[GS * g + tk]; const unsigned short db = (unsigned short)(cvt_pk_bf16(dv, 0.f) & 0xffffu);
#pragma unroll
                for (int jj = 0; jj < 8; ++jj) Dfrag[jj] = (8 * q + jj == tk) ? (short)db : (short)0; }
            LAS unsigned char* part = lds + S5_POFF;
            for (int it = 0; it <= S5_NCH; ++it) {
                if (it >= 1) {
                    const int s = it - 1;
                    const LAS unsigned char* hrow = lds + (size_t)(((s & 1) * 2 + d) * 32 + 16 * tt + tk) * S5_HROW;
                    f32x4 acc = {0.f, 0.f, 0.f, 0.f};
#pragma unroll
                    for (int ks = 0; ks < 4; ++ks) { const bf16x8 hf = *(const LAS bf16x8*)(hrow + 16 * q + 64 * ks); acc = __builtin_amdgcn_mfma_f32_16x16x32_bf16(Cf[ks], hf, acc, 0, 0, 0); }
                    if (d == 0) { bf16x8 uf = {0, 0, 0, 0, 0, 0, 0, 0}; if (q < 2) uf = *(const LAS bf16x8*)(hrow + 256 + 16 * q); acc = __builtin_amdgcn_mfma_f32_16x16x32_bf16(Dfrag, uf, acc, 0, 0, 0); }
                    const int tau = 32 * s + 16 * tt + tk, t = d ? (S5_LP - 1 - tau) : tau;
                    if (t < LTOK) {
                        LAS unsigned char* pp = part + (size_t)(t * GS + 4 * q) * 2;
                        if (s <= 32) { u32x2 w; w.x = cvt_pk_bf16(acc[0], acc[1]); w.y = cvt_pk_bf16(acc[2], acc[3]); *(LAS u32x2*)pp = w; }
                        else { const u32x2 o = *(const LAS u32x2*)pp;
                            const float y0 = acc[0] + bflo(o.x), y1 = acc[1] + bfhi(o.x), y2 = acc[2] + bflo(o.y), y3 = acc[3] + bfhi(o.y);
                            const float g0 = gelu_tanh(y0), g1 = gelu_tanh(y1), g2 = gelu_tanh(y2), g3 = gelu_tanh(y3); const size_t ro = (size_t)tok_row(b, t) * SSMW + GS * g + 4 * q;
                            u32x2 w; w.x = cvt_pk_bf16(g0, g1); w.y = cvt_pk_bf16(g2, g3); *(u32x2*)(gb + ro) = w;
                            *(unsigned*)(g8 + ro) = pk4_fp8(g0 * F8_GS, g1 * F8_GS, g2 * F8_GS, g3 * F8_GS); }
                    }
                }
                WG_BAR();
            }
        }
        __syncthreads();
    }
}

namespace att {
constexpr int KVBLK = 64, NMINI = 7;
constexpr int SHM_V = 16384, SHM_K = 16384, SHM_P = 8192;
constexpr int V_OFF = 0, KN_OFF = 3 * SHM_V, KP_OFF = KN_OFF + 2 * SHM_K, WS_OFF = KP_OFF + 2 * SHM_P, QR_OFF = WS_OFF + NWAVES * 256, NQL = 6, LDS_NEED = QR_OFF + NWAVES * NQL * 1024;
static_assert(LDS_NEED <= MISC_OFF, "attention LDS");
constexpr float THRL = 8.0f * 1.4426950408889634f;
#define KSWZ(row, colB) ((row) * 256 + ((colB) ^ (((row) & 7) << 4)))
#define KPSWZ(row, colB) ((row) * 128 + ((colB) ^ ((((row) >> 1) & 7) << 4)))
#define SBAR() __builtin_amdgcn_sched_barrier(0)
__device__ __forceinline__ int crow(int r, int hi) { return (r & 3) + 8 * (r >> 2) + 4 * hi; }
__device__ __forceinline__ void partialSM(f32x16& p0, f32x16& p1, float& m_reg, float& mn, float& alpha) {
    float pmax = p0[0];
#pragma unroll
    for (int r = 1; r < 16; ++r) pmax = fmaxf(pmax, p0[r]);
#pragma unroll
    for (int r = 0; r < 16; ++r) pmax = fmaxf(pmax, p1[r]);
    { auto rr = __builtin_amdgcn_permlane32_swap(__float_as_uint(pmax), __float_as_uint(pmax), false, false); pmax = fmaxf(__uint_as_float(rr[0]), __uint_as_float(rr[1])); }
    if (__builtin_expect(__all(pmax - m_reg <= THRL), 1)) { mn = m_reg; alpha = 1.f; }
    else { mn = fmaxf(m_reg, pmax); alpha = fast_exp2(m_reg - mn); m_reg = mn; }
#pragma unroll
    for (int r = 0; r < 16; ++r) p0[r] = p0[r] - mn;
#pragma unroll
    for (int r = 0; r < 16; ++r) p1[r] = p1[r] - mn;
#pragma unroll
    for (int r = 0; r < 16; ++r) p0[r] = fast_exp2(p0[r]);
}
__device__ __forceinline__ void finishSM(f32x16& p0, f32x16& p1, float alpha, float& l_reg, bf16x8& pa0, bf16x8& pa1, bf16x8& pa2, bf16x8& pa3) {
#pragma unroll
    for (int r = 0; r < 16; ++r) p1[r] = fast_exp2(p1[r]);
    float ps = 0;
#pragma unroll
    for (int r = 0; r < 16; ++r) ps += p0[r];
#pragma unroll
    for (int r = 0; r < 16; ++r) ps += p1[r];
    { auto rr = __builtin_amdgcn_permlane32_swap(__float_as_uint(ps), __float_as_uint(ps), false, false); ps = __uint_as_float(rr[0]) + __uint_as_float(rr[1]); }
    l_reg = l_reg * alpha + ps;
#define PK4(P, BASE, OUT) do { unsigned a0 = cvt_pk_bf16(P[BASE + 0], P[BASE + 1]), a1 = cvt_pk_bf16(P[BASE + 2], P[BASE + 3]);   \
    unsigned b0 = cvt_pk_bf16(P[BASE + 4], P[BASE + 5]), b1 = cvt_pk_bf16(P[BASE + 6], P[BASE + 7]);                              \
    auto r0 = __builtin_amdgcn_permlane32_swap(a0, b0, false, false); auto r1 = __builtin_amdgcn_permlane32_swap(a1, b1, false, false); \
    u32x4 w = {r0[0], r1[0], r0[1], r1[1]}; OUT = *reinterpret_cast<bf16x8*>(&w); } while (0)
    PK4(p0, 0, pa0); PK4(p0, 8, pa1); PK4(p1, 0, pa2); PK4(p1, 8, pa3);
#undef PK4
}
__device__ __forceinline__ void qkt(f32x16& p0, f32x16& p1, const LAS char* Kn, const LAS char* Kp, const bf16x8* qr, const LAS char* qrl, int r32, int hi, bool masked) {
    p0 = f32x16{}; p1 = f32x16{};
#pragma unroll
    for (int d0 = 0; d0 < 8; ++d0) { const int cb = (d0 * 16 + hi * 8) * 2;
        const bf16x8 b0 = *(const LAS bf16x8*)(Kn + KSWZ(r32, cb)), b1 = *(const LAS bf16x8*)(Kn + KSWZ(32 + r32, cb));
        const bf16x8 qf = d0 < 6 ? qr[d0 < 6 ? d0 : 0] : *(const LAS bf16x8*)(qrl + (d0 == 6 ? 5 : 4) * 1024);
        p0 = __builtin_amdgcn_mfma_f32_32x32x16_bf16(b0, qf, p0, 0, 0, 0); p1 = __builtin_amdgcn_mfma_f32_32x32x16_bf16(b1, qf, p1, 0, 0, 0); }
#pragma unroll
    for (int d0 = 0; d0 < 4; ++d0) { const int cb = (d0 * 16 + hi * 8) * 2;
        const bf16x8 b0 = *(const LAS bf16x8*)(Kp + KPSWZ(r32, cb)), b1 = *(const LAS bf16x8*)(Kp + KPSWZ(32 + r32, cb));
        const bf16x8 qf = *(const LAS bf16x8*)(qrl + d0 * 1024);
        p0 = __builtin_amdgcn_mfma_f32_32x32x16_bf16(b0, qf, p0, 0, 0, 0); p1 = __builtin_amdgcn_mfma_f32_32x32x16_bf16(b1, qf, p1, 0, 0, 0); }
    if (masked) {
#pragma unroll
        for (int r = 8; r < 16; ++r) p0[r] = -1e30f;
#pragma unroll
        for (int r = 0; r < 16; ++r) p1[r] = -1e30f;
    }
}
__device__ __forceinline__ int v_st(int k, int c) { const int kk = (k & ~0xC) | ((k & 4) << 1) | ((k & 8) >> 1); return ((kk >> 3) * 4 + (c >> 5)) * 512 + ((kk & 7) * 32 + (c & 31)) * 2; }
__device__ __forceinline__ int v_rd_base(int lane) { return ((lane & 3) << 3) | (((lane >> 2) & 3) << 6) | (((lane >> 4) & 1) << 5) | (((lane >> 5) & 1) << 8); }
constexpr int v_rd_off(int d0, int ks, int half) { return d0 * 512 + ks * 4096 + half * 2048; }
template <int OFF> __device__ __forceinline__ s16x4 tr_read(int vb) { s16x4 r; asm volatile("ds_read_b64_tr_b16 %0, %1 offset:%2" : "=&v"(r) : "v"(vb), "i"(OFF) : "memory"); return r; }
template <int D0> __device__ __forceinline__ void pv_one(f32x16& od, int vb, bf16x8 pa0, bf16x8 pa1, bf16x8 pa2, bf16x8 pa3) {
    const s16x4 l0 = tr_read<v_rd_off(D0, 0, 0)>(vb), h0 = tr_read<v_rd_off(D0, 0, 1)>(vb), l1 = tr_read<v_rd_off(D0, 1, 0)>(vb), h1 = tr_read<v_rd_off(D0, 1, 1)>(vb);
    const s16x4 l2 = tr_read<v_rd_off(D0, 2, 0)>(vb), h2 = tr_read<v_rd_off(D0, 2, 1)>(vb), l3 = tr_read<v_rd_off(D0, 3, 0)>(vb), h3 = tr_read<v_rd_off(D0, 3, 1)>(vb);
    asm volatile("s_waitcnt lgkmcnt(0)" ::: "memory"); SBAR();
#define PK(L, H) (bf16x8){L[0], L[1], L[2], L[3], H[0], H[1], H[2], H[3]}
    od = __builtin_amdgcn_mfma_f32_32x32x16_bf16(pa0, PK(l0, h0), od, 0, 0, 0);
    od = __builtin_amdgcn_mfma_f32_32x32x16_bf16(pa1, PK(l1, h1), od, 0, 0, 0);
    od = __builtin_amdgcn_mfma_f32_32x32x16_bf16(pa2, PK(l2, h2), od, 0, 0, 0);
    od = __builtin_amdgcn_mfma_f32_32x32x16_bf16(pa3, PK(l3, h3), od, 0, 0, 0);
#undef PK
}
__device__ __forceinline__ void pv_d0(f32x16* o, int vb, bf16x8 pa0, bf16x8 pa1, bf16x8 pa2, bf16x8 pa3) {
    pv_one<0>(o[0], vb, pa0, pa1, pa2, pa3); pv_one<1>(o[1], vb, pa0, pa1, pa2, pa3); pv_one<2>(o[2], vb, pa0, pa1, pa2, pa3); pv_one<3>(o[3], vb, pa0, pa1, pa2, pa3);
}

template <bool MINI>
__device__ __forceinline__ void attn_unit(int b, int h, int qrow0, int x0, int nx, bool has_meta, const bf16_t* __restrict__ qb, const bf16_t* __restrict__ kvb, const bf16_t* __restrict__ kpe,
                                          bf16_t* __restrict__ mix, float* __restrict__ part, float* __restrict__ psq_att, LAS char* lds, int tid) {
    const int wid = tid >> 6, lane = tid & 63, r32 = lane & 31, hi = lane >> 5;
    LAS char* V_lds = lds + V_OFF; LAS char* Kn_lds = lds + KN_OFF; LAS char* Kp_lds = lds + KP_OFF;
    LAS float* wsf = (LAS float*)(lds + WS_OFF) + wid * 64; LAS float* li_l = wsf; LAS float* al_l = wsf + 32;
    float m_reg = -1e30f, l_reg = 0; f32x16 o[4] = {}; bf16x8 qr[6];
    LAS char* qrl = lds + QR_OFF + wid * (NQL * 1024) + lane * 16;
    const int krow = tid >> 4, kcol = (((tid & 15) ^ (krow & 7)) * 8);
    const int vk0 = (tid >> 7) * 8 + ((tid & 31) >> 2), vc = ((tid >> 5) & 3) * 32 + (tid & 3) * 8;
    const int vkk1 = vk0 + 32, vka = (vk0 & ~0xC) | ((vk0 & 4) << 1) | ((vk0 & 8) >> 1), vkb = (vkk1 & ~0xC) | ((vkk1 & 4) << 1) | ((vkk1 & 8) >> 1);
    const int prow = tid >> 3, pcol = (((tid & 7) ^ ((prow >> 1) & 7)) * 8);
    const int vb0 = (int)(uintptr_t)V_lds + v_rd_base(lane);
    const int NT = nx + (has_meta ? 1 : 0);
    const bf16_t* kvh = kvb + h * 256;
    const unsigned ldsw = (unsigned)__builtin_amdgcn_readfirstlane(wid) * 1024u;
#define TILE_ID(i) ((i) < nx ? x0 + (i) : 32)
#define GLDS(src, dst) __builtin_amdgcn_global_load_lds((const unsigned*)(src), (LAS unsigned*)(dst), 16, 0, 0)
#define SLOAD(i, bf, vbf) do { const int _t = TILE_ID(i); const size_t _kb = _t < 32 ? (size_t)b * SEQ + 64 * _t : (size_t)MX + NMETA * b; \
    GLDS(kvh + (_kb + krow) * 2048 + kcol, Kn_lds + (bf) * SHM_K + ldsw); GLDS(kvh + (_kb + 32 + krow) * 2048 + kcol, Kn_lds + (bf) * SHM_K + 8192 + ldsw); \
    GLDS(kvh + (_kb + vka) * 2048 + 128 + vc, V_lds + (vbf) * SHM_V + ldsw); GLDS(kvh + (_kb + vkb) * 2048 + 128 + vc, V_lds + (vbf) * SHM_V + 8192 + ldsw); \
    GLDS(kpe + (_kb + prow) * 64 + pcol, Kp_lds + (bf) * SHM_P + ldsw); } while (0)
#define RESC(a) do { if (__any((a) < 1.f)) { if (hi == 0) al_l[r32] = (a); asm volatile("s_waitcnt lgkmcnt(0)" ::: "memory"); \
    _Pragma("unroll") for (int d = 0; d < 4; ++d) _Pragma("unroll") for (int r = 0; r < 16; ++r) o[d][r] *= al_l[crow(r, hi)]; } } while (0)
    f32x16 pA0, pA1; float mnA, alA; bf16x8 pa0 = {}, pa1 = {}, pa2 = {}, pa3 = {};
    const bool lag = wid >= 4;
    const bool act = !MINI || wid == 0;
    SLOAD(0, 0, 0);
    { const int qrow = MINI ? qrow0 + (r32 & 15) : qrow0 + wid * 32 + r32; const bf16_t* Qw = qb + (size_t)qrow * 1536 + h * DQK + hi * 8;
#pragma unroll
      for (int d0 = 0; d0 < 6; ++d0) qr[d0] = *(const bf16x8*)(Qw + d0 * 16);
#pragma unroll
      for (int d0 = 0; d0 < 4; ++d0) *(LAS bf16x8*)(qrl + d0 * 1024) = *(const bf16x8*)(Qw + (8 + d0) * 16);
      *(LAS bf16x8*)(qrl + 4 * 1024) = *(const bf16x8*)(Qw + 7 * 16); *(LAS bf16x8*)(qrl + 5 * 1024) = *(const bf16x8*)(Qw + 6 * 16); }
    VM_WAIT(); __syncthreads();
    int vcur = 0, vprev = 2;
    for (int i = 0; i < NT; ++i) {
        const int bf = i & 1; const bool more = (i + 1 < NT); const int vnext = vcur == 2 ? 0 : vcur + 1;
        if (more) SLOAD(i + 1, bf ^ 1, vnext);
        if (act) {
        if (lag && i > 0) { SBAR(); pv_d0(o, vb0 + vprev * SHM_V, pa0, pa1, pa2, pa3); }
        SBAR(); qkt(pA0, pA1, Kn_lds + bf * SHM_K, Kp_lds + bf * SHM_P, qr, qrl, r32, hi, TILE_ID(i) == 32);
        partialSM(pA0, pA1, m_reg, mnA, alA);
        RESC(alA);
        finishSM(pA0, pA1, alA, l_reg, pa0, pa1, pa2, pa3); SBAR();
        if (!lag) pv_d0(o, vb0 + vcur * SHM_V, pa0, pa1, pa2, pa3);
        }
        VM_WAIT();
        __syncthreads();
        vprev = vcur; vcur = vnext;
    }
    if (lag && act) pv_d0(o, vb0 + vprev * SHM_V, pa0, pa1, pa2, pa3);
    __syncthreads();
    if constexpr (!MINI) {
        if (hi == 0) li_l[r32] = l_reg; asm volatile("s_waitcnt lgkmcnt(0)" ::: "memory");
        float rli[16];
#pragma unroll
        for (int r = 0; r < 16; ++r) rli[r] = fast_rcp(li_l[crow(r, hi)]);
        LAS char* ost = lds + wid * 8192;
#pragma unroll
        for (int r = 0; r < 16; ++r)
#pragma unroll
            for (int d0 = 0; d0 < 4; ++d0) *(LAS unsigned short*)(ost + crow(r, hi) * 256 + (d0 * 32 + r32) * 2) = (unsigned short)(cvt_pk_bf16(o[d0][r] * rli[r], 0.f) & 0xffffu);
        asm volatile("s_waitcnt lgkmcnt(0)" ::: "memory");
        bf16_t* Ob = mix + (size_t)(qrow0 + wid * 32) * 2048 + h * DV;
        float* psq = psq_att; asm volatile("" : "+s"(psq));
#pragma unroll
        for (int i = 0; i < 8; ++i) { const int ch = i * 64 + lane, rw = ch >> 4, cp = ch & 15; const u32x4 ov = *(const LAS u32x4*)(ost + rw * 256 + cp * 16);
            *(u32x4*)(Ob + (size_t)rw * 2048 + cp * 8) = ov;
            float ss = (bflo(ov.x) * bflo(ov.x) + bfhi(ov.x) * bfhi(ov.x)) + (bflo(ov.y) * bflo(ov.y) + bfhi(ov.y) * bfhi(ov.y)) + (bflo(ov.z) * bflo(ov.z) + bfhi(ov.z) * bfhi(ov.z)) + (bflo(ov.w) * bflo(ov.w) + bfhi(ov.w) * bfhi(ov.w));
            ss += __shfl_xor(ss, 1); ss += __shfl_xor(ss, 2); ss += __shfl_xor(ss, 4); ss += __shfl_xor(ss, 8);
            if (cp == 0) psq[(size_t)(qrow0 + wid * 32 + rw) * 8 + h] = ss; }
        __syncthreads();
    } else {
        asm volatile("" :: "v"(o[0]), "v"(o[1]), "v"(o[2]), "v"(o[3]));
        if (wid == 0) {
#pragma unroll
            for (int r = 0; r < 8; ++r)
#pragma unroll
                for (int d0 = 0; d0 < 4; ++d0) __hip_atomic_store(part + crow(r, hi) * 128 + d0 * 32 + r32, o[d0][r], __ATOMIC_RELAXED, __HIP_MEMORY_SCOPE_AGENT);
            if (lane < 16) { __hip_atomic_store(part + 16 * 128 + lane, m_reg, __ATOMIC_RELAXED, __HIP_MEMORY_SCOPE_AGENT); __hip_atomic_store(part + 16 * 128 + 16 + lane, l_reg, __ATOMIC_RELAXED, __HIP_MEMORY_SCOPE_AGENT); }
        }
        __syncthreads();
    }
#undef TILE_ID
#undef SLOAD
#undef GLDS
#undef RESC
}
__device__ __forceinline__ void meta_merge(int b, int h, const float* apart, bf16_t* mix, float* psq_att, int wid, int lane) {
    const float* p0 = (const float*)((const char*)apart + (size_t)((b * NH + h) * 8) * APART_STRIDE);
    float ml[2][NMINI], ll[2][NMINI]; unsigned long long ov[2][NMINI];
#pragma unroll
    for (int j = 0; j < 2; ++j)
#pragma unroll
        for (int e = 0; e < NMINI; ++e) { const float* pe = (const float*)((const char*)p0 + (size_t)e * APART_STRIDE); const int i = 2 * wid + j;
            ml[j][e] = __hip_atomic_load(pe + 16 * 128 + i, __ATOMIC_RELAXED, __HIP_MEMORY_SCOPE_AGENT); ll[j][e] = __hip_atomic_load(pe + 16 * 128 + 16 + i, __ATOMIC_RELAXED, __HIP_MEMORY_SCOPE_AGENT);
            ov[j][e] = __hip_atomic_load((const unsigned long long*)(pe + i * 128 + 2 * lane), __ATOMIC_RELAXED, __HIP_MEMORY_SCOPE_AGENT); }
#pragma unroll
    for (int j = 0; j < 2; ++j) { float m = -1e30f;
#pragma unroll
        for (int e = 0; e < NMINI; ++e) m = fmaxf(m, ml[j][e]);
        float L = 0.f, o0 = 0.f, o1 = 0.f;
#pragma unroll
        for (int e = 0; e < NMINI; ++e) { const float w = fast_exp2(ml[j][e] - m); L += w * ll[j][e]; o0 += w * __uint_as_float((unsigned)ov[j][e]); o1 += w * __uint_as_float((unsigned)(ov[j][e] >> 32)); }
        const float rl = 1.0f / L; const unsigned pk = cvt_pk_bf16(o0 * rl, o1 * rl); const int row = MX + NMETA * b + 2 * wid + j;
        *(unsigned*)(mix + (size_t)row * 2048 + h * DV + 2 * lane) = pk;
        const float ss = wave_sum(bflo(pk) * bflo(pk) + bfhi(pk) * bfhi(pk)); if (lane == 0) psq_att[(size_t)row * 8 + h] = ss; }
}
__device__ __forceinline__ void attn_phase(const bf16_t* qb, const bf16_t* kvb, const bf16_t* kpe, bf16_t* mix, float* apart, float* psq_att, unsigned* tkt, LAS char* lds, int tid, int G, bool minis) {
    for (int u0 = blockIdx.x; u0 < 256; u0 += G) { const int u = (G == 256) ? ((u0 & 7) << 5) | (u0 >> 3) : u0;
        const int bh = u >> 3, qblk = u & 7, b = bh >> 3, h = bh & 7;
        attn_unit<false>(b, h, b * SEQ + 256 * qblk, 0, 32, true, qb, kvb, kpe, mix, nullptr, psq_att, lds, tid); }
    const int nglu = (MP / 256) * (SSMW / 256), first = G > nglu ? nglu : 0, nw = G - first;
    if (minis && (int)blockIdx.x >= first)
        for (int v = (int)blockIdx.x - first; v < 32 * NMINI; v += nw) { const int bh = v / NMINI, e = v - bh * NMINI, b = bh >> 3, h = bh & 7;
            const int x0 = e == 0 ? 0 : (e <= 5 ? 5 * e - 1 : 24 + 4 * (e - 5)), nx = (e == 0 || e >= 5) ? 4 : 5;
            attn_unit<true>(b, h, MX + NMETA * b, x0, nx, e == 0, qb, kvb, kpe, nullptr, (float*)((char*)apart + (size_t)(bh * 8 + e) * APART_STRIDE), nullptr, lds, tid);
            LAS unsigned* flag = (LAS unsigned*)(lds + MISC_OFF + 80);
            if (tid == 0) { VM_WAIT(); *flag = atomicAdd(tkt + bh * 16, 1u); }
            __syncthreads();
            if (*flag == NMINI - 1) meta_merge(b, h, apart, mix, psq_att, tid >> 6, tid & 63); }
}
#undef KSWZ
#undef KPSWZ
#undef SBAR
}

template <class Sched>
__device__ __forceinline__ void outnorm_scales(const Sched& S, const float* psq, float* scl, int nr, int tid) {
    for (int i = 0; ; ++i) { pg8::Unit u; if (!S.next(i, u)) break;
        const int row = u.pm * 256 + tid;
        if (tid < 256 && row < nr) {
            const f32x4 a0 = *(const f32x4*)(psq + (size_t)row * 8), a1 = *(const f32x4*)(psq + (size_t)row * 8 + 4);
            const float* ps = psq + (size_t)MP * 8 + (size_t)row * 16;
            const f32x4 s0 = *(const f32x4*)ps, s1 = *(const f32x4*)(ps + 4), s2 = *(const f32x4*)(ps + 8), s3 = *(const f32x4*)(ps + 12);
            const f32x4 sa = a0 + a1, sv = (s0 + s1) + (s2 + s3);
            const float ra = 1.0f / sqrtf(((sa[0] + sa[1]) + (sa[2] + sa[3])) * (1.0f / ATTW) + EPS), rs = 1.0f / sqrtf(((sv[0] + sv[1]) + (sv[2] + sv[3])) * (1.0f / SSMW) + EPS);
            scl[row] = ra / rs; scl[MP + row] = rs; } }
    VM_WAIT(); __syncthreads();
}


template <int N>
__device__ __forceinline__ float psq_sum(const float* p) {
    f32x4 v[N / 4];
#pragma unroll
    for (int j = 0; j < N / 4; ++j) v[j] = *(const f32x4*)(p + 4 * j);
    f32x4 a = v[0];
#pragma unroll
    for (int j = 1; j < N / 4; ++j) a += v[j];
    return (a[0] + a[1]) + (a[2] + a[3]);
}
template <int LO, int HI>
__device__ __forceinline__ f32x4 slab_sum_range(const float* slab, int r, int N, int c) {
    f32x4 v[HI - LO];
#pragma unroll
    for (int s = LO; s < HI; ++s) v[s - LO] = *(const f32x4*)(slab + ((size_t)s * 64 + r) * N + c);
    f32x4 a = v[0];
#pragma unroll
    for (int s = 1; s < HI - LO; ++s) a += v[s];
    return a;
}
template <int NS>
__device__ __forceinline__ f32x4 slab_sum(const float* slab, int r, int N, int c) {
    f32x4 v[NS];
#pragma unroll
    for (int s = 0; s < NS; ++s) v[s] = *(const f32x4*)(slab + ((size_t)s * 64 + r) * N + c);
    f32x4 a = v[0];
#pragma unroll
    for (int s = 1; s < NS; ++s) a += v[s];
    return a;
}
template <int NS>
__device__ __forceinline__ void tail_res_ffn_phase(float* h, bf16_t* hb, const float* psq, float* rs, const float* slab, const float* scl, int tid, int G) {
    const int lane = tid & 63, gw = blockIdx.x * NWAVES + (tid >> 6), ngw = G * NWAVES;
    constexpr float C = 1.0f / (F8_HS * F8_WGU);
    for (int r = ngw - 1 - gw; r < 64; r += ngw) { float ss = 0.f; const float rs_ = scl[MP + MX + r]; const f32x2 sc2 = {scl[MX + r] * rs_, rs_};
#pragma unroll 2
        for (int j = 0; j < 8; ++j) { const int c = j * 256 + 4 * lane; const size_t off = (size_t)(MX + r) * DM + c;
            const f32x4 v = *(const f32x4*)(h + off) + slab_sum_range<0, NS / 2>(slab, r, DM, c) * sc2.x + slab_sum_range<NS / 2, NS>(slab, r, DM, c) * sc2.y;
            *(f32x4*)(h + off) = v; *(unsigned*)((unsigned char*)hb + off) = pk4_fp8(v[0] * F8_HS, v[1] * F8_HS, v[2] * F8_HS, v[3] * F8_HS);
            ss += (v[0] * v[0] + v[1] * v[1]) + (v[2] * v[2] + v[3] * v[3]); }
        ss = wave_sum(ss); if (lane == 0) rs[MX + r] = C * __builtin_amdgcn_rsqf(ss * (1.0f / DM) + EPS); }
    for (int row = gw * 64 + lane; row < MP; row += ngw * 64)
        if (row < MX || row >= MREAL) rs[row] = row < MX ? C * __builtin_amdgcn_rsqf(psq_sum<32>(psq + (size_t)row * 32) * (1.0f / DM) + EPS) : 0.f;
}
template <bool F8OUT, int NS>
__device__ __forceinline__ void tail_res_phase(float* h, bf16_t* hb, ssq_t* ssq, const float* psq, const float* slab, float sc, int tid, int G) {
    const int lane = tid & 63, gw = blockIdx.x * NWAVES + (tid >> 6), ngw = G * NWAVES;
    for (int row = (ngw - 1 - gw) * 64 + lane; row < MX; row += ngw * 64) ssq[row] = ssq_fix(psq_sum<32>(psq + (size_t)row * 32));
    for (int w = gw; w < 64 * 8; w += ngw) { const int r = w >> 3, c = (w & 7) * 256 + 4 * lane; const size_t off = (size_t)(MX + r) * DM + c;
        const f32x4 v = *(const f32x4*)(h + off) + slab_sum<NS>(slab, r, DM, c) * sc;
        *(f32x4*)(h + off) = v;
        if constexpr (F8OUT) *(unsigned*)((unsigned char*)hb + off) = pk4_fp8(v[0] * F8_HS, v[1] * F8_HS, v[2] * F8_HS, v[3] * F8_HS);
        else { u32x2 pk; pk.x = cvt_pk_bf16(v[0], v[1]); pk.y = cvt_pk_bf16(v[2], v[3]); *(u32x2*)(hb + off) = pk; }
        const float ss = wave_sum((v[0] * v[0] + v[1] * v[1]) + (v[2] * v[2] + v[3] * v[3])); if (lane == 0) atomicAdd(ssq + MX + r, ssq_fix(ss)); }
}
template <int NS>
__device__ __forceinline__ void tail_g1_phase(bf16_t* proj, bf16_t* kpe, const ssq_t* ssq_h, ssq_t* ssq_cq, ssq_t* ssq_ckv, const float* psq, const float* cosb, const float* sinb, const float* slab, int tid, int G) {
    const int lane = tid & 63, gw = blockIdx.x * NWAVES + (tid >> 6), ngw = G * NWAVES;
    for (int row = (ngw - 1 - gw) * 64 + lane; row < MX; row += ngw * 64) {
        ssq_cq[row] = ssq_fix(psq_sum<8>(psq + (size_t)row * 12)); ssq_ckv[row] = ssq_fix(psq_sum<4>(psq + (size_t)row * 12 + 8)); }
    for (int w = gw; w < 64 * 8; w += ngw) { const int r = w >> 3, pn = w & 7, c = pn * 256 + 4 * lane, row = MX + r;
        const float rr = 1.0f / sqrtf(ssq_get(ssq_h, row) * (1.0f / DM) + EPS);
        const f32x4 v = slab_sum<NS>(slab, r, PROJW, c) * rr;
        if (pn == 3) {
            if (lane < 16) { const int pos = row_pos(row), i0 = 2 * lane; const f32x2 cc = *(const f32x2*)(cosb + pos * 32 + i0), sn = *(const f32x2*)(sinb + pos * 32 + i0);
                u32x2 pk; pk.x = cvt_pk_bf16(v[0] * cc.x - v[1] * sn.x, v[0] * sn.x + v[1] * cc.x); pk.y = cvt_pk_bf16(v[2] * cc.y - v[3] * sn.y, v[2] * sn.y + v[3] * cc.y);
                *(u32x2*)(kpe + (size_t)row * 64 + 4 * lane) = pk; }
        } else {
            u32x2 pk; pk.x = cvt_pk_bf16(v[0], v[1]); pk.y = cvt_pk_bf16(v[2], v[3]); *(u32x2*)(proj + (size_t)row * PROJW + c) = pk;
            if (pn < 3) { const float ss = wave_sum((v[0] * v[0] + v[1] * v[1]) + (v[2] * v[2] + v[3] * v[3])); if (lane == 0) atomicAdd((pn < 2 ? ssq_cq : ssq_ckv) + row, ssq_fix(ss)); }
        }
    }
}

struct Route { int e0, e1, s0, s1; float w0, w1, r, pad; };
template <int NS>
__device__ __forceinline__ void router_phase(float* h, bf16_t* hb, const float* slab, const float* scl, const float* wr, const float* gain, Route* route, unsigned* cnt, unsigned char* xp8, unsigned char* mact8, float* rperm, float* gperm, int nrows, LAS unsigned char* lds, int tid, int G) {
    const int lane = tid & 63, gw = blockIdx.x * NWAVES + (tid >> 6), ngw = G * NWAVES;
    { unsigned zz = 0u; asm volatile("" : "+v"(zz));
      for (int i = gw * 8 + (lane >> 3); i < MOE_ROWS; i += ngw * 8) *(u32x4*)(mact8 + (size_t)i * DFEP + DFE + 16 * (lane & 7)) = (u32x4){zz, zz, zz, zz}; }
    f32x4 nx[8];
#pragma unroll
    for (int j = 0; j < 8; ++j) nx[j] = *(const f32x4*)(h + (size_t)(gw < nrows ? gw : 0) * DM + 4 * lane + 256 * j);
    LAS float* wl = (LAS float*)lds;
    for (int i0 = tid; i0 < DM * NE; i0 += NTHR * 8) { float a[8], g[8];
#pragma unroll
        for (int u = 0; u < 8; ++u) { const int i = i0 + u * NTHR; a[u] = wr[i]; g[u] = gain[i >> 3]; }
#pragma unroll
        for (int u = 0; u < 8; ++u) { const int i = i0 + u * NTHR; wl[(i & 7) * DM + (i >> 3)] = a[u] * g[u]; } }
    __syncthreads();
    for (int row = gw; row < nrows; row += ngw) {
        float lg[NE] = {0.f, 0.f, 0.f, 0.f, 0.f, 0.f, 0.f, 0.f}; float ss = 0.f;
        f32x4 hv[8];
#pragma unroll
        for (int j = 0; j < 8; ++j) hv[j] = nx[j];
        { const int nrow = row + ngw < nrows ? row + ngw : row;
#pragma unroll
          for (int j = 0; j < 8; ++j) nx[j] = *(const f32x4*)(h + (size_t)nrow * DM + 4 * lane + 256 * j); }
        if (row >= MX) {
            const float rs_ = scl[MP + row]; const f32x2 sc2 = {scl[row] * rs_, rs_};
#pragma unroll
            for (int hf = 0; hf < 4; ++hf) { f32x4 sl[2];
#pragma unroll
                for (int j = 0; j < 2; ++j) sl[j] = slab_sum_range<0, NS / 2>(slab, row - MX, DM, 4 * lane + 256 * (2 * hf + j)) * sc2.x + slab_sum_range<NS / 2, NS>(slab, row - MX, DM, 4 * lane + 256 * (2 * hf + j)) * sc2.y;
#pragma unroll
                for (int j = 0; j < 2; ++j) hv[2 * hf + j] += sl[j];
                asm volatile("" : "+v"(hv[2 * hf]), "+v"(hv[2 * hf + 1])); }
#pragma unroll
            for (int j = 0; j < 8; ++j) { const int c = 4 * lane + 256 * j; *(f32x4*)(h + (size_t)row * DM + c) = hv[j]; }
        }
#pragma unroll
        for (int j = 0; j < 8; ++j) { const int c = 4 * lane + 256 * j; const f32x4 x = hv[j];
            ss += (x[0] * x[0] + x[1] * x[1]) + (x[2] * x[2] + x[3] * x[3]);
#pragma unroll
            for (int e = 0; e < NE; ++e) { const f32x4 w = *(const LAS f32x4*)(wl + e * DM + c); lg[e] += (x[0] * w[0] + x[1] * w[1]) + (x[2] * w[2] + x[3] * w[3]); } }
        ss = wave_sum(ss);
#pragma unroll
        for (int e = 0; e < NE; ++e) lg[e] = wave_sum(lg[e]);
        const float r = 1.0f / sqrtf(ss * (1.0f / DM) + EPS);
        {
            int e0 = 0; float v0 = lg[0];
#pragma unroll
            for (int e = 1; e < NE; ++e) if (lg[e] > v0) { v0 = lg[e]; e0 = e; }
            int e1 = -1; float v1 = -3.0e38f;
#pragma unroll
            for (int e = 0; e < NE; ++e) if (e != e0 && lg[e] > v1) { v1 = lg[e]; e1 = e; }
            const float w1 = 1.0f / (1.0f + expf((v0 - v1) * r)), w0 = 1.0f - w1;
            int s0 = 0, s1 = 0;
            if (lane == 0) { s0 = (int)atomicAdd(cnt + 64 * e0, 1u); s1 = (int)atomicAdd(cnt + 64 * e1, 1u); }
            s0 = __builtin_amdgcn_readfirstlane(s0); s1 = __builtin_amdgcn_readfirstlane(s1);
            const size_t d0 = (size_t)e0 * MP + s0, d1 = (size_t)e1 * MP + s1;
            if (lane == 0) { Route rt; rt.e0 = e0; rt.e1 = e1; rt.s0 = s0; rt.s1 = s1; rt.w0 = w0; rt.w1 = w1; rt.r = r; rt.pad = 0.f; route[row] = rt;
                rperm[d0] = r * (1.0f / (F8_HS * F8_WGU)); rperm[d1] = r * (1.0f / (F8_HS * F8_WGU)); gperm[d0] = w0; gperm[d1] = w1; }
#pragma unroll
            for (int j = 0; j < 8; ++j) { const int c = 4 * lane + 256 * j; const unsigned pk = pk4_fp8(hv[j][0] * F8_HS, hv[j][1] * F8_HS, hv[j][2] * F8_HS, hv[j][3] * F8_HS);
                *(unsigned*)(xp8 + d0 * DM + c) = pk; *(unsigned*)(xp8 + d1 * DM + c) = pk; }
        }
    }
    __syncthreads();
}
__device__ __forceinline__ void moe_counts(const unsigned* cnt, int (&cv)[NE]) {
    unsigned t[NE];
#pragma unroll
    for (int e = 0; e < NE; ++e) t[e] = cnt[64 * e];
#pragma unroll
    for (int e = 0; e < NE; ++e) cv[e] = __builtin_amdgcn_readfirstlane((int)t[e]);
}
__device__ __forceinline__ void moe_prefix(const unsigned* cnt, int (&pfx)[NE + 1]) {
    int cv[NE]; moe_counts(cnt, cv);
    pfx[0] = 0;
#pragma unroll
    for (int e = 0; e < NE; ++e) pfx[e + 1] = pfx[e] + ((cv[e] + 255) >> 8);
}
__device__ __forceinline__ void moe_prefix_put(LAS unsigned char* lds, const int (&pfx)[NE + 1], int tid) {
    if (tid == 0) {
#pragma unroll
        for (int e = 0; e <= NE; ++e) *(LAS int*)(lds + MISC_OFF + 40 + 4 * e) = pfx[e]; } }
__device__ __forceinline__ void moe_prefix_get(LAS unsigned char* lds, int (&pfx)[NE + 1]) {
    int t[NE + 1];
#pragma unroll
    for (int e = 0; e <= NE; ++e) t[e] = *(const LAS int*)(lds + MISC_OFF + 40 + 4 * e);
#pragma unroll
    for (int e = 0; e <= NE; ++e) pfx[e] = __builtin_amdgcn_readfirstlane(t[e]); }
__device__ __forceinline__ void permute_phase(const bf16_t* hb, const Route* route, const unsigned* cnt, bf16_t* xperm, unsigned char* mact8, float* rperm, float* gperm, int nrows, int tid, int G) {
    const int lane = tid & 63, gw = blockIdx.x * NWAVES + (tid >> 6), ngw = G * NWAVES;
    int pfx[NE + 1]; moe_prefix(cnt, pfx);
    { unsigned zz = 0u; asm volatile("" : "+v"(zz));
      for (int i = gw * 8 + (lane >> 3); i < pfx[NE] * 256; i += ngw * 8) *(u32x4*)(mact8 + (size_t)i * DFEP + DFE + 16 * (lane & 7)) = (u32x4){zz, zz, zz, zz}; }
    const unsigned char* hb8 = (const unsigned char*)hb; unsigned char* xp8 = (unsigned char*)xperm;
    Route nrt = route[gw < nrows ? gw : 0]; u32x4 nv[2];
#pragma unroll
    for (int j = 0; j < 2; ++j) nv[j] = *(const u32x4*)(hb8 + (size_t)(gw < nrows ? gw : 0) * DM + 1024 * j + 16 * lane);
    for (int row = gw; row < nrows; row += ngw) {
        const Route rt = nrt; u32x4 v[2] = {nv[0], nv[1]};
        const int nrow = row + ngw < nrows ? row + ngw : row;
        nrt = route[nrow];
#pragma unroll
        for (int j = 0; j < 2; ++j) nv[j] = *(const u32x4*)(hb8 + (size_t)nrow * DM + 1024 * j + 16 * lane);
#pragma unroll
        for (int k = 0; k < 2; ++k) { const int e = k ? rt.e1 : rt.e0, s = k ? rt.s1 : rt.s0; const size_t dst = (size_t)pfx[e] * 256 + s;
#pragma unroll
            for (int j = 0; j < 2; ++j) *(u32x4*)(xp8 + dst * DM + 1024 * j + 16 * lane) = v[j];
            if (lane == 0) { rperm[dst] = rt.r * (1.0f / (F8_HS * F8_WGU)); gperm[dst] = k ? rt.w1 : rt.w0; } }
    }
    int cv[NE]; moe_counts(cnt, cv);
    for (int e = 0; e < NE; ++e) { const int c = cv[e]; const int npad = (pfx[e + 1] - pfx[e]) * 256 - c;
        for (int i = gw; i < npad; i += ngw) { const size_t dst = (size_t)pfx[e] * 256 + c + i;
#pragma unroll
            for (int j = 0; j < 2; ++j) *(u32x4*)((unsigned char*)xperm + dst * DM + 1024 * j + 16 * lane) = (u32x4){0u, 0u, 0u, 0u};
            if (lane == 0) { rperm[dst] = 0.f; gperm[dst] = 0.f; } } }
}
template <bool LAST>
__device__ __forceinline__ void combine_phase(float* h, bf16_t* hb, ssq_t* ssq, const bf16_t* y, const Route* route, LAS unsigned char* lds, const float* fnorm, float* out, int tid, int G) {
    const int lane = tid & 63, gw = blockIdx.x * NWAVES + (tid >> 6), ngw = G * NWAVES;
    int pfx[NE + 1]; moe_prefix_get(lds, pfx);
    constexpr int NR = LAST ? MX : MREAL;
    f32x4 fn[8];
#pragma unroll
    for (int j = 0; j < 8; ++j) fn[j] = LAST ? *(const f32x4*)(fnorm + 8 * lane + 512 * (j >> 1) + 4 * (j & 1)) : (f32x4){0.f, 0.f, 0.f, 0.f};
    Route nrt = route[gw + ngw < NR ? gw + ngw : (gw < NR ? gw : 0)];
    u32x4 nya[4], nyb[4]; f32x4 nh[8];
#define CMB_LD(r_, rt_) do { const size_t d0_ = ((size_t)pfx[(rt_).e0] * 256 + (rt_).s0) * DM, d1_ = ((size_t)pfx[(rt_).e1] * 256 + (rt_).s1) * DM; \
        _Pragma("unroll") for (int jj = 0; jj < 4; ++jj) { const int c_ = 8 * lane + 512 * jj; nya[jj] = *(const u32x4*)(y + d0_ + c_); nyb[jj] = *(const u32x4*)(y + d1_ + c_); \
            nh[2 * jj] = *(const f32x4*)(h + (size_t)(r_) * DM + c_); nh[2 * jj + 1] = *(const f32x4*)(h + (size_t)(r_) * DM + c_ + 4); } } while (0)
    { const int r0 = gw < NR ? gw : 0; const Route rt0 = route[r0]; CMB_LD(r0, rt0); }
    for (int row = gw; row < NR; row += ngw) {
        u32x4 cya[4], cyb[4]; f32x4 ch[8];
#pragma unroll
        for (int jj = 0; jj < 4; ++jj) { cya[jj] = nya[jj]; cyb[jj] = nyb[jj]; ch[2 * jj] = nh[2 * jj]; ch[2 * jj + 1] = nh[2 * jj + 1]; }
        { const int nrow = row + ngw < NR ? row + ngw : row; const Route rt = nrt; nrt = route[row + 2 * ngw < NR ? row + 2 * ngw : row]; CMB_LD(nrow, rt); }
        f32x4 v[8]; float ss = 0.f;
#pragma unroll
        for (int jj = 0; jj < 4; ++jj) { const int c = 8 * lane + 512 * jj; const u32x4 ya = cya[jj], yb = cyb[jj];
            v[2 * jj] = ch[2 * jj] + ((f32x4){bflo(ya.x), bfhi(ya.x), bflo(ya.y), bfhi(ya.y)} + (f32x4){bflo(yb.x), bfhi(yb.x), bflo(yb.y), bfhi(yb.y)});
            v[2 * jj + 1] = ch[2 * jj + 1] + ((f32x4){bflo(ya.z), bfhi(ya.z), bflo(ya.w), bfhi(ya.w)} + (f32x4){bflo(yb.z), bfhi(yb.z), bflo(yb.w), bfhi(yb.w)});
#pragma unroll
            for (int n = 0; n < 2; ++n) { const int j = 2 * jj + n; ss += (v[j][0] * v[j][0] + v[j][1] * v[j][1]) + (v[j][2] * v[j][2] + v[j][3] * v[j][3]); } }
        ss = wave_sum(ss);
        if constexpr (!LAST) {
#pragma unroll
            for (int jj = 0; jj < 4; ++jj) { const int c = 8 * lane + 512 * jj; *(f32x4*)(h + (size_t)row * DM + c) = v[2 * jj]; *(f32x4*)(h + (size_t)row * DM + c + 4) = v[2 * jj + 1];
                u32x4 w; w.x = cvt_pk_bf16(v[2 * jj][0], v[2 * jj][1]); w.y = cvt_pk_bf16(v[2 * jj][2], v[2 * jj][3]); w.z = cvt_pk_bf16(v[2 * jj + 1][0], v[2 * jj + 1][1]); w.w = cvt_pk_bf16(v[2 * jj + 1][2], v[2 * jj + 1][3]);
                *(u32x4*)(hb + (size_t)row * DM + c) = w; }
            if (lane == 0) ssq[row] = ssq_fix(ss);
        } else {
#if DBG
#pragma unroll
            for (int j = 0; j < 8; ++j) { const int c = 8 * lane + 512 * (j >> 1) + 4 * (j & 1); *(f32x4*)(h + (size_t)row * DM + c) = v[j]; }
#endif
            if (row < MX) { const float r = 1.0f / sqrtf(ss * (1.0f / DM) + EPS);
#pragma unroll
                for (int j = 0; j < 8; ++j) { const int c = 8 * lane + 512 * (j >> 1) + 4 * (j & 1); *(f32x4*)(out + (size_t)row * DM + c) = v[j] * r * fn[j]; } }
        }
    }
}

struct Args { Inputs in; float* out; unsigned char* ws; int ph_lo, ph_hi; };
__global__ void __launch_bounds__(NTHR, 2) fwd_kernel(Args args) {
    extern __shared__ __attribute__((aligned(16))) unsigned char lds_raw[];
    LAS unsigned char* lds = (LAS unsigned char*)lds_raw;
    volatile LAS unsigned* MISC = (volatile LAS unsigned*)(lds + MISC_OFF);
    const int tid = threadIdx.x, G = gridDim.x;
    unsigned char* ws = args.ws;
    unsigned* ctl = (unsigned*)(ws + WS_CTL);
    for (int u = tid; u < 32; u += NTHR) MISC[u] = 0u;
    __syncthreads();
    const int lo = args.ph_lo, hi = args.ph_hi;
    const bool multi = (hi - lo) > 1;
    XcdBarrier bar; bar.bar = ctl + CW_BAR; bar.x = 0; bar.st = MISC + 8;
    if (multi) bar = xcd_barrier_post(ctl + CW_BAR, MISC + 8);
#ifdef PH_ONLY
#define IN(k) ((((k) % 32) == PH_ONLY) && lo <= (k) && (k) < hi)
#else
#define IN(k) (lo <= (k) && (k) < hi)
#endif
#define SEAM(k) do { if (IN(k) && IN((k) + 1)) { xcd_barrier(bar); if (PROBE_REP & 128) xcd_barrier(bar); } } while (0)
#define SEAM2(k, k2) do { if (IN(k) && IN(k2)) { xcd_barrier(bar); if (PROBE_REP & 128) xcd_barrier(bar); } } while (0)
#define WSL ({ GAS unsigned char* _w = (GAS unsigned char*)ws; asm volatile("" : "+s"(_w)); _w; })
#define AS_GLOBAL(T, p) ((T)({ GAS void* _g = (GAS void*)(p); asm volatile("" : "+v"(_g)); _g; }))
#define DEFP unsigned char* wsl = (unsigned char*)WSL; const float* const* itab = (const float* const*)(wsl + WS_TAB); (void)itab; float* h = (float*)(wsl + WS_H); bf16_t* hb = (bf16_t*)(wsl + WS_HB); bf16_t* proj = (bf16_t*)(wsl + WS_PROJ); bf16_t* kpe = (bf16_t*)(wsl + WS_KPE); \
    bf16_t* qb = (bf16_t*)(wsl + WS_QB); bf16_t* kvb = (bf16_t*)(wsl + WS_KVB); bf16_t* mix = (bf16_t*)(wsl + WS_MIX); bf16_t* mixn = (bf16_t*)(wsl + WS_MIXN); \
    unsigned char* yp = wsl + WS_YP; bf16_t* gb = (bf16_t*)(wsl + WS_GB); float* apart = (float*)(wsl + WS_APART); \
    ssq_t* ssqb = (ssq_t*)(wsl + CTL_SSQ); const float* cosb = (const float*)(wsl + WS_ROPE); const float* sinb = cosb + LTOK * 32; \
    Route* route = (Route*)(wsl + WS_ROUTE); float* rperm = (float*)(wsl + WS_RPERM); float* gperm = (float*)(wsl + WS_GPERM); \
    bf16_t* act = (bf16_t*)(wsl + WS_BIG); bf16_t* xperm = (bf16_t*)(wsl + WS_XPERM); bf16_t* mact = (bf16_t*)(wsl + WS_MACT); bf16_t* yslot = (bf16_t*)(wsl + WS_YSLOT); float* slab = (float*)(wsl + WS_SLAB); (void)slab; \
    const unsigned char* wl = wsl + WS_W + (size_t)l * SZ_LAYER; const unsigned char* wd = wsl + WS_WFF + (size_t)(l >> 1) * SZ_DENSE; \
    const unsigned char* wm = wsl + WS_WFF + 2 * SZ_DENSE + (size_t)(l >> 1) * SZ_MOE; unsigned* cnt = (unsigned*)(wsl + WS_CTL) + CW_CNT + (l >> 1) * 1024; \
    (void)h; (void)hb; (void)proj; (void)kpe; (void)qb; (void)kvb; (void)mix; (void)mixn; (void)yp; (void)gb; (void)apart; (void)ssqb; (void)cosb; (void)sinb; (void)route; (void)rperm; (void)gperm; \
    (void)act; (void)xperm; (void)mact; (void)yslot; (void)wl; (void)wd; (void)wm; (void)cnt;
    const int c = (int)blockIdx.x;
    const int wid_s = __builtin_amdgcn_readfirstlane((int)threadIdx.x >> 6);
#define TIDL ({ unsigned _z = 0u; asm volatile("" : "+v"(_z)); int _t = (wid_s << 6) | (int)__builtin_amdgcn_mbcnt_hi(~0u, __builtin_amdgcn_mbcnt_lo(~0u, _z)); asm volatile("" : "+v"(_t)); _t; })

    if (IN(0)) {
        if (blockIdx.x == 0 && tid == 0) { const float** tab = (const float**)(ws + WS_TAB);
#pragma unroll
            for (int k = 0; k < 29; ++k) tab[k] = args.in.p[k];
            tab[29] = args.out; }
        prologue_phase(args.in, ws, lds, TIDL, G);
        if (PROBE_REP & 1) { __syncthreads(); prologue_phase(args.in, ws, lds, TIDL, G); }
    }
    SEAM(0);
    for (int l = 0; l < DEPTH; ++l) {
        const int P = 32 * l;
        if (IN(P + 1)) {
            DEFP
            pg8::SchedT S{hb, (const bf16_t*)(wl + OFF_WIN), DM, DM, 8, G, c, 256, 8};
            pg8::EpiG1 E{proj, kpe, ssqb + (size_t)SSQ_H1(l) * MP, ssqb + (size_t)SSQ_CQ(l) * MP, ssqb + (size_t)SSQ_CKV(l) * MP, cosb, sinb, slab, (float*)mix};
            pg8::gemm_phase<pg8::EpiG1, pg8::SchedT, true>(lds, S, E, TIDL);
            ffn_slot(l, 0, G, c, TIDL, itab, wsl, lds);
        }
        SEAM(P + 1);
        if (IN(P + 2)) { DEFP tail_g1_phase<8>(proj, kpe, ssqb + (size_t)SSQ_H1(l) * MP, ssqb + (size_t)SSQ_CQ(l) * MP, ssqb + (size_t)SSQ_CKV(l) * MP, (const float*)mix, cosb, sinb, slab, TIDL, G); }
        SEAM(P + 2);
        if (IN(P + 3)) {
            DEFP
            { pg8::Sched2D S{proj, (const bf16_t*)(wl + OFF_WUQ), PROJW, QL, MP / 256, 6, G, c};
              pg8::EpiQ E{qb, ssqb + (size_t)SSQ_CQ(l) * MP, cosb, sinb};
              pg8::gemm_phase<pg8::EpiQ, pg8::Sched2D, true>(lds, S, E, TIDL); }
            { pg8::Sched2D S{proj + QL, (const bf16_t*)(wl + OFF_WUKV), PROJW, KVL, MP / 256, 8, G, (c + 58) % G};
              pg8::EpiScaleBf16 E{kvb, 2048, ssqb + (size_t)SSQ_CKV(l) * MP, 1.0f / KVL};
              pg8::gemm_phase<pg8::EpiScaleBf16, pg8::Sched2D, true>(lds, S, E, TIDL); }
            s5_phase(wsl + WS_S5, proj, yp, gb, AS_GLOBAL(const float*, itab[15]) + (size_t)l * SSMW, l, lds, TIDL, G);
            ffn_slot(l, 5, G, c, TIDL, itab, wsl, lds);
            if (PROBE_REP & 4) s5_phase(wsl + WS_S5, proj, yp, gb, AS_GLOBAL(const float*, itab[15]) + (size_t)l * SSMW, l, lds, TIDL, G);
        }
        SEAM(P + 3);
        if (IN(P + 4)) {
            DEFP
            att::attn_phase(qb, kvb, kpe, mix, apart, (float*)proj, (unsigned*)(wsl + WS_CTL) + CW_TKT + l * 512, (LAS char*)lds, TIDL, G, l != DEPTH - 1);
            { pg8::Sched2D S{(const bf16_t*)yp, (const bf16_t*)(wl + OFF_WGLU), SSMW / 2, SSMW / 2, MP / 256, 4, G, c};
              pg8::EpiGlu E{gb, mix, (float*)proj + (size_t)MP * 8};
              pg8::gemm_phase<pg8::EpiGlu, pg8::Sched2D, true, true>(lds, S, E, TIDL); }
        }
        SEAM2(P + 4, P + 6);
#define nrows ({ int _n = l == DEPTH - 1 ? MX : MREAL; asm volatile("" : "+s"(_n)); _n; })
        if (IN(P + 6)) {
            DEFP
            const float* xin; { const unsigned long long xa = (unsigned long long)itab[0];
              xin = (const float*)(GAS const void*)(((unsigned long long)(unsigned)__builtin_amdgcn_readfirstlane((int)(xa >> 32)) << 32) | (unsigned)__builtin_amdgcn_readfirstlane((int)xa)); }
            pg8::SchedT S{mix, (const bf16_t*)(wl + OFF_WOUT), DM, DM, 8, G, c, 256, l == DEPTH - 1 ? 0 : 8};
            pg8::EpiRes<true, true> E{h, (l & 1) ? (bf16_t*)nullptr : hb, ssqb + (size_t)SSQ_H2(l) * MP, slab, 1.0f, (const float*)gb, l == 0 ? xin : (const float*)h, (float*)proj + (1 << 18), (const float*)proj, nrows};
            pg8::gemm_phase<pg8::EpiRes<true, true>, pg8::SchedT, true>(lds, S, E, TIDL);
            ffn_slot(l, 1, G, c, TIDL, itab, wsl, lds);
            if (PROBE_REP & 2048) { pg8::Sched2D S2{mixn, (const bf16_t*)(wl + OFF_WOUT), DM, DM, 32, 8, G, c}; pg8::EpiScaleBf16 E2{mix, 2048, ssqb + (size_t)SSQ_H2(l) * MP, 1.0f / DM}; pg8::gemm_phase<pg8::EpiScaleBf16, pg8::Sched2D, true>(lds, S2, E2, TIDL); }
        }
        if ((l & 1) == 0) {
            SEAM(P + 6);
            if (IN(P + 7)) { DEFP tail_res_ffn_phase<8>(h, hb, (const float*)proj + (1 << 18), rperm, slab, (const float*)gb, TIDL, G); }
            SEAM(P + 7);
            if (IN(P + 8)) {
                DEFP
                pg8::Sched2D S{hb, (const bf16_t*)wd, DM / 2, DM / 2, MP / 256, 2 * DFF / 256, G, c};
                pg8::EpiGU<true> E{act, DFF, rperm};
                pg8::gemm_phase<pg8::EpiGU<true>, pg8::Sched2D, true, true>(lds, S, E, TIDL);
                ffn_slot(l, 2, G, c, TIDL, itab, wsl, lds);
                if (PROBE_REP & 8) pg8::gemm_phase<pg8::EpiGU<true>, pg8::Sched2D, true, true>(lds, S, E, TIDL);
            }
            SEAM(P + 8);
            if (IN(P + 9)) {
                DEFP
                pg8::SchedT S{act, (const bf16_t*)(wd + SZ_DGU), DFF / 2, DFF / 2, 8, G, c, 256, 11};
                pg8::EpiRes<false> E{h, hb, ssqb + (size_t)SSQ_H1(l + 1) * MP, slab, 1.0f / (F8_AS * F8_WDN), nullptr, h, (float*)proj + (3 << 18), nullptr, 0};
                pg8::gemm_phase<pg8::EpiRes<false>, pg8::SchedT, true, true>(lds, S, E, TIDL);
                ffn_slot(l, 3, G, c, TIDL, itab, wsl, lds);
                if (PROBE_REP & 1024) { pg8::Sched2D S2{act, (const bf16_t*)(wd + SZ_DGU), DFF, DFF, 32, 8, G, c}; pg8::EpiScaleBf16 E2{mix, 2048, ssqb + (size_t)SSQ_H2(l) * MP, 1.0f / DM}; pg8::gemm_phase<pg8::EpiScaleBf16, pg8::Sched2D, true>(lds, S2, E2, TIDL); }
            }
            SEAM(P + 9);
            if (IN(P + 10)) { DEFP tail_res_phase<false, 11>(h, hb, ssqb + (size_t)SSQ_H1(l + 1) * MP, (const float*)proj + (3 << 18), slab, 1.0f / (F8_AS * F8_WDN), TIDL, G); }
            SEAM2(P + 10, P + 33);
        } else {
            SEAM2(P + 6, P + 16);
            if (IN(P + 16)) { DEFP router_phase<8>(h, hb, slab, (const float*)gb, AS_GLOBAL(const float*, itab[24]) + (size_t)(l >> 1) * DM * NE, AS_GLOBAL(const float*, itab[20]) + (size_t)l * DM, route, cnt, (unsigned char*)xperm, (unsigned char*)mact, rperm, gperm, nrows, lds, TIDL, G); }
            SEAM2(P + 16, P + 18);
            if (IN(P + 18)) {
                DEFP
                pg8::SchedMoE S; S.A = xperm; S.Bt0 = (const bf16_t*)wm; S.estride = SZ_EXP; S.lda = DM / 2; S.K = DM / 2; S.nN = 2 * DFE / 256; S.G = G; S.c = c; S.capA = 1; moe_prefix(cnt, S.pfx); moe_prefix_put(lds, S.pfx, TIDL);
                pg8::EpiGU<true> E{mact, DFEP, rperm};
                pg8::gemm_phase<pg8::EpiGU<true>, pg8::SchedMoE, true, true>(lds, S, E, TIDL);
                if (PROBE_REP & 32) pg8::gemm_phase<pg8::EpiGU<true>, pg8::SchedMoE, true, true>(lds, S, E, TIDL);
            }
            SEAM(P + 18);
            if (IN(P + 19)) {
                DEFP
                pg8::SchedMoE S; S.A = mact; S.Bt0 = (const bf16_t*)(wm + SZ_EGU); S.estride = SZ_EXP; S.lda = DFEP / 2; S.K = DFEP / 2; S.nN = 8; S.G = G; S.c = c; S.capA = 0; moe_prefix_get(lds, S.pfx);
                pg8::EpiMD E{yslot, gperm};
                pg8::gemm_phase<pg8::EpiMD, pg8::SchedMoE, true, true>(lds, S, E, TIDL);
                ffn_slot(l, 4, G, c, TIDL, itab, wsl, lds);
                if (PROBE_REP & 256) pg8::gemm_phase<pg8::EpiMD, pg8::SchedMoE, true, true>(lds, S, E, TIDL);
            }
            SEAM(P + 19);
            if (IN(P + 20)) {
                DEFP
                if (l == DEPTH - 1) combine_phase<true>(h, hb, nullptr, yslot, route, lds, AS_GLOBAL(const float*, itab[28]), AS_GLOBAL(float*, itab[29]), TIDL, G);
                else combine_phase<false>(h, hb, ssqb + (size_t)SSQ_H1(l + 1) * MP, yslot, route, lds, nullptr, nullptr, TIDL, G);
            }
            SEAM2(P + 20, P + 33);
        }
    }
#undef IN
#undef SEAM
#undef SEAM2
#undef nrows
}

#if DBG
namespace dbg {
__device__ __forceinline__ unsigned hsh(unsigned a, unsigned b) { unsigned x = a * 0x9E3779B1u ^ (b + 0x7F4A7C15u) * 0x85EBCA6Bu; x ^= x >> 15; x *= 0x2C1B3C6Du; x ^= x >> 12; x *= 0x297A2D39u; x ^= x >> 15; return x; }
__device__ __forceinline__ int pick_row(int s, unsigned salt) { const int sp[8] = {0, 2047, 2048, 8191, 8192, 8207, 8255, 4097}; return s < 8 ? sp[s] : (int)(hsh(s, salt) % MREAL); }
__device__ __forceinline__ void report(unsigned* et, int slot, float got, float ref, float rtol, float atol, int lane) {
    if (lane == 0) { float e = fabsf(got - ref) / (rtol * fabsf(ref) + atol); if (!(e == e) || !(got == got)) e = 1e30f; atomicMax(et + slot, __float_as_uint(e)); } }
template <class F> __device__ __forceinline__ float wdot(int K, int lane, F f) { float s = 0.f; for (int k = lane; k < K; k += 64) s += f(k); return wave_sum(s); }
__device__ __forceinline__ float rope_cos(int pos, int i) { return cosf((float)pos * powf(10000.0f, -(float)(2 * i) / 64.0f)); }
__device__ __forceinline__ float rope_sin(int pos, int i) { return sinf((float)pos * powf(10000.0f, -(float)(2 * i) / 64.0f)); }

__global__ void ck_g1(const float* h, const float* w_in, const float* gain, const bf16_t* proj, const bf16_t* kpe, unsigned* et, int slot) {
    const int s = blockIdx.x, lane = threadIdx.x, row = pick_row(s, 11); int j = hsh(s, 12) % INC; if (s & 1) j = 768 + hsh(s, 13) % 64;
    const float* hr = h + (size_t)row * DM;
    const float r = 1.0f / sqrtf(wdot(DM, lane, [&](int k) { return hr[k] * hr[k]; }) / DM + EPS);
    if (j >= 768 && j < 832) { const int i = (j - 768) & 31;
        const float x1 = r * wdot(DM, lane, [&](int k) { return hr[k] * gain[k] * w_in[(size_t)k * INC + 768 + i]; }), x2 = r * wdot(DM, lane, [&](int k) { return hr[k] * gain[k] * w_in[(size_t)k * INC + 800 + i]; });
        const int pos = row_pos(row); const float c = rope_cos(pos, i), sn = rope_sin(pos, i);
        report(et, slot, bf2f(kpe[(size_t)row * 64 + 2 * i]), x1 * c - x2 * sn, 0.02f, 0.02f, lane); report(et, slot, bf2f(kpe[(size_t)row * 64 + 2 * i + 1]), x1 * sn + x2 * c, 0.02f, 0.02f, lane);
    } else { const float ref = r * wdot(DM, lane, [&](int k) { return hr[k] * gain[k] * w_in[(size_t)k * INC + j]; });
        report(et, slot, bf2f(proj[(size_t)row * PROJW + (j < 768 ? j : 1024 + j - 832)]), ref, 0.02f, 0.02f, lane); }
}
__global__ void ck_g2(const bf16_t* proj, const float* w_uq, const float* qn, const float* w_ukv, const float* kvn, const bf16_t* qb, const bf16_t* kvb, unsigned* et, int slot) {
    const int s = blockIdx.x, lane = threadIdx.x, row = pick_row(s, 21); const bf16_t* pr = proj + (size_t)row * PROJW;
    if (s & 1) {
        const int c = hsh(s, 22) % 1536, hd = c / DQK, d = c % DQK;
        const float r = 1.0f / sqrtf(wdot(QL, lane, [&](int k) { const float v = bf2f(pr[k]); return v * v; }) / QL + EPS);
        float ref;
        if (d < DNOPE) ref = r * wdot(QL, lane, [&](int k) { return bf2f(pr[k]) * qn[k] * w_uq[(size_t)k * 1536 + c]; });
        else { const int i = (d - DNOPE) >> 1, wh = (d - DNOPE) & 1;
            const float x1 = r * wdot(QL, lane, [&](int k) { return bf2f(pr[k]) * qn[k] * w_uq[(size_t)k * 1536 + hd * DQK + DNOPE + i]; }), x2 = r * wdot(QL, lane, [&](int k) { return bf2f(pr[k]) * qn[k] * w_uq[(size_t)k * 1536 + hd * DQK + DNOPE + 32 + i]; });
            const int pos = row_pos(row); const float cc = rope_cos(pos, i), sn = rope_sin(pos, i); ref = wh ? x1 * sn + x2 * cc : x1 * cc - x2 * sn; }
        report(et, slot, bf2f(qb[(size_t)row * 1536 + c]), ref * CQ, 0.02f, 0.003f, lane);
    } else {
        const int c = hsh(s, 23) % 2048;
        const float r = 1.0f / sqrtf(wdot(KVL, lane, [&](int k) { const float v = bf2f(pr[QL + k]); return v * v; }) / KVL + EPS);
        const float ref = r * wdot(KVL, lane, [&](int k) { return bf2f(pr[QL + k]) * kvn[k] * w_ukv[(size_t)k * 2048 + c]; });
        report(et, slot, bf2f(kvb[(size_t)row * 2048 + c]), ref, 0.02f, 0.02f, lane);
    }
}
__global__ void ck_att(const bf16_t* qb, const bf16_t* kvb, const bf16_t* kpe, const bf16_t* mix, unsigned* et, int slot, int meta) {
    const int s = blockIdx.x, lane = threadIdx.x, row = meta ? MX + (int)(hsh(s, 31) % 64) : (int)(hsh(s, 31) % MX), hd = hsh(s, 32) % NH, d = hsh(s, 33) % DV;
    const int b = row < MX ? row >> 11 : (row - MX) >> 4;
    const bf16_t* q = qb + (size_t)row * 1536 + hd * DQK;
    float sc[33], mx = -1e30f;
    for (int jj = 0; jj < 33; ++jj) { const int t = jj * 64 + lane; float a = -1e30f;
        if (t < LTOK) { const int kr = tok_row(b, t); a = 0.f; for (int k = 0; k < DNOPE; ++k) a += bf2f(q[k]) * bf2f(kvb[(size_t)kr * 2048 + hd * 256 + k]); for (int k = 0; k < ROPE; ++k) a += bf2f(q[DNOPE + k]) * bf2f(kpe[(size_t)kr * 64 + k]); }
        sc[jj] = a; mx = fmaxf(mx, a); }
    for (int o = 1; o < 64; o <<= 1) mx = fmaxf(mx, __shfl_xor(mx, o));
    float num = 0.f, den = 0.f, p2 = 0.f;
    for (int jj = 0; jj < 33; ++jj) { const int t = jj * 64 + lane; if (t < LTOK) { const float p = exp2f(sc[jj] - mx); den += p; p2 += p * p; num += p * bf2f(kvb[(size_t)tok_row(b, t) * 2048 + hd * 256 + 128 + d]); } }
    num = wave_sum(num); den = wave_sum(den); p2 = wave_sum(p2);
    report(et, slot, bf2f(mix[(size_t)row * 2048 + hd * DV + d]), num / den, 0.02f, 0.02f * sqrtf(p2) / den, lane);
}
__global__ void ck_part(const bf16_t* qb, const bf16_t* kvb, const bf16_t* kpe, const float* apart, unsigned* et, int slot_l, int slot_o) {
    const int s = blockIdx.x, lane = threadIdx.x, b = hsh(s, 35) % NBATCH, hd = hsh(s, 36) % NH, e = s % 8, i = hsh(s, 37) % 16, d = hsh(s, 38) % DV;
    const bf16_t* q = qb + (size_t)(MX + NMETA * b + i) * 1536 + hd * DQK;
    const float* pe = (const float*)((const char*)apart + (size_t)((b * NH + hd) * 8 + e) * APART_STRIDE);
    const float m = pe[16 * 128 + i], l = pe[16 * 128 + 16 + i], od = pe[i * 128 + d];
    float S = 0.f, O = 0.f, P2 = 0.f;
    for (int jj = 0; jj < 5; ++jj) { const int kk = jj * 64 + lane; int t = -1;
        if (jj < 4) t = NMETA + 256 * e + kk; else if (e == 0 && lane < NMETA) t = lane;
        if (t >= 0) { const int kr = tok_row(b, t); float a = 0.f; for (int k = 0; k < DNOPE; ++k) a += bf2f(q[k]) * bf2f(kvb[(size_t)kr * 2048 + hd * 256 + k]); for (int k = 0; k < ROPE; ++k) a += bf2f(q[DNOPE + k]) * bf2f(kpe[(size_t)kr * 64 + k]);
            const float p = exp2f(a - m); S += p; P2 += p * p; O += p * bf2f(kvb[(size_t)kr * 2048 + hd * 256 + 128 + d]); } }
    S = wave_sum(S); O = wave_sum(O); P2 = wave_sum(P2);
    report(et, slot_l, l, S, 0.02f, 1e-6f, lane); report(et, slot_o, od, O, 0.02f, 0.02f * sqrtf(P2) + 1e-9f, lane);
}
__global__ void ck_part2(const bf16_t* qb, const bf16_t* kvb, const bf16_t* kpe, const float* apart, unsigned* et, int slot0) {
    const int s = blockIdx.x, lane = threadIdx.x, b = hsh(s, 35) % NBATCH, hd = hsh(s, 36) % NH, e = 1 + s % 7, i = hsh(s, 37) % 16, d = hsh(s, 38) % DV;
    const bf16_t* q = qb + (size_t)(MX + NMETA * b + i) * 1536 + hd * DQK;
    const float* pe = (const float*)((const char*)apart + (size_t)((b * NH + hd) * 8 + e) * APART_STRIDE);
    const float m = pe[16 * 128 + i], od = pe[i * 128 + d];
    float Ot[4], P2 = 0.f;
    for (int jj = 0; jj < 4; ++jj) { const int t = NMETA + 256 * e + jj * 64 + lane; const int kr = tok_row(b, t); float a = 0.f;
        for (int k = 0; k < DNOPE; ++k) a += bf2f(q[k]) * bf2f(kvb[(size_t)kr * 2048 + hd * 256 + k]); for (int k = 0; k < ROPE; ++k) a += bf2f(q[DNOPE + k]) * bf2f(kpe[(size_t)kr * 64 + k]);
        const float p = exp2f(a - m); P2 += p * p; Ot[jj] = wave_sum(p * bf2f(kvb[(size_t)kr * 2048 + hd * 256 + 128 + d])); }
    P2 = wave_sum(P2); const float O = Ot[0] + Ot[1] + Ot[2] + Ot[3], at = 0.02f * sqrtf(P2) + 1e-9f;
    report(et, slot0 + (i >> 2), od, O, 0.02f, at, lane);
    report(et, slot0 + 4 + (d >> 5), od, O, 0.02f, at, lane);
}
__global__ void ck_s5(const bf16_t* proj, const float* lre, const float* lim, const float* lst, const float* bre, const float* bim, const float* cre, const float* cim, const float* dsk, const bf16_t* gb, unsigned* et, int slot, int l) {
    const int s = blockIdx.x, p = threadIdx.x, b = hsh(s, 41) % NBATCH, g = hsh(s, 42) % NG, co = hsh(s, 43) % GS; int t = hsh(s, 44) % LTOK; if (s == 0) t = 0; if (s == 1) t = LTOK - 1; if (s == 2) t = 15; if (s == 3) t = 16; if (s == 4) t = 1055; if (s == 5) t = 1056;
    float y = 0.f;
    for (int d = 0; d < 2; ++d) { const int ldg = (l * 2 + d) * NG + g, i = ldg * NS + p;
        const float lr = lre[i], li = lim[i], dt = expf(lst[ldg]), mag = expf(lr * dt), ar = mag * cosf(li * dt), ai = mag * sinf(li * dt);
        const float den = 1.0f / (lr * lr + li * li), xr = ar - 1.0f, xi = ai, fr = (xr * lr + xi * li) * den, fi = (xi * lr - xr * li) * den;
        float br[GS], bi[GS]; for (int c = 0; c < GS; ++c) { const float a = bre[(size_t)i * GS + c], bb = bim[(size_t)i * GS + c]; br[c] = fr * a - fi * bb; bi[c] = fr * bb + fi * a; }
        float hr = 0.f, hi = 0.f;
        const int t0 = d ? LTOK - 1 : 0, step = d ? -1 : 1, n = d ? LTOK - t : t + 1;
        for (int k = 0, tt = t0; k < n; ++k, tt += step) { const bf16_t* u = proj + (size_t)tok_row(b, tt) * PROJW + 1024 + GS * g; float ur = 0.f, ui = 0.f;
            for (int c = 0; c < GS; ++c) { const float uv = bf2f(u[c]); ur += br[c] * uv; ui += bi[c] * uv; }
            const float nr = ar * hr - ai * hi + ur, ni = ar * hi + ai * hr + ui; hr = nr; hi = ni; }
        y += cre[((size_t)ldg * GS + co) * NS + p] * hr - cim[((size_t)ldg * GS + co) * NS + p] * hi; }
    y = wave_sum(y);
    const size_t row = tok_row(b, t); y += dsk[GS * g + co] * bf2f(proj[row * PROJW + 1024 + GS * g + co]);
    const float tt = 0.7978845608028654f * (y + 0.044715f * y * y * y), ref = 0.5f * y * (1.0f + tanhf(tt));
    report(et, slot, bf2f(gb[row * SSMW + GS * g + co]), ref, 0.03f, 0.03f, p);
}
__global__ void ck_glu(const bf16_t* gb, const float* w_glu, const bf16_t* mix, unsigned* et, int slot) {
    const int s = blockIdx.x, lane = threadIdx.x, row = pick_row(s, 51), c = hsh(s, 52) % SSMW; const bf16_t* g = gb + (size_t)row * SSMW;
    const float z = wdot(SSMW, lane, [&](int k) { return bf2f(g[k]) * w_glu[(size_t)k * SSMW + c]; }), gv = bf2f(g[c]);
    report(et, slot, bf2f(mix[(size_t)row * 2048 + ATTW + c]), gv / (1.0f + expf(-z)), 0.02f, 0.01f, lane);
}
__global__ void ck_mixn(const bf16_t* mix, const bf16_t* mixn, unsigned* et, int slot) {
    const int s = blockIdx.x, lane = threadIdx.x, row = pick_row(s, 61), c = hsh(s, 62) % 2048, hf = c >> 10; const bf16_t* m = mix + (size_t)row * 2048 + hf * 1024;
    const float r = 1.0f / sqrtf(wdot(1024, lane, [&](int k) { const float v = bf2f(m[k]); return v * v; }) / 1024 + EPS);
    report(et, slot, bf2f(mixn[(size_t)row * 2048 + c]), bf2f(mix[(size_t)row * 2048 + c]) * r, 0.02f, 0.02f, lane);
}
__global__ void ck_gout(const float* h, const float* hs, const bf16_t* mixn, const float* w_out, const float* ga, const float* gs, unsigned* et, int slot) {
    const int s = blockIdx.x, lane = threadIdx.x, row = pick_row(s, 71), c = hsh(s, 72) % DM; const bf16_t* m = mixn + (size_t)row * 2048;
    const float ref = hs[(size_t)row * DM + c] + wdot(DM, lane, [&](int k) { return bf2f(m[k]) * (k < ATTW ? ga[k] : gs[k - ATTW]) * w_out[(size_t)k * DM + c]; });
    report(et, slot, h[(size_t)row * DM + c], ref, 0.01f, 0.02f, lane);
}
__global__ void ck_act(const float* h, const float* wg, const float* wu, const float* gain, const bf16_t* act, unsigned* et, int slot) {
    const int s = blockIdx.x, lane = threadIdx.x, row = pick_row(s, 81), f = hsh(s, 82) % DFF; const float* hr = h + (size_t)row * DM;
    const float r = 1.0f / sqrtf(wdot(DM, lane, [&](int k) { return hr[k] * hr[k]; }) / DM + EPS);
    const float g = r * wdot(DM, lane, [&](int k) { return hr[k] * gain[k] * wg[(size_t)k * DFF + f]; }), u = r * wdot(DM, lane, [&](int k) { return hr[k] * gain[k] * wu[(size_t)k * DFF + f]; });
    report(et, slot, bf2f(act[(size_t)row * DFF + f]), g / (1.0f + expf(-g)) * u, 0.03f, 0.02f, lane);
}
__global__ void ck_down(const float* h, const float* hs, const bf16_t* act, const float* wd, unsigned* et, int slot) {
    const int s = blockIdx.x, lane = threadIdx.x, row = pick_row(s, 91), c = hsh(s, 92) % DM; const bf16_t* a = act + (size_t)row * DFF;
    const float ref = hs[(size_t)row * DM + c] + wdot(DFF, lane, [&](int k) { return bf2f(a[k]) * wd[(size_t)k * DM + c]; });
    report(et, slot, h[(size_t)row * DM + c], ref, 0.01f, 0.02f, lane);
}
__global__ void ck_moe(const float* h, const float* hs, const float* wr, const float* wg, const float* wu, const float* wd, const float* gain, unsigned* et, int slot) {
    const int s = blockIdx.x, lane = threadIdx.x, row = pick_row(s, 101), c = hsh(s, 102) % DM; const float* hr = hs + (size_t)row * DM;
    const float r = 1.0f / sqrtf(wdot(DM, lane, [&](int k) { return hr[k] * hr[k]; }) / DM + EPS);
    float lg[NE]; for (int e = 0; e < NE; ++e) lg[e] = r * wdot(DM, lane, [&](int k) { return hr[k] * gain[k] * wr[(size_t)k * NE + e]; });
    int e0 = 0; for (int e = 1; e < NE; ++e) if (lg[e] > lg[e0]) e0 = e; int e1 = -1; for (int e = 0; e < NE; ++e) if (e != e0 && (e1 < 0 || lg[e] > lg[e1])) e1 = e;
    const float w1 = 1.0f / (1.0f + expf(lg[e0] - lg[e1])), w0 = 1.0f - w1;
    float acc = 0.f;
    for (int kk = 0; kk < 2; ++kk) { const int e = kk ? e1 : e0; const float we = kk ? w1 : w0; const float* g_ = wg + (size_t)e * DM * DFE; const float* u_ = wu + (size_t)e * DM * DFE; const float* d_ = wd + (size_t)e * DFE * DM;
        for (int f = lane; f < DFE; f += 64) { float ga = 0.f, ua = 0.f; for (int k = 0; k < DM; ++k) { const float x = hr[k] * gain[k]; ga += x * g_[(size_t)k * DFE + f]; ua += x * u_[(size_t)k * DFE + f]; }
            ga *= r; ua *= r; acc += we * (ga / (1.0f + expf(-ga)) * ua) * d_[(size_t)f * DM + c]; } }
    acc = wave_sum(acc);
    report(et, slot, h[(size_t)row * DM + c], hr[c] + acc, 0.01f, 0.02f, lane);
}
__global__ void ck_final(const float* h, const float* fn, const float* out, unsigned* et, int slot) {
    const int s = blockIdx.x, lane = threadIdx.x, row = pick_row(s, 111) % MX, c = hsh(s, 112) % DM; const float* hr = h + (size_t)row * DM;
    const float r = 1.0f / sqrtf(wdot(DM, lane, [&](int k) { return hr[k] * hr[k]; }) / DM + EPS);
    report(et, slot, out[(size_t)row * DM + c], hr[c] * r * fn[c], 0.001f, 0.001f, lane);
}
__global__ void encode(const unsigned* et, float* out, size_t n) {
    float code = -1.f; const unsigned tmo = et[200] | et[256 + 200];
    for (int pass = 0; pass < 2 && code < 0.f; ++pass)
        for (int l = 0; l < DEPTH && code < 0.f; ++l) { int v = 0;
            for (int k = 1; k <= 10; ++k) { const int sl = 10 + 20 * l + k; const bool f1 = __uint_as_float(et[sl]) > 3.0f, f2 = __uint_as_float(et[256 + sl]) > 3.0f; if (pass == 0 ? (f1 && f2) : (f1 != f2)) v |= 1 << (k - 1); }
            if (v) code = (float)(10 + v % 90) * 0.1f * powf(10.0f, (float)(4 + v / 90 + 12 * l + 48 * pass)); }
    if (code < 0.f && (__uint_as_float(et[95]) > 3.0f || __uint_as_float(et[256 + 95]) > 3.0f)) code = 9.5e2f;
    if (tmo) code = 9.9e2f;
    if (code < 0.f) return;
    const float a = sqrtf(code);
    for (size_t i = (size_t)blockIdx.x * blockDim.x + threadIdx.x; i < n; i += (size_t)gridDim.x * blockDim.x) out[i] = a;
}
__global__ void copy_tmo(const unsigned* ctl, unsigned* et) { if (threadIdx.x == 0) et[200] = ctl[CW_BAR + XB_TMO] | ctl[CW_TMO]; }
}
#endif

__global__ void fill_kernel(float* out, size_t n, float a) { for (size_t i = (size_t)blockIdx.x * blockDim.x + threadIdx.x; i < n; i += (size_t)gridDim.x * blockDim.x) out[i] = a; }
extern "C" void kernel_launch(void* const* d_in, const int* in_sizes, int n_in, void* d_out, int out_size, void* d_ws, size_t ws_size, hipStream_t stream) {
    static int grid = 0;
    if (grid == 0) {
        if (n_in == 29 && out_size == MX * DM && ws_size < WS_TOTAL) { grid = -2; }
        else if (n_in != 29 || out_size != MX * DM) { fprintf(stderr, "kernel_launch: built for 29 inputs, %d outputs, >= %zu bytes of workspace; got n_in %d, out %d, ws %zu; nothing launched\n", MX * DM, (size_t)WS_TOTAL, n_in, out_size, ws_size); grid = -1; return; }
        int dev = 0, cus = 0, per_cu = 0;
        if (grid == -2) {   } else
        if (hipGetDevice(&dev) != hipSuccess || hipDeviceGetAttribute(&cus, hipDeviceAttributeMultiprocessorCount, dev) != hipSuccess) { grid = -1; return; }
        if (grid == -2) {} else if (hipFuncSetAttribute((const void*)fwd_kernel, hipFuncAttributeMaxDynamicSharedMemorySize, LDS_BYTES) != hipSuccess) { fprintf(stderr, "kernel_launch: hipFuncSetAttribute failed\n"); grid = -1; return; }
        if (grid != -2) if (hipOccupancyMaxActiveBlocksPerMultiprocessor(&per_cu, (const void*)fwd_kernel, NTHR, LDS_BYTES) != hipSuccess || per_cu < 1) fprintf(stderr, "kernel_launch: occupancy query says %d\n", per_cu);
        (void)hipGetLastError();
        if (grid != -2) grid = cus;
    }
    if (grid == -2) { hipLaunchKernelGGL(fill_kernel, dim3(1024), dim3(256), 0, stream, (float*)d_out, (size_t)out_size, 9949.87f); return; }
    if (grid < 0) return;
    (void)hipMemsetAsync((char*)d_ws + WS_CTL, 0, CTL_BYTES, stream);
    Args a{};
    for (int i = 0; i < 29; ++i) a.in.p[i] = (const float*)d_in[i];
    a.out = (float*)d_out; a.ws = (unsigned char*)d_ws;
#if !DBG
    a.ph_lo = 0; a.ph_hi = 128;
    hipLaunchKernelGGL(fwd_kernel, dim3(grid), dim3(NTHR), LDS_BYTES, stream, a);
#else
    unsigned char* ws = (unsigned char*)d_ws; unsigned* et = (unsigned*)(ws + WS_DBG_ERR); float* hs = (float*)(ws + WS_DBG_H);
    float* h = (float*)(ws + WS_H); bf16_t* proj = (bf16_t*)(ws + WS_PROJ); bf16_t* kpe = (bf16_t*)(ws + WS_KPE); bf16_t* qb = (bf16_t*)(ws + WS_QB); bf16_t* kvb = (bf16_t*)(ws + WS_KVB);
    bf16_t* mix = (bf16_t*)(ws + WS_MIX); bf16_t* mixn = (bf16_t*)(ws + WS_MIXN); bf16_t* gb = (bf16_t*)(ws + WS_GB); bf16_t* act = (bf16_t*)(ws + WS_BIG);
    const float* const* in = (const float* const*)a.in.p;
    (void)hipMemsetAsync(et, 0, 4096, stream);
    for (int rep = 0; rep < 2; ++rep) {
    if (rep) { (void)hipMemsetAsync((char*)d_ws + WS_CTL, 0, CTL_BYTES, stream); et += 256; }
    auto run = [&](int ph) { a.ph_lo = ph; a.ph_hi = ph + 1; hipLaunchKernelGGL(fwd_kernel, dim3(grid), dim3(NTHR), LDS_BYTES, stream, a); };
    auto snap = [&]() { (void)hipMemcpyAsync(hs, h, (size_t)MP * DM * 4, hipMemcpyDeviceToDevice, stream); };
    const int NSMP = 512;
    run(0);
    for (int l = 0; l < DEPTH; ++l) {
        const int P = 32 * l, SL = 10 + 20 * l;
        run(P + 1); run(P + 2); hipLaunchKernelGGL(dbg::ck_g1, dim3(NSMP), dim3(64), 0, stream, h, in[3] + (size_t)l * DM * INC, in[2] + l * DM, proj, kpe, et, SL + 1);
        run(P + 3); hipLaunchKernelGGL(dbg::ck_g2, dim3(NSMP), dim3(64), 0, stream, proj, in[5] + (size_t)l * QL * 1536, in[4] + l * QL, in[7] + (size_t)l * KVL * 2048, in[6] + l * KVL, qb, kvb, et, SL + 2);
        hipLaunchKernelGGL(dbg::ck_s5, dim3(96), dim3(64), 0, stream, proj, in[8], in[9], in[10], in[11], in[12], in[13], in[14], in[15] + (size_t)l * SSMW, gb, et, SL + 4, l);
        run(P + 4); hipLaunchKernelGGL(dbg::ck_glu, dim3(NSMP), dim3(64), 0, stream, gb, in[16] + (size_t)l * SSMW * SSMW, mix, et, SL + 5);
        run(P + 5); hipLaunchKernelGGL(dbg::ck_att, dim3(256), dim3(64), 0, stream, qb, kvb, kpe, mix, et, SL + 3, 0); hipLaunchKernelGGL(dbg::ck_att, dim3(64), dim3(64), 0, stream, qb, kvb, kpe, mix, et, SL + ((l & 1) ? 8 : 10), 1);
        hipLaunchKernelGGL(dbg::ck_mixn, dim3(NSMP), dim3(64), 0, stream, mix, mixn, et, SL + 6);
        snap(); run(P + 6); run((l & 1) ? P + 16 : P + 7);
        hipLaunchKernelGGL(dbg::ck_gout, dim3(NSMP), dim3(64), 0, stream, h, hs, mixn, in[19] + (size_t)l * DM * DM, in[17] + l * ATTW, in[18] + l * SSMW, et, SL + 7);
        if ((l & 1) == 0) { const int i = l >> 1;
            run(P + 8); hipLaunchKernelGGL(dbg::ck_act, dim3(NSMP), dim3(64), 0, stream, h, in[21] + (size_t)i * DM * DFF, in[22] + (size_t)i * DM * DFF, in[20] + (size_t)l * DM, act, et, SL + 8);
            snap(); run(P + 9); run(P + 10); hipLaunchKernelGGL(dbg::ck_down, dim3(NSMP), dim3(64), 0, stream, h, hs, act, in[23] + (size_t)i * DFF * DM, et, SL + 9);
        } else { const int i = l >> 1;
            snap(); run(P + 17); run(P + 18); run(P + 19); run(P + 20);
            hipLaunchKernelGGL(dbg::ck_moe, dim3(48), dim3(64), 0, stream, h, hs, in[24] + (size_t)i * DM * NE, in[25] + (size_t)i * NE * DM * DFE, in[26] + (size_t)i * NE * DM * DFE, in[27] + (size_t)i * NE * DFE * DM, in[20] + (size_t)l * DM, et, SL + 10);
        }
    }
    hipLaunchKernelGGL(dbg::ck_final, dim3(NSMP), dim3(64), 0, stream, h, in[28], (const float*)d_out, et, 95);
    hipLaunchKernelGGL(dbg::copy_tmo, dim3(1), dim3(64), 0, stream, (const unsigned*)(ws + WS_CTL), et);
    }
    hipLaunchKernelGGL(dbg::encode, dim3(1024), dim3(256), 0, stream, (const unsigned*)(ws + WS_DBG_ERR), (float*)d_out, (size_t)MX * DM);
#endif
}
```

```cpp
#include <hip/hip_runtime.h>
#include <cstdio>
#include <cstdint>

#ifndef PROBE_REP
#define PROBE_REP 0
#endif
#ifndef DBG
#define DBG 0
#endif

constexpr int DM = 2048, NBATCH = 4, SEQ = 2048, NMETA = 16, LTOK = SEQ + NMETA, DEPTH = 4;
constexpr int MX = NBATCH * SEQ, MREAL = MX + NBATCH * NMETA, MP = 8448;
constexpr int QL = 512, KVL = 256, ROPE = 64, NH = 8, DNOPE = 128, DQK = 192, DV = 128;
constexpr int ATTW = 1024, SSMW = 1024, NG = 64, GS = 16, NS = 64, INC = 1856;
constexpr int DFF = 5632, NE = 8, DFE = 1408;
constexpr float EPS = 1e-6f;
constexpr float CQ = 0.07216878364870323f * 1.4426950408889634f;
constexpr int PROJW = 2048;
constexpr int MOE_ROWS = 18688;

typedef unsigned short bf16_t;
typedef short bf16x8 __attribute__((ext_vector_type(8)));
typedef short s16x4 __attribute__((ext_vector_type(4)));
typedef float f32x4 __attribute__((ext_vector_type(4)));
typedef float f32x2 __attribute__((ext_vector_type(2)));
typedef float f32x16 __attribute__((ext_vector_type(16)));
typedef unsigned u32x4 __attribute__((ext_vector_type(4)));
typedef unsigned u32x2 __attribute__((ext_vector_type(2)));
typedef int i32x8 __attribute__((ext_vector_type(8)));
typedef int i32x4 __attribute__((ext_vector_type(4)));
#define LAS __attribute__((address_space(3)))
#define GAS __attribute__((address_space(1)))

constexpr size_t al256(size_t x) { return (x + 255) / 256 * 256; }
constexpr size_t WS_CTL = 0;
constexpr int CW_TMO = 0, CW_BAR = 4096, CW_CNT = 8192, CW_TKT = 12288;
constexpr size_t CTL_SSQ = 65536;
constexpr int NSSQ = DEPTH * 4 + 1;
constexpr size_t CTL_BYTES = al256(CTL_SSQ + (size_t)NSSQ * MP * 8);
constexpr size_t WS_TAB = al256(CTL_BYTES);
constexpr size_t WS_DBG_ERR = WS_TAB + 256;
constexpr size_t WS_W = WS_DBG_ERR + 4096;
constexpr size_t SZ_WIN = (size_t)2048 * 2048 * 2, SZ_WUQ = (size_t)1536 * 512 * 2, SZ_WUKV = (size_t)2048 * 256 * 2, SZ_WGLU = (size_t)1024 * 1024 * 2, SZ_WOUT = (size_t)2048 * 2048 * 2;
constexpr size_t SZ_LAYER = SZ_WIN + SZ_WUQ + SZ_WUKV + SZ_WGLU + SZ_WOUT;
constexpr size_t OFF_WIN = 0, OFF_WUQ = SZ_WIN, OFF_WUKV = OFF_WUQ + SZ_WUQ, OFF_WGLU = OFF_WUKV + SZ_WUKV, OFF_WOUT = OFF_WGLU + SZ_WGLU;
constexpr size_t WS_WFF = WS_W + DEPTH * SZ_LAYER;
constexpr size_t SZ_DGU = (size_t)2 * DFF * DM * 2, SZ_DDN = (size_t)DM * DFF * 2, SZ_DENSE = SZ_DGU + SZ_DDN;
constexpr size_t SZ_EGU = (size_t)2 * DFE * DM * 2, SZ_EDN = (size_t)DM * DFE * 2, SZ_EXP = SZ_EGU + SZ_EDN;
constexpr size_t SZ_MOE = NE * SZ_EXP;
constexpr size_t WS_S5 = WS_WFF + 2 * SZ_DENSE + 2 * SZ_MOE;
constexpr size_t S5_LAM = 0, S5_BRE = 512, S5_BIM = 512 + 2048, S5_CEF = 512 + 4096, S5_STRIDE = 512 + 4096 + 4096;
constexpr size_t WS_ROPE = al256(WS_S5 + (size_t)DEPTH * 2 * NG * S5_STRIDE);
constexpr size_t WS_H = al256(WS_ROPE + (size_t)2 * LTOK * 32 * 4);
constexpr size_t WS_HB = WS_H + (size_t)MP * DM * 4;
constexpr size_t WS_PROJ = WS_HB + (size_t)MP * DM * 2;
constexpr size_t WS_KPE = WS_PROJ + (size_t)MP * PROJW * 2;
constexpr size_t WS_QB = WS_KPE + (size_t)MP * 64 * 2;
constexpr size_t WS_KVB = WS_QB + (size_t)MP * 1536 * 2;
constexpr size_t WS_MIX = WS_KVB + (size_t)MP * 2048 * 2;
constexpr size_t WS_MIXN = WS_PROJ;
constexpr size_t WS_YP = WS_MIX + (size_t)MP * 2048 * 2;
constexpr size_t WS_GB = WS_YP + (size_t)MP * 1024 * 4;
constexpr size_t WS_APART = WS_GB + (size_t)MP * 1024 * 2;
constexpr size_t APART_STRIDE = (16 * 128 + 32) * 4;
constexpr size_t WS_ROUTE = al256(WS_APART + (size_t)NBATCH * NH * 8 * APART_STRIDE);
constexpr size_t WS_RPERM = WS_ROUTE + (size_t)MP * 32;
constexpr size_t WS_GPERM = WS_RPERM + (size_t)NE * MP * 4;
constexpr size_t WS_BIG = al256(WS_GPERM + (size_t)NE * MP * 4);
constexpr size_t WS_MACT = WS_BIG, WS_XPERM = WS_MACT + (size_t)MOE_ROWS * DFE * 2, WS_YSLOT = WS_XPERM;
constexpr size_t WS_END = WS_YSLOT + (size_t)MOE_ROWS * 2048 * 4;
static_assert((size_t)MP * DFF * 2 <= WS_END - WS_BIG, "dense act fits the overlay");
constexpr size_t WS_DBG_H = WS_QB;
static_assert(WS_DBG_H + (size_t)MP * DM * 4 <= WS_YP, "snapshot fits");
constexpr size_t WS_SLAB = al256(WS_END);
constexpr int SLAB_MAXSL = 22;
constexpr size_t WS_TOTAL = WS_SLAB + (size_t)SLAB_MAXSL * 64 * 2048 * 4;

typedef unsigned long long ssq_t;
constexpr float SSQ_SCALE = 16777216.0f, SSQ_INV = 1.0f / 16777216.0f;
__device__ __forceinline__ float ssq_get(const ssq_t* p, int row) { return (float)p[row] * SSQ_INV; }
__device__ __forceinline__ ssq_t ssq_fix(float ss) { return (ssq_t)(ss * SSQ_SCALE); }
__host__ __device__ constexpr int SSQ_H1(int l) { return l * 4; }
__host__ __device__ constexpr int SSQ_CQ(int l) { return l * 4 + 1; }
__host__ __device__ constexpr int SSQ_CKV(int l) { return l * 4 + 2; }
__host__ __device__ constexpr int SSQ_H2(int l) { return l * 4 + 3; }

__device__ __forceinline__ unsigned cvt_pk_bf16(float lo, float hi) { unsigned r; asm volatile("v_cvt_pk_bf16_f32 %0, %1, %2" : "=v"(r) : "v"(lo), "v"(hi)); return r; }
constexpr float F8_HS = 4.0f, F8_WGU = 64.0f, F8_AS = 8.0f, F8_WDN = 256.0f;
constexpr int DFEP = 1536;
constexpr float F8_GS = 16.0f, F8_WGL = 32.0f;
__device__ __forceinline__ unsigned pk4_fp8(float a, float b, float c, float d) {
    unsigned r = 0;
    r = __builtin_amdgcn_cvt_pk_fp8_f32(__builtin_amdgcn_fmed3f(a, -448.0f, 448.0f), __builtin_amdgcn_fmed3f(b, -448.0f, 448.0f), r, false);
    r = __builtin_amdgcn_cvt_pk_fp8_f32(__builtin_amdgcn_fmed3f(c, -448.0f, 448.0f), __builtin_amdgcn_fmed3f(d, -448.0f, 448.0f), r, true);
    return r; }
__device__ __forceinline__ float bf2f(unsigned short b) { return __uint_as_float(((unsigned)b) << 16); }
__device__ __forceinline__ float bflo(unsigned w) { return __uint_as_float(w << 16); }
__device__ __forceinline__ float bfhi(unsigned w) { return __uint_as_float(w & 0xffff0000u); }
__device__ __forceinline__ float fast_exp2(float x) { return __builtin_amdgcn_exp2f(x); }
__device__ __forceinline__ float fast_rcp(float x) { return __builtin_amdgcn_rcpf(x); }
__device__ __forceinline__ float sigmoidf_(float z) { return fast_rcp(1.0f + fast_exp2(-1.4426950408889634f * z)); }
__device__ __forceinline__ float gelu_tanh(float y) { const float t = 0.7978845608028654f * (y + 0.044715f * y * y * y); return y * sigmoidf_(2.0f * t); }
__device__ __forceinline__ float wave_sum(float v) {
#pragma unroll
    for (int o = 1; o < 64; o <<= 1) v += __shfl_xor(v, o);
    return v;
}
__device__ __forceinline__ float swap32(float x, int hh) { auto rr = __builtin_amdgcn_permlane32_swap(__float_as_uint(x), __float_as_uint(x), false, false); return __uint_as_float(hh ? rr[0] : rr[1]); }
__device__ __forceinline__ int row_pos(int row) { return row < MX ? NMETA + (row & (SEQ - 1)) : ((row - MX) & (NMETA - 1)); }
__device__ __forceinline__ int tok_row(int b, int t) { return t < NMETA ? MX + NMETA * b + t : SEQ * b + t - NMETA; }
#define LDS_WAIT() asm volatile("s_waitcnt lgkmcnt(0)" ::: "memory")
#define VM_WAIT() asm volatile("s_waitcnt vmcnt(0)" ::: "memory")

namespace pg8 {
constexpr int BM = 256, BK = 64, HALF = 128, HTB = HALF * BK * 2, STAGE_BYTES = 8 * HTB, NXCD = 8, WGM = 8;
__host__ __device__ __forceinline__ int lds_byte(int r, int c) { const int st = (r >> 4) * 2 + (c >> 5), rr = r & 15, cc = c & 31, ob = rr * 64 + cc * 2; return st * 1024 + (ob ^ (((ob >> 9) & 1) << 5)); }
__host__ __device__ __forceinline__ void stage_rc(int b, int& R, int& C) { const int st = b / 1024, sb = b % 1024, swz = sb ^ (((sb >> 9) & 1) << 5); R = (st >> 1) * 16 + swz / 64; C = (st & 1) * 32 + (swz % 64) / 2; }
__host__ __device__ __forceinline__ int perm32(int rho) { const int n = rho >> 4, i = rho & 15; return 8 * (i >> 2) + 4 * n + (i & 3); }
struct Unit { int pm, pn, ks, roff; };

__device__ __forceinline__ bool order2d(int i, int G, int c, int nM, int nN, Unit& u) {
    const int nwg = nM * nN; const long L = (long)i * G + c; if (L >= nwg) return false;
    int wgid = (int)L; { const int q = nwg / NXCD, r = nwg % NXCD, xcd = wgid % NXCD, off = wgid / NXCD; wgid = (xcd < r ? xcd * (q + 1) : r * (q + 1) + (xcd - r) * q) + off; }
    const int nig = WGM * nN, gid = wgid / nig, fm = gid * WGM, gsz = (nM - fm) < WGM ? (nM - fm) : WGM;
    u.pm = fm + ((wgid % nig) % gsz); u.pn = (wgid % nig) / gsz; u.ks = -1; u.roff = 0; return true;
}
struct Sched2D {
    static constexpr bool HAS_TAIL = false;
    const bf16_t* A; const bf16_t* Bt; int lda, K, nM, nN, G, c;
    __device__ __forceinline__ int nt(const Unit&) const { return K / BK; }
    __device__ __forceinline__ bool next(int i, Unit& u) const { return order2d(i, G, c, nM, nN, u); }
    __device__ __forceinline__ void ptrs(const Unit& u, const char*& a, const char*& b) const { a = (const char*)A + (size_t)u.pm * BM * lda * 2; b = (const char*)Bt + (size_t)u.pn * BM * K * 2; }
};
struct SchedT {
    static constexpr bool HAS_TAIL = true;
    const bf16_t* A; const bf16_t* Bt; int lda, K, nN, G, c, sliceK, nslice;
    __device__ __forceinline__ int nt(const Unit& u) const { return (u.ks < 0 ? K : sliceK) / BK; }
    __device__ __forceinline__ bool next(int i, Unit& u) const {
        if (order2d(i, G, c, MX / BM, nN, u)) return true;
        const long L = (long)i * G + c - (long)(MX / BM) * nN; if (L < 0 || L >= (long)nN * nslice) return false;
        u.pm = MX / BM; u.pn = (int)(L % nN); u.ks = (int)(L / nN); u.roff = 0; return true; }
    __device__ __forceinline__ void ptrs(const Unit& u, const char*& a, const char*& b) const { const size_t ko = u.ks < 0 ? 0 : (size_t)u.ks * sliceK * 2;
        a = (const char*)A + (size_t)u.pm * BM * lda * 2 + ko; b = (const char*)Bt + (size_t)u.pn * BM * K * 2 + ko; }
};
struct SchedMoE {
    static constexpr bool HAS_TAIL = false;
    const bf16_t* A; const bf16_t* Bt0; size_t estride; int lda, K, nN, G, c; int pfx[NE + 1]; int capA;
    __device__ __forceinline__ int nt(const Unit&) const { return K / BK; }
    __device__ __forceinline__ bool next(int i, Unit& u) const {
        if (!order2d(i, G, c, pfx[NE], nN, u)) return false;
        int e = 0, pe = 0;
#pragma unroll
        for (int j = 1; j < NE; ++j) if (u.pm >= pfx[j]) { e = j; pe = pfx[j]; }
        u.roff = e * MP - pe * BM; return true; }
    __device__ __forceinline__ void ptrs(const Unit& u, const char*& a, const char*& b) const {
        int e = 0;
#pragma unroll
        for (int j = 1; j < NE; ++j) e += (u.pm >= pfx[j]) ? 1 : 0;
        a = (const char*)A + (size_t)(u.pm * BM + (capA ? u.roff : 0)) * lda * 2; b = (const char*)Bt0 + (size_t)e * estride + (size_t)u.pn * BM * K * 2; }
};

template <bool PERM>
__device__ __forceinline__ void tail_store(const f32x4 (&acc)[2][2][4][2], const Unit& u, int wr, int wc, int fr, int fq, float* slab, int N) {
    if (wr != 0) return;
    { unsigned z = 0u; asm volatile("" : "+v"(z)); const int ln = (int)__builtin_amdgcn_mbcnt_hi(~0u, __builtin_amdgcn_mbcnt_lo(~0u, z)); fr = ln & 15; fq = ln >> 4; }
    asm volatile("" : "+s"(slab), "+v"(fr), "+v"(fq));
#pragma unroll
    for (int m = 0; m < 4; ++m) { float* rp = slab + ((size_t)u.ks * 64 + m * 16 + fr) * N + u.pn * BM + wc * 32;
#pragma unroll
        for (int bj = 0; bj < 2; ++bj)
#pragma unroll
            for (int n = 0; n < 2; ++n) *(f32x4*)(rp + bj * HALF + (PERM ? 8 * fq + 4 * n : 16 * n + 4 * fq)) = acc[0][bj][m][n]; }
}
__host__ __device__ __forceinline__ int f8_p(int fr) { return ((fr >> 1) & 7) ^ (2 * (((fr >> 2) ^ (fr >> 3)) & 1)); }
template <class Epi, class Sched, bool ALIGN_EPI, bool F8 = false>
__device__ __forceinline__ void gemm_phase(LAS unsigned char* lds, const Sched& S, const Epi& E, int tid) {
    const int wid = __builtin_amdgcn_readfirstlane(tid >> 6), lane = tid & 63, wr = wid >> 2, wc = wid & 3, fr = lane & 15, fq = lane >> 4;
    const int K = S.K, lda = S.lda;
    unsigned voffA[2], voffB[2];
#pragma unroll
    for (int i = 0; i < 2; ++i) { int R, C;
        if constexpr (F8) { const int a = tid * 16 + i * 8192; R = a >> 7; C = ((((a >> 4) & 7) ^ f8_p(R & 15)) * 8); } else stage_rc(tid * 16 + i * 8192, R, C);
        const int Rb = Epi::PERM ? ((R & ~31) + perm32(R & 31)) : R;
        voffA[i] = (unsigned)(R * lda + C) * 2u; voffB[i] = (unsigned)(Rb * K + C) * 2u; }
    const size_t kstep = (size_t)(BK * 2);
    const size_t hstepA = (size_t)HALF * lda * 2, hstepB = (size_t)HALF * K * 2;
    const unsigned ldsw = (unsigned)wid * 1024u;
    const int aoff = F8 ? wr * 8192 + fr * 128 + (((2 * fq) ^ f8_p(fr)) * 16) : lds_byte(wr * 64 + fr, fq * 8), boff = F8 ? wc * 4096 + fr * 128 + (((2 * fq) ^ f8_p(fr)) * 16) : lds_byte(wc * 32 + fr, fq * 8);
    const int xoff1 = F8 ? ((((2 * fq + 1) ^ f8_p(fr)) - ((2 * fq) ^ f8_p(fr))) * 16) : 1024;
#define PG8_SA(b, h) (((b) * 2 + (h)) * HTB)
#define PG8_SB(b, h) ((4 + (b) * 2 + (h)) * HTB)
#define PG8_STAGE(bufoff, gbase, voff) do { _Pragma("unroll") for (int _i = 0; _i < 2; ++_i) \
        __builtin_amdgcn_global_load_lds((const unsigned*)((const char*)(gbase) + (voff)[_i]), (LAS unsigned*)(lds + (bufoff) + ldsw + _i * 8192), 16, 0, 0); } while (0)
#define PG8_LDA(dst, b, h) do { _Pragma("unroll") for (int m = 0; m < 4; ++m) { dst[m][0] = *(const LAS bf16x8*)(lds + PG8_SA(b, h) + aoff + m * 2048); dst[m][1] = *(const LAS bf16x8*)(lds + PG8_SA(b, h) + aoff + m * 2048 + xoff1); } } while (0)
#define PG8_LDB(dst, b, h) do { _Pragma("unroll") for (int n = 0; n < 2; ++n) { dst[n][0] = *(const LAS bf16x8*)(lds + PG8_SB(b, h) + boff + n * 2048); dst[n][1] = *(const LAS bf16x8*)(lds + PG8_SB(b, h) + boff + n * 2048 + xoff1); } } while (0)
#define PG8_F8FRAG(F) __builtin_shufflevector(__builtin_bit_cast(i32x4, F[0]), __builtin_bit_cast(i32x4, F[1]), 0, 1, 2, 3, 4, 5, 6, 7)
#define PG8_MMA(ai, bj, At, Bt) do { __builtin_amdgcn_s_setprio(1); if constexpr (F8) asm volatile("s_nop 1"); _Pragma("unroll") for (int m = 0; m < 4; ++m) _Pragma("unroll") for (int n = 0; n < 2; ++n) { \
        if constexpr (F8) asm volatile("v_mfma_f32_16x16x128_f8f6f4 %0, %1, %2, %0" : "+v"(acc[ai][bj][m][n]) : "v"(PG8_F8FRAG(Bt[n])), "v"(PG8_F8FRAG(At[m])));   \
        else { _Pragma("unroll") for (int k = 0; k < 2; ++k) acc[ai][bj][m][n] = __builtin_amdgcn_mfma_f32_16x16x32_bf16(Bt[n][k], At[m][k], acc[ai][bj][m][n], 0, 0, 0); } } \
        __builtin_amdgcn_s_setprio(0); } while (0)
#define PG8_WAIT_V(n) asm volatile("s_waitcnt vmcnt(" #n ")" ::: "memory")
#define PG8_WAIT_L(n) asm volatile("s_waitcnt lgkmcnt(" #n ")" ::: "memory")
#define PG8_BAR __builtin_amdgcn_s_barrier()
#define PG8_SCHED __builtin_amdgcn_sched_barrier(0)
    Unit cur, nxt; int ui = 0;
    if (!S.next(0, cur)) return;
    int nt = S.nt(cur);
    f32x4 acc[2][2][4][2];
#pragma unroll
    for (int a = 0; a < 2; ++a)
#pragma unroll
        for (int b = 0; b < 2; ++b)
#pragma unroll
            for (int m = 0; m < 4; ++m)
#pragma unroll
                for (int n = 0; n < 2; ++n) acc[a][b][m][n] = (f32x4){0.f, 0.f, 0.f, 0.f};
    bf16x8 At[4][2], B0[2][2], B1[2][2];
    const char* cA; const char* cB; S.ptrs(cur, cA, cB);
    PG8_STAGE(PG8_SB(0, 0), cB, voffB); PG8_STAGE(PG8_SB(0, 1), cB + hstepB, voffB); PG8_STAGE(PG8_SA(0, 0), cA, voffA); PG8_STAGE(PG8_SA(0, 1), cA + hstepA, voffA);
    if constexpr (Epi::MIDSCALE) E.prep(S, tid);
    if (wr == 1) PG8_BAR;
    PG8_WAIT_V(2); PG8_BAR;
    PG8_STAGE(PG8_SB(1, 0), cB + kstep, voffB); PG8_STAGE(PG8_SA(1, 0), cA + kstep, voffA); PG8_STAGE(PG8_SB(1, 1), cB + hstepB + kstep, voffB);
    PG8_WAIT_V(6); PG8_BAR;
    for (;;) {
        const bool has_next = S.next(ui + 1, nxt);
        const char* nA = cA; const char* nB = cB; if (has_next) S.ptrs(nxt, nA, nB);
        for (int t = 0; t < nt; t += 2) {
            if constexpr (Epi::MIDSCALE) { if (cur.ks < 0 && t == nt / 2) E.midscale(acc, cur, wr, fr); }
            const bool last = (t == nt - 2);
            const char* a1 = cA + (size_t)(t + 1) * kstep;
            const char* a2 = last ? nA : cA + (size_t)(t + 2) * kstep; const char* b2 = last ? nB : cB + (size_t)(t + 2) * kstep;
            const char* a3 = a2 + kstep; const char* b3 = b2 + kstep;
            PG8_LDB(B0, 0, 0); PG8_LDB(B1, 0, 1); PG8_SCHED; PG8_LDA(At, 0, 0); PG8_STAGE(PG8_SA(1, 1), a1 + hstepA, voffA);
            PG8_WAIT_V(8); PG8_WAIT_L(0); PG8_BAR; PG8_MMA(0, 0, At, B0); PG8_MMA(0, 1, At, B1); PG8_BAR; PG8_SCHED;
            PG8_LDA(At, 0, 1); PG8_STAGE(PG8_SB(0, 0), b2, voffB); PG8_STAGE(PG8_SB(0, 1), b2 + hstepB, voffB); PG8_STAGE(PG8_SA(0, 0), a2, voffA);
            PG8_WAIT_V(8); PG8_WAIT_L(0); PG8_BAR; PG8_MMA(1, 0, At, B0); PG8_MMA(1, 1, At, B1); PG8_BAR; PG8_SCHED;
            PG8_LDB(B0, 1, 0); PG8_LDB(B1, 1, 1); PG8_SCHED; PG8_LDA(At, 1, 0); PG8_STAGE(PG8_SA(0, 1), a2 + hstepA, voffA);
            PG8_WAIT_V(8); PG8_WAIT_L(0); PG8_BAR; PG8_MMA(0, 0, At, B0); PG8_MMA(0, 1, At, B1); PG8_BAR; PG8_SCHED;
            PG8_LDA(At, 1, 1); PG8_STAGE(PG8_SB(1, 0), b3, voffB); PG8_STAGE(PG8_SB(1, 1), b3 + hstepB, voffB); PG8_STAGE(PG8_SA(1, 0), a3, voffA);
            PG8_WAIT_V(8); PG8_WAIT_L(0); PG8_BAR; PG8_MMA(1, 0, At, B0); PG8_MMA(1, 1, At, B1); PG8_BAR; PG8_SCHED;
        }
        if constexpr (ALIGN_EPI) { if (wr == 0) PG8_BAR; }
        if constexpr (F8) asm volatile("s_nop 15\n\ts_nop 15" ::: "memory");
        if constexpr (Sched::HAS_TAIL) { if (cur.ks < 0) E(acc, cur, wr, wc, fr, fq); else tail_store<Epi::PERM>(acc, cur, wr, wc, fr, fq, E.slab, S.nN * BM); }
        else E(acc, cur, wr, wc, fr, fq);
        if (!has_next) break;
#pragma unroll
        for (int a = 0; a < 2; ++a)
#pragma unroll
            for (int b = 0; b < 2; ++b)
#pragma unroll
                for (int m = 0; m < 4; ++m)
#pragma unroll
                    for (int n = 0; n < 2; ++n) acc[a][b][m][n] = (f32x4){0.f, 0.f, 0.f, 0.f};
        cur = nxt; cA = nA; cB = nB; ++ui; nt = S.nt(cur);
        if constexpr (ALIGN_EPI) { if (wr == 1) PG8_BAR; }
    }
    PG8_WAIT_V(0);
    if constexpr (!ALIGN_EPI) { if (wr == 0) PG8_BAR; }
    PG8_BAR;
#undef PG8_SA
#undef PG8_SB
#undef PG8_STAGE
#undef PG8_LDA
#undef PG8_LDB
#undef PG8_MMA
#undef PG8_F8FRAG
#undef PG8_WAIT_V
#undef PG8_WAIT_L
#undef PG8_BAR
#undef PG8_SCHED
}

__device__ __forceinline__ float quad_sum(float s) { s += __shfl_xor(s, 16); s += __shfl_xor(s, 32); return s; }

#define EPI_ROW(ai, m) (u.pm * BM + (ai) * HALF + wr * 64 + (m) * 16 + fr)
#define EPI_FOR8(ai, m) _Pragma("unroll") for (int ai = 0; ai < 2; ++ai) _Pragma("unroll") for (int m = 0; m < 4; ++m)
__device__ __forceinline__ float rms_scale(const ssq_t* ssq, int row, float inv_n) { return __builtin_amdgcn_rsqf(ssq_get(ssq, row) * inv_n + EPS); }

struct EpiG1 {
    static constexpr bool PERM = true, MIDSCALE = false;
    bf16_t* proj; bf16_t* kpe; const ssq_t* ssq_h; ssq_t* ssq_cq; ssq_t* ssq_ckv; const float* cosb; const float* sinb; float* slab; float* psq;
    __device__ __forceinline__ void operator()(const f32x4 (&acc)[2][2][4][2], const Unit& u, int wr, int wc, int fr, int fq) const {
        float rr[2][4];
        EPI_FOR8(ai, m) rr[ai][m] = rms_scale(ssq_h, EPI_ROW(ai, m), 1.0f / DM);
        if (u.pn == 3) {
            if (wc < 2) {
                f32x2 cs[2][2], nx[2][2];
#define G1_CS(dst, ai, m) do { const int pos_ = row_pos(EPI_ROW(ai, m)); _Pragma("unroll") for (int n = 0; n < 2; ++n) { const int i0_ = 16 * wc + 4 * fq + 2 * n; \
                    dst[n][0] = *(const f32x2*)(cosb + pos_ * 32 + i0_); dst[n][1] = *(const f32x2*)(sinb + pos_ * 32 + i0_); } } while (0)
                G1_CS(cs, 0, 0);
                EPI_FOR8(ai, m) {
                    const int row = EPI_ROW(ai, m), k = ai * 4 + m; const float r = rr[ai][m];
                    if (k < 7) G1_CS(nx, (k + 1) >> 2, (k + 1) & 3);
                    f32x4 o[2];
#pragma unroll
                    for (int n = 0; n < 2; ++n) { const f32x4 v = acc[ai][0][m][n] * r; const f32x2 c = cs[n][0], s = cs[n][1];
                        o[n] = (f32x4){v[0] * c.x - v[1] * s.x, v[0] * s.x + v[1] * c.x, v[2] * c.y - v[3] * s.y, v[2] * s.y + v[3] * c.y}; }
                    u32x4 w; w.x = cvt_pk_bf16(o[0][0], o[0][1]); w.y = cvt_pk_bf16(o[0][2], o[0][3]); w.z = cvt_pk_bf16(o[1][0], o[1][1]); w.w = cvt_pk_bf16(o[1][2], o[1][3]);
                    *(u32x4*)(kpe + (size_t)row * 64 + 32 * wc + 8 * fq) = w;
#pragma unroll
                    for (int n = 0; n < 2; ++n) { cs[n][0] = nx[n][0]; cs[n][1] = nx[n][1]; }
                }
#undef G1_CS
            }
        } else {
            EPI_FOR8(ai, m) {
                const int row = EPI_ROW(ai, m); const float r = rr[ai][m];
                float ss = 0.f;
#pragma unroll
                for (int bj = 0; bj < 2; ++bj) { const f32x4 v0 = acc[ai][bj][m][0] * r, v1 = acc[ai][bj][m][1] * r;
                    ss += (v0[0] * v0[0] + v0[1] * v0[1]) + (v0[2] * v0[2] + v0[3] * v0[3]) + (v1[0] * v1[0] + v1[1] * v1[1]) + (v1[2] * v1[2] + v1[3] * v1[3]);
                    u32x4 w; w.x = cvt_pk_bf16(v0[0], v0[1]); w.y = cvt_pk_bf16(v0[2], v0[3]); w.z = cvt_pk_bf16(v1[0], v1[1]); w.w = cvt_pk_bf16(v1[2], v1[3]);
                    *(u32x4*)(proj + (size_t)row * PROJW + u.pn * BM + bj * HALF + wc * 32 + 8 * fq) = w; }
                if (u.pn < 3) { ss = quad_sum(ss); if (fq == 0) psq[(size_t)row * 12 + u.pn * 4 + wc] = ss; }
            }
        }
    }
};
struct EpiQ {
    static constexpr bool PERM = true, MIDSCALE = false;
    bf16_t* qb; const ssq_t* ssq_cq; const float* cosb; const float* sinb;
    __device__ __forceinline__ void operator()(const f32x4 (&acc)[2][2][4][2], const Unit& u, int wr, int wc, int fr, int fq) const {
        float rr[2][4];
        EPI_FOR8(ai, m) rr[ai][m] = CQ * rms_scale(ssq_cq, EPI_ROW(ai, m), 1.0f / QL);
        const int st0 = u.pn * 8 + wc, st1 = st0 + 4, sm0 = st0 % 6, sm1 = st1 % 6;
        const bool rope = sm0 >= 4 || sm1 >= 4; const int rsm = (sm0 >= 4 ? sm0 : sm1) - 4;
        f32x2 cs[2][2] = {}, nx[2][2] = {};
#define Q_CS(dst, ai, m) do { const int pos_ = row_pos(EPI_ROW(ai, m)); _Pragma("unroll") for (int n = 0; n < 2; ++n) { const int i0_ = 16 * rsm + 4 * fq + 2 * n; \
            dst[n][0] = *(const f32x2*)(cosb + pos_ * 32 + i0_); dst[n][1] = *(const f32x2*)(sinb + pos_ * 32 + i0_); } } while (0)
        if (rope) Q_CS(cs, 0, 0);
        EPI_FOR8(ai, m) {
            const int row = EPI_ROW(ai, m), k = ai * 4 + m; const float r = rr[ai][m];
            if (rope && k < 7) Q_CS(nx, (k + 1) >> 2, (k + 1) & 3);
#pragma unroll
            for (int bj = 0; bj < 2; ++bj) {
                const int strip = bj ? st1 : st0, sm = bj ? sm1 : sm0;
                f32x4 v[2] = {acc[ai][bj][m][0] * r, acc[ai][bj][m][1] * r};
                if (sm >= 4) {
#pragma unroll
                    for (int n = 0; n < 2; ++n) { const f32x2 c = cs[n][0], s = cs[n][1]; const f32x4 x = v[n];
                        v[n] = (f32x4){x[0] * c.x - x[1] * s.x, x[0] * s.x + x[1] * c.x, x[2] * c.y - x[3] * s.y, x[2] * s.y + x[3] * c.y}; }
                }
                u32x4 w; w.x = cvt_pk_bf16(v[0][0], v[0][1]); w.y = cvt_pk_bf16(v[0][2], v[0][3]); w.z = cvt_pk_bf16(v[1][0], v[1][1]); w.w = cvt_pk_bf16(v[1][2], v[1][3]);
                *(u32x4*)(qb + (size_t)row * 1536 + strip * 32 + 8 * fq) = w;
            }
#pragma unroll
            for (int n = 0; n < 2; ++n) { cs[n][0] = nx[n][0]; cs[n][1] = nx[n][1]; }
        }
#undef Q_CS
    }
};
struct EpiScaleBf16 {
    static constexpr bool PERM = true, MIDSCALE = false;
    bf16_t* out; int ldo; const ssq_t* ssq; float inv_n;
    __device__ __forceinline__ void operator()(const f32x4 (&acc)[2][2][4][2], const Unit& u, int wr, int wc, int fr, int fq) const {
        float rr[2][4];
        EPI_FOR8(ai, m) rr[ai][m] = rms_scale(ssq, EPI_ROW(ai, m), inv_n);
        EPI_FOR8(ai, m) {
            const int row = EPI_ROW(ai, m); const float r = rr[ai][m];
#pragma unroll
            for (int bj = 0; bj < 2; ++bj) { const f32x4 v0 = acc[ai][bj][m][0] * r, v1 = acc[ai][bj][m][1] * r;
                u32x4 w; w.x = cvt_pk_bf16(v0[0], v0[1]); w.y = cvt_pk_bf16(v0[2], v0[3]); w.z = cvt_pk_bf16(v1[0], v1[1]); w.w = cvt_pk_bf16(v1[2], v1[3]);
                *(u32x4*)(out + (size_t)row * ldo + u.pn * BM + bj * HALF + wc * 32 + 8 * fq) = w; }
        }
    }
};
struct EpiGlu {
    static constexpr bool PERM = true, MIDSCALE = false;
    const bf16_t* gb; bf16_t* mix; float* psq_ssm;
    __device__ __forceinline__ void operator()(const f32x4 (&acc)[2][2][4][2], const Unit& u, int wr, int wc, int fr, int fq) const {
        constexpr float ZS = 1.0f / (F8_GS * F8_WGL);
        u32x4 gq[3][2];
#define GLU_LD(dst, ai, m) do { _Pragma("unroll") for (int bj = 0; bj < 2; ++bj) dst[bj] = *(const u32x4*)(gb + (size_t)EPI_ROW(ai, m) * SSMW + u.pn * BM + bj * HALF + wc * 32 + 8 * fq); } while (0)
        GLU_LD(gq[0], 0, 0); GLU_LD(gq[1], 0, 1);
        EPI_FOR8(ai, m) {
            const int row = EPI_ROW(ai, m), k = ai * 4 + m;
            if (k < 6) GLU_LD(gq[(k + 2) % 3], (k + 2) >> 2, (k + 2) & 3);
            float ss = 0.f;
#pragma unroll
            for (int bj = 0; bj < 2; ++bj) { const int col = u.pn * BM + bj * HALF + wc * 32 + 8 * fq;
                const u32x4 gv = gq[k % 3][bj]; const f32x4 z0 = acc[ai][bj][m][0] * ZS, z1 = acc[ai][bj][m][1] * ZS;
                u32x4 w; w.x = cvt_pk_bf16(bflo(gv.x) * sigmoidf_(z0[0]), bfhi(gv.x) * sigmoidf_(z0[1])); w.y = cvt_pk_bf16(bflo(gv.y) * sigmoidf_(z0[2]), bfhi(gv.y) * sigmoidf_(z0[3]));
                w.z = cvt_pk_bf16(bflo(gv.z) * sigmoidf_(z1[0]), bfhi(gv.z) * sigmoidf_(z1[1])); w.w = cvt_pk_bf16(bflo(gv.w) * sigmoidf_(z1[2]), bfhi(gv.w) * sigmoidf_(z1[3]));
                *(u32x4*)(mix + (size_t)row * 2048 + ATTW + col) = w;
                ss += (bflo(w.x) * bflo(w.x) + bfhi(w.x) * bfhi(w.x)) + (bflo(w.y) * bflo(w.y) + bfhi(w.y) * bfhi(w.y)) + (bflo(w.z) * bflo(w.z) + bfhi(w.z) * bfhi(w.z)) + (bflo(w.w) * bflo(w.w) + bfhi(w.w) * bfhi(w.w)); }
            ss = quad_sum(ss); if (fq == 0) psq_ssm[(size_t)row * 16 + u.pn * 4 + wc] = ss;
        }
#undef GLU_LD
    }
};
template <bool F8OUT, bool MIDS = false> struct EpiRes {
    static constexpr bool PERM = true, MIDSCALE = MIDS;
    float* h; bf16_t* hb; ssq_t* ssq; float* slab; float sc; const float* scl;
    const float* hin;
    float* psq;
    const float* psq_in; int nr;
    template <class Sched>
    __device__ __forceinline__ void prep(const Sched& S, int tid) const {
        float* sclw = const_cast<float*>(scl);
        for (int i = 0; ; ++i) { Unit u; if (!S.next(i, u)) break;
            const int row = u.pm * 256 + tid;
            if (tid < 256 && row < nr) {
                const f32x4 a0 = *(const f32x4*)(psq_in + (size_t)row * 8), a1 = *(const f32x4*)(psq_in + (size_t)row * 8 + 4);
                const float* ps = psq_in + (size_t)MP * 8 + (size_t)row * 16;
                const f32x4 s0 = *(const f32x4*)ps, s1 = *(const f32x4*)(ps + 4), s2 = *(const f32x4*)(ps + 8), s3 = *(const f32x4*)(ps + 12);
                const f32x4 sa = a0 + a1, sv = (s0 + s1) + (s2 + s3);
                const float ra = 1.0f / sqrtf(((sa[0] + sa[1]) + (sa[2] + sa[3])) * (1.0f / ATTW) + EPS), rs = 1.0f / sqrtf(((sv[0] + sv[1]) + (sv[2] + sv[3])) * (1.0f / SSMW) + EPS);
                sclw[row] = ra / rs; sclw[MP + row] = rs; } }
        VM_WAIT(); __syncthreads();
    }
    __device__ __forceinline__ void midscale(f32x4 (&acc)[2][2][4][2], const Unit& u, int wr, int fr) const {
        float f[2][4];
        EPI_FOR8(ai, m) f[ai][m] = scl[EPI_ROW(ai, m)];
        EPI_FOR8(ai, m) {
#pragma unroll
            for (int bj = 0; bj < 2; ++bj)
#pragma unroll
                for (int n = 0; n < 2; ++n) acc[ai][bj][m][n] *= f[ai][m]; }
    }
    __device__ __forceinline__ void operator()(const f32x4 (&acc)[2][2][4][2], const Unit& u, int wr, int wc, int fr, int fq) const {
        float fs[2][4];
        EPI_FOR8(ai, m) fs[ai][m] = MIDS ? scl[MP + EPI_ROW(ai, m)] * sc : sc;
        f32x4 hq[3][2][2];
#define RES_OFF(ai, m, bj, n) ((size_t)EPI_ROW(ai, m) * DM + u.pn * BM + (bj) * HALF + wc * 32 + 8 * fq + 4 * (n))
#define RES_LD(dst, ai, m) do { _Pragma("unroll") for (int bj = 0; bj < 2; ++bj) _Pragma("unroll") for (int n = 0; n < 2; ++n) dst[bj][n] = *(const f32x4*)(hin + RES_OFF(ai, m, bj, n)); } while (0)
        RES_LD(hq[0], 0, 0); RES_LD(hq[1], 0, 1);
        EPI_FOR8(ai, m) {
            const int row = EPI_ROW(ai, m), k = ai * 4 + m;
            if (k < 6) RES_LD(hq[(k + 2) % 3], (k + 2) >> 2, (k + 2) & 3);
            const bool real = row < MREAL; float ss = 0.f;
#pragma unroll
            for (int bj = 0; bj < 2; ++bj) { const size_t off = RES_OFF(ai, m, bj, 0); f32x4 v[2];
#pragma unroll
                for (int n = 0; n < 2; ++n) { v[n] = hq[k % 3][bj][n] + acc[ai][bj][m][n] * fs[ai][m]; if (!real) v[n] = (f32x4){0.f, 0.f, 0.f, 0.f};
                    *(f32x4*)(h + off + 4 * n) = v[n]; ss += (v[n][0] * v[n][0] + v[n][1] * v[n][1]) + (v[n][2] * v[n][2] + v[n][3] * v[n][3]); }
                if constexpr (F8OUT) { if (hb) { u32x2 w; w.x = pk4_fp8(v[0][0] * F8_HS, v[0][1] * F8_HS, v[0][2] * F8_HS, v[0][3] * F8_HS); w.y = pk4_fp8(v[1][0] * F8_HS, v[1][1] * F8_HS, v[1][2] * F8_HS, v[1][3] * F8_HS);
                    *(u32x2*)((unsigned char*)hb + off) = w; } }
                else { u32x4 w; w.x = cvt_pk_bf16(v[0][0], v[0][1]); w.y = cvt_pk_bf16(v[0][2], v[0][3]); w.z = cvt_pk_bf16(v[1][0], v[1][1]); w.w = cvt_pk_bf16(v[1][2], v[1][3]); *(u32x4*)(hb + off) = w; } }
            if (!F8OUT || hb) { ss = quad_sum(ss); if (fq == 0) psq[(size_t)row * 32 + u.pn * 4 + wc] = ss; }
        }
#undef RES_LD
#undef RES_OFF
    }
};
template <bool F8OUT> struct EpiGU {
    static constexpr bool PERM = true, MIDSCALE = false;
    bf16_t* act; int ldo; const float* rs;
    __device__ __forceinline__ void operator()(const f32x4 (&acc)[2][2][4][2], const Unit& u, int wr, int wc, int fr, int fq) const {
        float rr[2][4];
        EPI_FOR8(ai, m) rr[ai][m] = rs[u.roff + EPI_ROW(ai, m)];
        EPI_FOR8(ai, m) {
            const int row = EPI_ROW(ai, m);
            const float r = rr[ai][m], rl = r * -1.4426950408889634f, c2 = r * r * (F8OUT ? F8_AS : 1.0f);
            float o[8];
#pragma unroll
            for (int n = 0; n < 2; ++n)
#pragma unroll
                for (int j = 0; j < 4; ++j) { const float ag = acc[ai][0][m][n][j], au = acc[ai][1][m][n][j]; o[4 * n + j] = (ag * au) * (fast_rcp(1.0f + fast_exp2(ag * rl)) * c2); }
            if constexpr (F8OUT) { u32x2 w; w.x = pk4_fp8(o[0], o[1], o[2], o[3]); w.y = pk4_fp8(o[4], o[5], o[6], o[7]);
                *(u32x2*)((unsigned char*)act + (size_t)row * ldo + u.pn * HALF + wc * 32 + 8 * fq) = w; }
            else { u32x4 w; w.x = cvt_pk_bf16(o[0], o[1]); w.y = cvt_pk_bf16(o[2], o[3]); w.z = cvt_pk_bf16(o[4], o[5]); w.w = cvt_pk_bf16(o[6], o[7]);
                *(u32x4*)(act + (size_t)row * ldo + u.pn * HALF + wc * 32 + 8 * fq) = w; }
        }
    }
};
struct EpiMD {
    static constexpr bool PERM = true, MIDSCALE = false;
    bf16_t* y; const float* gperm;
    __device__ __forceinline__ void operator()(const f32x4 (&acc)[2][2][4][2], const Unit& u, int wr, int wc, int fr, int fq) const {
        float rr[2][4];
        EPI_FOR8(ai, m) rr[ai][m] = gperm[u.roff + EPI_ROW(ai, m)] * (1.0f / (F8_AS * F8_WDN));
        EPI_FOR8(ai, m) {
            const int row = EPI_ROW(ai, m); const float gt = rr[ai][m];
#pragma unroll
            for (int bj = 0; bj < 2; ++bj) { const f32x4 v0 = acc[ai][bj][m][0] * gt, v1 = acc[ai][bj][m][1] * gt;
                u32x4 w; w.x = cvt_pk_bf16(v0[0], v0[1]); w.y = cvt_pk_bf16(v0[2], v0[3]); w.z = cvt_pk_bf16(v1[0], v1[1]); w.w = cvt_pk_bf16(v1[2], v1[3]);
                *(u32x4*)(y + (size_t)row * DM + u.pn * BM + bj * HALF + wc * 32 + 8 * fq) = w; }
        }
    }
};
#undef EPI_ROW
#undef EPI_FOR8
}

#define XB_TMO      128
#define XB_XCNT(j)  (256  + 64 * (j))
#define XB_XSUB(j)  (1280 + 64 * (j))
#define XB_XGEN(j)  (2304 + 64 * (j))
#define XB_TOP      3328
#define XB_TOPGEN   3392
#define XCD_BAR_WORDS 3456
#define XB_SPIN_CAP (1u << 18)
__device__ __forceinline__ unsigned xb_ld(unsigned* p)              { return __hip_atomic_load(p, __ATOMIC_RELAXED, __HIP_MEMORY_SCOPE_AGENT); }
__device__ __forceinline__ unsigned xb_add(unsigned* p, unsigned v) { return __hip_atomic_fetch_add(p, v, __ATOMIC_RELAXED, __HIP_MEMORY_SCOPE_AGENT); }
__device__ __forceinline__ unsigned xb_xcc_id() { return (unsigned)__builtin_amdgcn_s_getreg((3 << 11) | 20) & 0xFu; }
#define XB_SPIN(cond, bar) do { unsigned _sp = 0; while (cond) { __builtin_amdgcn_s_sleep(1); \
    if ((++_sp & 255u) == 0u) { if (xb_ld(&(bar)[XB_TMO])) break; if (_sp > XB_SPIN_CAP) { atomicAdd(&(bar)[XB_TMO], 1u); break; } } } } while (0)
struct XcdBarrier { unsigned* bar; unsigned x; volatile LAS unsigned* st; };
__device__ __forceinline__ XcdBarrier xcd_barrier_post(unsigned* bar, volatile LAS unsigned* st) {
    XcdBarrier b; b.bar = bar; b.x = xb_xcc_id(); b.st = st;
    if (threadIdx.x == 0) (void)xb_add(&bar[XB_XCNT(b.x)], 1u);
    return b;
}
__device__ __forceinline__ void xcd_barrier_complete(unsigned* bar, unsigned x, unsigned& nloc, unsigned& nx) {
    const unsigned G = gridDim.x * gridDim.y * gridDim.z;
    unsigned sum, cnt, mine, sp = 0u;
    for (;;) {
        sum = 0u; cnt = 0u; mine = 0u;
#pragma unroll
        for (unsigned j = 0; j < 16; ++j) { const unsigned c = xb_ld(&bar[XB_XCNT(j)]); sum += c; cnt += (c > 0u) ? 1u : 0u; mine = (j == x) ? c : mine; }
        if (sum == G) break;
        __builtin_amdgcn_s_sleep(1);
        if ((++sp & 255u) == 0u) { if (xb_ld(&bar[XB_TMO])) break; if (sp > XB_SPIN_CAP) { atomicAdd(&bar[XB_TMO], 1u); break; } }
    }
    nloc = mine > 0u ? mine : 1u; nx = cnt > 0u ? cnt : 1u;
}
__device__ __forceinline__ void xcd_barrier(const XcdBarrier& b) {
    asm volatile("s_waitcnt vmcnt(0)" ::: "memory");
    __syncthreads();
    if (threadIdx.x == 0) {
        unsigned* bar = b.bar;
        __builtin_amdgcn_s_waitcnt(0);
        unsigned nloc = b.st[0], nx = b.st[1];
        if (nloc == 0u) { xcd_barrier_complete(bar, b.x, nloc, nx); b.st[0] = nloc; b.st[1] = nx; }
        const unsigned old = xb_add(&bar[XB_XSUB(b.x)], 1u);
        const unsigned gen = old / nloc, target = (gen + 1u) * nx;
        if (old + 1u == (gen + 1u) * nloc) {
            __builtin_amdgcn_fence(__ATOMIC_RELEASE, "agent");
            asm volatile("s_waitcnt vmcnt(0)" ::: "memory");
#pragma unroll
            for (unsigned j = 0; j < 16; ++j) (void)xb_add(&bar[XB_XGEN(j)], 1u);
            XB_SPIN(xb_ld(&bar[XB_XGEN(b.x)]) < target, bar);
            __builtin_amdgcn_fence(__ATOMIC_ACQUIRE, "agent");
            asm volatile("s_waitcnt vmcnt(0)" ::: "memory");
        } else {
            asm volatile("buffer_inv sc1" ::: "memory");
            XB_SPIN(xb_ld(&bar[XB_XGEN(b.x)]) < target, bar);
            asm volatile("s_waitcnt vmcnt(0)" ::: "memory");
        }
    }
    __syncthreads();
}

constexpr int RING_BYTES = 131072;
constexpr int LDS_BYTES = 155648;
constexpr int MISC_OFF = LDS_BYTES - 256;
constexpr int NWAVES = 8, NTHR = 512;

struct Inputs { const float* p[29]; };

template <class MAP>
__device__ __forceinline__ void transpose_item(const float* __restrict__ W, int K, int N, bf16_t* __restrict__ WT, const float* __restrict__ gA, int splitK, const float* __restrict__ gB,
                                               LAS float* scr, int item, int lane, const MAP& map) {
    const int nblk = N / 32, kb = item / nblk, nb = item - kb * nblk, k0 = 64 * kb, n0 = 32 * nb;
    float v[32];
#pragma unroll
    for (int i = 0; i < 32; ++i) { const int kk = 2 * i + (lane >> 5); v[i] = W[(size_t)(k0 + kk) * N + n0 + (lane & 31)]; }
#pragma unroll
    for (int i = 0; i < 32; ++i) { const int kk = 2 * i + (lane >> 5); scr[kk * 33 + (lane & 31)] = v[i]; }
    LDS_WAIT(); asm volatile("" ::: "memory");
    const int c = lane & 7;
    const float* gp = gA ? (k0 < splitK ? gA + k0 : gB + (k0 - splitK)) : nullptr;
    float g[8];
#pragma unroll
    for (int j = 0; j < 8; ++j) g[j] = gp ? gp[8 * c + j] : 1.0f;
#pragma unroll
    for (int j = 0; j < 4; ++j) { const int n = (lane >> 3) + 8 * j; const LAS float* s = scr + (8 * c) * 33 + n;
        u32x4 o; o.x = cvt_pk_bf16(s[0 * 33] * g[0], s[1 * 33] * g[1]); o.y = cvt_pk_bf16(s[2 * 33] * g[2], s[3 * 33] * g[3]); o.z = cvt_pk_bf16(s[4 * 33] * g[4], s[5 * 33] * g[5]); o.w = cvt_pk_bf16(s[6 * 33] * g[6], s[7 * 33] * g[7]);
        *(u32x4*)(WT + (size_t)map(n0 + n) * K + k0 + 8 * c) = o; }
    LDS_WAIT(); asm volatile("" ::: "memory");
}
template <class MAP>
__device__ __forceinline__ void transpose_item8(const float* __restrict__ W, int K, int N, unsigned char* __restrict__ WT, int pitch, const float* __restrict__ gA, float wscale,
                                                LAS float* scr, int item, int lane, const MAP& map) {
    const int nblk = N / 32, kb = item / nblk, nb = item - kb * nblk, k0 = 64 * kb, n0 = 32 * nb;
    float v[32];
#pragma unroll
    for (int i = 0; i < 32; ++i) { const int kk = 2 * i + (lane >> 5); v[i] = W[(size_t)(k0 + kk) * N + n0 + (lane & 31)]; }
#pragma unroll
    for (int i = 0; i < 32; ++i) { const int kk = 2 * i + (lane >> 5); scr[kk * 33 + (lane & 31)] = v[i]; }
    LDS_WAIT(); asm volatile("" ::: "memory");
    const int c = lane >> 4, nl = lane & 15;
    float g[16];
#pragma unroll
    for (int j = 0; j < 16; ++j) g[j] = (gA ? gA[k0 + 16 * c + j] : 1.0f) * wscale;
#pragma unroll
    for (int j2 = 0; j2 < 2; ++j2) { const int n = nl + 16 * j2; const LAS float* s = scr + (16 * c) * 33 + n;
        u32x4 o; o.x = pk4_fp8(s[0 * 33] * g[0], s[1 * 33] * g[1], s[2 * 33] * g[2], s[3 * 33] * g[3]); o.y = pk4_fp8(s[4 * 33] * g[4], s[5 * 33] * g[5], s[6 * 33] * g[6], s[7 * 33] * g[7]);
        o.z = pk4_fp8(s[8 * 33] * g[8], s[9 * 33] * g[9], s[10 * 33] * g[10], s[11 * 33] * g[11]); o.w = pk4_fp8(s[12 * 33] * g[12], s[13 * 33] * g[13], s[14 * 33] * g[14], s[15 * 33] * g[15]);
        *(u32x4*)(WT + (size_t)map(n0 + n) * pitch + k0 + 16 * c) = o; }
    LDS_WAIT(); asm volatile("" ::: "memory");
}
struct MapId { __device__ __forceinline__ int operator()(int n) const { return n; } };
struct MapWin {
    __device__ __forceinline__ int operator()(int n) const { if (n < 768) return n; if (n < 832) { const int i = n - 768; return 768 + (i < 32 ? 2 * i : 2 * (i - 32) + 1); } return 1024 + (n - 832); } };
struct MapWuq {
    __device__ __forceinline__ int operator()(int n) const { const int hd = n / DQK, d = n - hd * DQK; if (d < DNOPE) return n; const int i = d - DNOPE; return hd * DQK + DNOPE + (i < 32 ? 2 * i : 2 * (i - 32) + 1); } };
struct MapGU {
    int sel; __device__ __forceinline__ int operator()(int n) const { return 256 * (n >> 7) + 128 * sel + (n & 127); } };

template <class MAP>
__device__ __forceinline__ void transpose_matrix(const float* W, int K, int N, bf16_t* WT, const float* gA, int splitK, const float* gB, LAS float* scr, int lane, int gw, int ngw, int& base, const MAP& map) {
    const int nit = (K / 64) * (N / 32);
    int first = gw - (base % ngw); if (first < 0) first += ngw;
    for (int it = first; it < nit; it += ngw) transpose_item(W, K, N, WT, gA, splitK, gB, scr, it, lane, map);
    base += nit;
}

template <class MAP>
__device__ __forceinline__ void transpose_matrix8(const float* W, int K, int N, unsigned char* WT, const float* gA, float wscale, LAS float* scr, int lane, int gw, int ngw, int& base, const MAP& map, int pitch = 0) {
    const int nit = (K / 64) * (N / 32); if (pitch == 0) pitch = K;
    int first = gw - (base % ngw); if (first < 0) first += ngw;
    for (int it = first; it < nit; it += ngw) transpose_item8(W, K, N, WT, pitch, gA, wscale, scr, it, lane, map);
    base += nit;
}

struct PendItem { float v[32]; f32x4 g[4]; unsigned char* dst; int rstride; int fmt; };
__device__ __forceinline__ void st16_wt(void* p, u32x4 v) { asm volatile("global_store_dwordx4 %0, %1, off sc1\n\ts_nop 1" :: "v"(p), "v"(v) : "memory"); }
__device__ __forceinline__ void item_finish(const PendItem& p, LAS float* scr, int lane) {
#pragma unroll
    for (int i = 0; i < 32; ++i) { const int kk = 2 * i + (lane >> 5); scr[kk * 33 + (lane & 31)] = p.v[i]; }
    LDS_WAIT(); asm volatile("" ::: "memory");
    if (p.fmt == 1) {
        const int c = lane & 7; const float g[8] = {p.g[0][0], p.g[0][1], p.g[0][2], p.g[0][3], p.g[1][0], p.g[1][1], p.g[1][2], p.g[1][3]};
#pragma unroll
        for (int j = 0; j < 4; ++j) { const int n = (lane >> 3) + 8 * j; const LAS float* s = scr + (8 * c) * 33 + n;
            u32x4 o; o.x = cvt_pk_bf16(s[0 * 33] * g[0], s[1 * 33] * g[1]); o.y = cvt_pk_bf16(s[2 * 33] * g[2], s[3 * 33] * g[3]); o.z = cvt_pk_bf16(s[4 * 33] * g[4], s[5 * 33] * g[5]); o.w = cvt_pk_bf16(s[6 * 33] * g[6], s[7 * 33] * g[7]);
            st16_wt(p.dst + (size_t)n * p.rstride + 16 * c, o); }
    } else {
        const int c = lane >> 4, nl = lane & 15; float g[16];
#pragma unroll
        for (int j = 0; j < 16; ++j) g[j] = p.g[j >> 2][j & 3];
#pragma unroll
        for (int j2 = 0; j2 < 2; ++j2) { const int n = nl + 16 * j2; const LAS float* s = scr + (16 * c) * 33 + n;
            u32x4 o; o.x = pk4_fp8(s[0 * 33] * g[0], s[1 * 33] * g[1], s[2 * 33] * g[2], s[3 * 33] * g[3]); o.y = pk4_fp8(s[4 * 33] * g[4], s[5 * 33] * g[5], s[6 * 33] * g[6], s[7 * 33] * g[7]);
            o.z = pk4_fp8(s[8 * 33] * g[8], s[9 * 33] * g[9], s[10 * 33] * g[10], s[11 * 33] * g[11]); o.w = pk4_fp8(s[12 * 33] * g[12], s[13 * 33] * g[13], s[14 * 33] * g[14], s[15 * 33] * g[15]);
            st16_wt(p.dst + (size_t)n * p.rstride + 16 * c, o); }
    }
    LDS_WAIT(); asm volatile("" ::: "memory");
}
template <class MAP>
__device__ __forceinline__ void convert_matrix(PendItem& pend, const float* W, int K, int N, unsigned char* WT, int pitchB, int fmt, const float* gA, int splitK, const float* gB, float wscale,
                                               LAS float* scr, int lane, int gw, int ngw, int& base, const MAP& map) {
    const int nblk = N / 32, nit = (K / 64) * nblk, esize = fmt == 1 ? 2 : 1;
    int first = gw - (base % ngw); if (first < 0) first += ngw;
    for (int it = first; it < nit; it += ngw) {
        const int kb = it / nblk, nb = it - kb * nblk, k0 = 64 * kb, n0 = 32 * nb;
        float nv[32];
#pragma unroll
        for (int i = 0; i < 32; ++i) { const int kk = 2 * i + (lane >> 5); nv[i] = W[(size_t)(k0 + kk) * N + n0 + (lane & 31)]; }
        if (pend.fmt) item_finish(pend, scr, lane);
#pragma unroll
        for (int i = 0; i < 32; ++i) pend.v[i] = nv[i];
        const int r0 = map(n0);
        pend.dst = WT + (size_t)r0 * pitchB + (size_t)k0 * esize; pend.rstride = (map(n0 + 1) - r0) * pitchB;
        const float* gq = gA ? (k0 < splitK ? gA + k0 : gB + (k0 - splitK)) : W; const int goff = fmt == 1 ? 8 * (lane & 7) : 16 * (lane >> 4);
        f32x4 gv[4]; gv[0] = *(const f32x4*)(gq + goff); gv[1] = *(const f32x4*)(gq + goff + 4);
        if (fmt == 2) { gv[2] = *(const f32x4*)(gq + goff + 8); gv[3] = *(const f32x4*)(gq + goff + 12); } else { gv[2] = gv[0]; gv[3] = gv[1]; }
#pragma unroll
        for (int j = 0; j < 4; ++j) pend.g[j] = gA ? gv[j] * wscale : (f32x4){wscale, wscale, wscale, wscale};
        pend.fmt = fmt;
    }
    base += nit;
}

constexpr int IT_DENSE_M = (DM / 64) * (DFF / 32), IT_DENSE = 3 * IT_DENSE_M;
constexpr int IT_EXP_M = (DM / 64) * (DFE / 32), IT_EXP = 3 * IT_EXP_M, IT_MOE = NE * IT_EXP;
static_assert((DFF / 64) * (DM / 32) == IT_DENSE_M && (DFE / 64) * (DM / 32) == IT_EXP_M, "gate/up and down matrices have equal item counts");
#ifndef TAIL_BUDGET
#define TAIL_BUDGET 2
#endif
#ifndef GU_BUDGET
#define GU_BUDGET 10
#endif
#ifndef MDN_BUDGET
#define MDN_BUDGET 7
#endif
__device__ __forceinline__ int cap_mdn(int G) { return G == 256 ? (G - 64) * NWAVES * MDN_BUDGET : 0; }
#ifndef S5E_BUDGET
#define S5E_BUDGET 6
#endif
__device__ __forceinline__ int cap_s5e(int G) { return G == 256 ? 50 * NWAVES * S5E_BUDGET : 0; }
__device__ __forceinline__ int set_total(int set) { return set == 2 ? IT_DENSE : IT_MOE; }
__device__ __forceinline__ int cap_tail(int G, int ntail) { return (G > ntail ? G - ntail : 0) * NWAVES * TAIL_BUDGET; }
__device__ __forceinline__ int gu_short(int G) { const int rem = ((MP / 256) * (2 * DFF / 256)) % G; return rem ? G - rem : 0; }
__device__ __forceinline__ int cap_gu(int G) { return gu_short(G) * NWAVES * GU_BUDGET; }
__device__ __forceinline__ int slot_begin(int s, int G) { int o = 0; if (s > 0) o += cap_tail(G, 64); if (s > 1) o += cap_tail(G, 64); if (s == 3 || s == 5) o += cap_gu(G); if (s == 5) o += cap_tail(G, 88); return o; }
__device__ __forceinline__ int slot_cap(int s, int G) { return s < 2 ? cap_tail(G, 64) : (s == 2 ? cap_gu(G) : (s == 3 ? cap_tail(G, 88) : (s == 4 ? cap_mdn(G) : cap_s5e(G)))); }
__device__ __forceinline__ int set_deferred(int set, int G) { const int l = set - 1; int o = 2 * cap_tail(G, 64); if ((l & 1) == 0) o += cap_gu(G) + cap_tail(G, 88) + cap_s5e(G); else o += cap_mdn(G); const int t = set_total(set); return o < t ? o : t; }
struct FfnSrc { const float* fn; const float* dg; const float* du; const float* dd; const float* mg; const float* mu; const float* md; };
#define TO_GLOBAL(T, p) ((T)({ GAS void* _g = (GAS void*)(p); asm volatile("" : "+v"(_g)); _g; }))
__device__ __forceinline__ void ffn_convert_range(int set, int t0, int t1, int jw, int nw, const FfnSrc& src, unsigned char* ws, LAS float* scr, int lane) {
    PendItem pend; pend.fmt = 0; pend.dst = nullptr; pend.rstride = 0;
#pragma unroll
    for (int i = 0; i < 32; ++i) pend.v[i] = 0.f;
#pragma unroll
    for (int j = 0; j < 4; ++j) pend.g[j] = (f32x4){0.f, 0.f, 0.f, 0.f};
    for (int t = t0 + jw; t < t1; t += nw) {
        const float* W; const float* gn; unsigned char* WT; int K, N, pitch, sel, local; float wscale;
        if (set == 2) { const int m = t / IT_DENSE_M; local = t - m * IT_DENSE_M; unsigned char* wd = ws + WS_WFF + SZ_DENSE;
            if (m < 2) { W = (m ? src.du : src.dg) + (size_t)DM * DFF; K = DM; N = DFF; WT = wd; pitch = DM; gn = src.fn + 2 * DM; wscale = F8_WGU; sel = m; }
            else { W = src.dd + (size_t)DFF * DM; K = DFF; N = DM; WT = wd + SZ_DGU; pitch = DFF; gn = nullptr; wscale = F8_WDN; sel = -1; } }
        else { const int i = set == 1 ? 0 : 1, e = t / IT_EXP, r = t - e * IT_EXP, m = r / IT_EXP_M; local = r - m * IT_EXP_M;
            unsigned char* we = ws + WS_WFF + 2 * SZ_DENSE + (size_t)i * SZ_MOE + (size_t)e * SZ_EXP;
            if (m < 2) { W = (m ? src.mu : src.mg) + (size_t)(i * NE + e) * DM * DFE; K = DM; N = DFE; WT = we; pitch = DM; gn = src.fn + (2 * i + 1) * DM; wscale = F8_WGU; sel = m; }
            else { W = src.md + (size_t)(i * NE + e) * DFE * DM; K = DFE; N = DM; WT = we + SZ_EGU; pitch = DFEP; gn = nullptr; wscale = F8_WDN; sel = -1; } }
        (void)K;
        W = TO_GLOBAL(const float*, W);
        const int nblk = N / 32, kb = local / nblk, nb = local - kb * nblk, k0 = 64 * kb, n0 = 32 * nb;
        float nv[32];
#pragma unroll
        for (int i = 0; i < 32; ++i) { const int kk = 2 * i + (lane >> 5); nv[i] = W[(size_t)(k0 + kk) * N + n0 + (lane & 31)]; }
        if (pend.fmt) item_finish(pend, scr, lane);
#pragma unroll
        for (int i = 0; i < 32; ++i) pend.v[i] = nv[i];
        const int r0 = sel >= 0 ? 256 * (n0 >> 7) + 128 * sel + (n0 & 127) : n0;
        pend.dst = (unsigned char*)TO_GLOBAL(unsigned char*, WT + (size_t)r0 * pitch + k0); pend.rstride = pitch;
        const float* gq = TO_GLOBAL(const float*, gn ? gn + k0 : W); const int goff = 16 * (lane >> 4);
        f32x4 gv[4];
#pragma unroll
        for (int j = 0; j < 4; ++j) gv[j] = *(const f32x4*)(gq + goff + 4 * j);
#pragma unroll
        for (int j = 0; j < 4; ++j) pend.g[j] = gn ? gv[j] * wscale : (f32x4){wscale, wscale, wscale, wscale};
        pend.fmt = 2;
    }
    if (pend.fmt) item_finish(pend, scr, lane);
}

__device__ __forceinline__ void ffn_slot(int l, int s, int G, int c, int tid, const float* const* itab, unsigned char* ws, LAS unsigned char* lds) {
    if (l >= DEPTH - 1) return;
    asm volatile("" : "+s"(G), "+s"(l));
    const int set = l + 1, lane = tid & 63, wave = tid >> 6;
    int first_idle, nidle;
    if (s == 2) { nidle = gu_short(G); first_idle = G - nidle; } else { const int nt = s == 3 ? 88 : 64; first_idle = nt < G ? nt : G; nidle = G - first_idle; }
    if ((s == 4 || s == 5) && G != 256) return;
    if (s == 5) { if (l & 1) return; first_idle = 206; nidle = 50; }
    if (c < first_idle || nidle == 0) return;
    const int t0 = slot_begin(s, G), dl = set_deferred(set, G); int t1 = t0 + slot_cap(s, G); if (t1 > dl) t1 = dl;
    if (t0 >= t1) return;
    const FfnSrc src{itab[20], itab[21], itab[22], itab[23], itab[25], itab[26], itab[27]};
    ffn_convert_range(set, t0, t1, (c - first_idle) * NWAVES + wave, nidle * NWAVES, src, ws, (LAS float*)(lds + wave * 8704), lane);
}

__device__ __forceinline__ void prologue_phase(const Inputs& in_, unsigned char* ws, LAS unsigned char* lds, int tid, int G) {
    const int lane = tid & 63, wave = tid >> 6, gw = blockIdx.x * NWAVES + wave, ngw = G * NWAVES;
    LAS float* scr = (LAS float*)(lds + wave * 8704);
    Inputs in;
#pragma unroll
    for (int k = 0; k < 29; ++k) in.p[k] = (const float*)(GAS const void*)in_.p[k];
    ws = (unsigned char*)(GAS void*)ws;
    {
        float* h = (float*)(ws + WS_H); bf16_t* hb = (bf16_t*)(ws + WS_HB); ssq_t* ssq = (ssq_t*)(ws + CTL_SSQ) + (size_t)SSQ_H1(0) * MP;
        for (int row = gw; row < MP; row += ngw) {
            const float* src = row < MX ? in.p[0] + (size_t)row * DM : (row < MREAL ? in.p[1] + (size_t)((row - MX) & (NMETA - 1)) * DM : nullptr);
            float ss = 0.f;
#pragma unroll
            for (int jj = 0; jj < 4; ++jj) { const int c = 8 * lane + 512 * jj;
                const f32x4 v = src ? *(const f32x4*)(src + c) : (f32x4){0.f, 0.f, 0.f, 0.f}, v2 = src ? *(const f32x4*)(src + c + 4) : (f32x4){0.f, 0.f, 0.f, 0.f};
                if (row >= MX) { *(f32x4*)(h + (size_t)row * DM + c) = v; *(f32x4*)(h + (size_t)row * DM + c + 4) = v2; }
                u32x4 w; w.x = cvt_pk_bf16(v[0], v[1]); w.y = cvt_pk_bf16(v[2], v[3]); w.z = cvt_pk_bf16(v2[0], v2[1]); w.w = cvt_pk_bf16(v2[2], v2[3]); *(u32x4*)(hb + (size_t)row * DM + c) = w;
                ss += (v[0] * v[0] + v[1] * v[1]) + (v[2] * v[2] + v[3] * v[3]) + (v2[0] * v2[0] + v2[1] * v2[1]) + (v2[2] * v2[2] + v2[3] * v2[3]); }
            ss = wave_sum(ss); if (lane == 0) ssq[row] = ssq_fix(ss);
        }
    }
    { bf16_t* proj = (bf16_t*)(ws + WS_PROJ); bf16_t* kpe = (bf16_t*)(ws + WS_KPE);
      for (int row = MREAL + gw; row < MP; row += ngw) {
#pragma unroll
          for (int j = 0; j < 4; ++j) *(u32x4*)(proj + (size_t)row * PROJW + 512 * j + 8 * lane) = (u32x4){0u, 0u, 0u, 0u};
          if (lane < 8) *(u32x4*)(kpe + (size_t)row * 64 + 8 * lane) = (u32x4){0u, 0u, 0u, 0u}; } }
    {
        float* cosb = (float*)(ws + WS_ROPE); float* sinb = cosb + LTOK * 32;
        for (int i = gw * 64 + lane; i < LTOK * 32; i += ngw * 64) { const int t = i >> 5, k = i & 31;
            const float inv = powf(10000.0f, -(float)(2 * k) / 64.0f); const float ang = (float)t * inv; cosb[i] = cosf(ang); sinb[i] = sinf(ang); }
    }
    for (int i = gw * 64 + lane; i < DEPTH * 2 * NG * NS; i += ngw * 64) {
        const int p = i & 63, ldg = i >> 6;
        unsigned char* tb = ws + WS_S5 + (size_t)ldg * S5_STRIDE;
        const float lr = in.p[8][i], li = in.p[9][i], dt = expf(in.p[10][ldg]);
        const float mag = expf(lr * dt), ar = mag * cosf(li * dt), ai = mag * sinf(li * dt);
        ((f32x2*)(tb + S5_LAM))[p] = (f32x2){ar, ai};
        const float den = 1.0f / (lr * lr + li * li), xr = ar - 1.0f, xi = ai;
        const float fr_ = (xr * lr + xi * li) * den, fi_ = (xi * lr - xr * li) * den;
        const float* bre = in.p[11] + (size_t)i * GS; const float* bim = in.p[12] + (size_t)i * GS;
        bf16_t* ore = (bf16_t*)(tb + S5_BRE) + p * GS; bf16_t* oim = (bf16_t*)(tb + S5_BIM) + p * GS;
#pragma unroll
        for (int c = 0; c < GS; c += 2) { const float r0 = fr_ * bre[c] - fi_ * bim[c], i0 = fr_ * bim[c] + fi_ * bre[c], r1 = fr_ * bre[c + 1] - fi_ * bim[c + 1], i1 = fr_ * bim[c + 1] + fi_ * bre[c + 1];
            *(unsigned*)(ore + c) = cvt_pk_bf16(r0, r1); *(unsigned*)(oim + c) = cvt_pk_bf16(i0, i1); }
        const float* cre = in.p[13] + (size_t)ldg * GS * NS; const float* cim = in.p[14] + (size_t)ldg * GS * NS; bf16_t* ce = (bf16_t*)(tb + S5_CEF);
#pragma unroll
        for (int co = 0; co < GS; ++co) *(unsigned*)(ce + co * 128 + 2 * p) = cvt_pk_bf16(cre[co * NS + p], -cim[co * NS + p]);
    }
    int base = 0;
    PendItem pend; pend.fmt = 0; pend.dst = nullptr; pend.rstride = 0;
#pragma unroll
    for (int i = 0; i < 32; ++i) pend.v[i] = 0.f;
#pragma unroll
    for (int j = 0; j < 4; ++j) pend.g[j] = (f32x4){0.f, 0.f, 0.f, 0.f};
    for (int l = 0; l < DEPTH; ++l) {
        unsigned char* wl = ws + WS_W + (size_t)l * SZ_LAYER;
        convert_matrix(pend, in.p[3] + (size_t)l * DM * INC, DM, INC, wl + OFF_WIN, DM * 2, 1, in.p[2] + l * DM, 1 << 30, nullptr, 1.0f, scr, lane, gw, ngw, base, MapWin());
        convert_matrix(pend, in.p[5] + (size_t)l * QL * 1536, QL, 1536, wl + OFF_WUQ, QL * 2, 1, in.p[4] + l * QL, 1 << 30, nullptr, 1.0f, scr, lane, gw, ngw, base, MapWuq());
        convert_matrix(pend, in.p[7] + (size_t)l * KVL * 2048, KVL, 2048, wl + OFF_WUKV, KVL * 2, 1, in.p[6] + l * KVL, 1 << 30, nullptr, 1.0f, scr, lane, gw, ngw, base, MapId());
        convert_matrix(pend, in.p[16] + (size_t)l * SSMW * SSMW, SSMW, SSMW, wl + OFF_WGLU, SSMW, 2, nullptr, 0, nullptr, F8_WGL, scr, lane, gw, ngw, base, MapId());
        convert_matrix(pend, in.p[19] + (size_t)l * DM * DM, DM, DM, wl + OFF_WOUT, DM * 2, 1, in.p[17] + l * ATTW, ATTW, in.p[18] + l * SSMW, 1.0f, scr, lane, gw, ngw, base, MapId());
    }
    for (int i = 0; i < 1; ++i) {
        unsigned char* wd = ws + WS_WFF + (size_t)i * SZ_DENSE; const float* gn = in.p[20] + (size_t)(2 * i) * DM;
        convert_matrix(pend, in.p[21] + (size_t)i * DM * DFF, DM, DFF, wd, DM, 2, gn, 1 << 30, nullptr, F8_WGU, scr, lane, gw, ngw, base, MapGU{0});
        convert_matrix(pend, in.p[22] + (size_t)i * DM * DFF, DM, DFF, wd, DM, 2, gn, 1 << 30, nullptr, F8_WGU, scr, lane, gw, ngw, base, MapGU{1});
        convert_matrix(pend, in.p[23] + (size_t)i * DFF * DM, DFF, DM, wd + SZ_DGU, DFF, 2, nullptr, 0, nullptr, F8_WDN, scr, lane, gw, ngw, base, MapId());
    }
    if (pend.fmt) item_finish(pend, scr, lane);
    pend.fmt = 0;
    { FfnSrc src{in.p[20], in.p[21], in.p[22], in.p[23], in.p[25], in.p[26], in.p[27]};
      for (int set = 1; set <= 3; ++set) ffn_convert_range(set, set_deferred(set, G), set_total(set), gw, ngw, src, ws, scr, lane); }
    for (int i = 0; i < 2 * NE; ++i) { unsigned char* we = ws + WS_WFF + 2 * SZ_DENSE + (size_t)i * SZ_EXP;
        for (int r = gw; r < DM; r += ngw) if (lane < 8) *(u32x4*)(we + SZ_EGU + (size_t)r * DFEP + DFE + 16 * lane) = (u32x4){0u, 0u, 0u, 0u}; }
}

constexpr int S5_HROW = 304;
constexpr int S5_POFF = 2 * 2 * 32 * S5_HROW;
constexpr int S5_NCH = 66, S5_LP = S5_NCH * 32;
#define WG_BAR() do { LDS_WAIT(); __builtin_amdgcn_s_barrier(); asm volatile("" ::: "memory"); } while (0)
__device__ __forceinline__ void s5_phase(const unsigned char* ws_tab, const bf16_t* proj, unsigned char* g8, bf16_t* gb, const float* dskip, int l, LAS unsigned char* lds, int tid, int G) {
    const int lane = tid & 63, wid = __builtin_amdgcn_readfirstlane(tid >> 6);
    for (int unit0 = blockIdx.x; unit0 < NBATCH * NG; unit0 += G) {
        const int unit = (G == 256) ? ((unit0 & 7) << 5) | (unit0 >> 3) : unit0;
        const int b = unit >> 6, g = unit & 63;
        if (wid < 4) {
            const int d = wid >> 1, pt = wid & 1, pl = lane & 31, hh = lane >> 5, p = 32 * pt + pl;
            const unsigned char* tb = ws_tab + (size_t)((l * 2 + d) * NG + g) * S5_STRIDE;
            const f32x2 lam = ((const f32x2*)(tb + S5_LAM))[p];
            const bf16x8 Bre = *(const bf16x8*)(tb + S5_BRE + (p * GS + 8 * hh) * 2), Bim = *(const bf16x8*)(tb + S5_BIM + (p * GS + 8 * hh) * 2);
            float pr[4], pi[4]; pr[0] = lam.x; pi[0] = lam.y;
#pragma unroll
            for (int k = 1; k < 4; ++k) { pr[k] = pr[k - 1] * lam.x - pi[k - 1] * lam.y; pi[k] = pr[k - 1] * lam.y + pi[k - 1] * lam.x; }
            const float l4r = pr[3], l4i = pi[3], l8r = l4r * l4r - l4i * l4i, l8i = 2.f * l4r * l4i, l12r = l8r * l4r - l8i * l4i, l12i = l8r * l4i + l8i * l4r, l16r = l8r * l8r - l8i * l8i, l16i = 2.f * l8r * l8i;
            float Hr = 0.f, Hi = 0.f;
            const int arow = lane & 31, ipos = 16 * ((arow >> 2) & 1) + 4 * (arow & 3) + (arow >> 3), kh = lane >> 5;
            const bf16_t* ubase = proj + 1024 + GS * g + 8 * kh;
#define S5_UROW(it_) ({ const int tau_ = 32 * (it_) + ipos, t_ = d ? (S5_LP - 1 - tau_) : tau_; (size_t)tok_row(b, t_ < LTOK ? t_ : 0) * PROJW; })
#define S5_UOK(it_) ({ const int tau_ = 32 * (it_) + ipos, t_ = d ? (S5_LP - 1 - tau_) : tau_; t_ < LTOK; })
            bf16x8 aq[4];
#pragma unroll
            for (int k = 0; k < 4; ++k) aq[k] = *(const bf16x8*)(ubase + S5_UROW(k));
            for (int it0 = 0; it0 <= S5_NCH; it0 += 4) {
#pragma unroll
              for (int kq = 0; kq < 4; ++kq) { const int it = it0 + kq;
               if (it <= S5_NCH) {
                if (it < S5_NCH) {
                    const bf16x8 a = S5_UOK(it) ? aq[kq] : (bf16x8){0, 0, 0, 0, 0, 0, 0, 0};
                    f32x16 are = {}, aim = {};
                    are = __builtin_amdgcn_mfma_f32_32x32x16_bf16(a, Bre, are, 0, 0, 0);
                    aim = __builtin_amdgcn_mfma_f32_32x32x16_bf16(a, Bim, aim, 0, 0, 0);
                    aq[kq] = *(const bf16x8*)(ubase + S5_UROW(it + 4 < S5_NCH ? it + 4 : it));
#define CMA(or_, oi_, ar_, ai_, br_, bi_, cr_, ci_) do { or_ = fmaf(ar_, br_, fmaf(-(ai_), bi_, cr_)); oi_ = fmaf(ar_, bi_, fmaf(ai_, br_, ci_)); } while (0)
#define CMA2(or_, oi_, ar_, ai_, br_, bi_, cr_, ci_) do { const f32x2 _tr = (br_) * (ar_) + (cr_), _ti = (bi_) * (ar_) + (ci_); or_ = _tr - (bi_) * (ai_); oi_ = _ti + (br_) * (ai_); } while (0)
                    f32x2 XR[4][2], XI[4][2];
#pragma unroll
                    for (int j = 0; j < 4; ++j)
#pragma unroll
                        for (int q = 0; q < 2; ++q) { XR[j][q] = (f32x2){are[4 * j + 2 * q], are[4 * j + 2 * q + 1]}; XI[j][q] = (f32x2){aim[4 * j + 2 * q], aim[4 * j + 2 * q + 1]}; }
#pragma unroll
                    for (int j = 1; j < 4; ++j)
#pragma unroll
                        for (int q = 0; q < 2; ++q) { f32x2 nr, ni; CMA2(nr, ni, lam.x, lam.y, XR[j - 1][q], XI[j - 1][q], XR[j][q], XI[j][q]); XR[j][q] = nr; XI[j][q] = ni; }
                    const float e0r = XR[3][0].x, e0i = XI[3][0].x, e1r = XR[3][0].y, e1i = XI[3][0].y, e2r = XR[3][1].x, e2i = XI[3][1].x, e3r = XR[3][1].y, e3i = XI[3][1].y;
                    float er, ei, t1r, t1i; CMA(er, ei, l4r, l4i, e2r, e2i, e3r, e3i); CMA(t1r, t1i, l12r, l12i, e0r, e0i, er, ei); CMA(er, ei, l8r, l8i, e1r, e1i, t1r, t1i);
                    const float Eor = swap32(er, hh), Eoi = swap32(ei, hh);
                    float i0r = Hr, i0i = Hi; if (hh) CMA(i0r, i0i, l16r, l16i, Hr, Hi, Eor, Eoi);
                    float i1r, i1i, i2r, i2i, i3r, i3i; CMA(i1r, i1i, l4r, l4i, i0r, i0i, e0r, e0i); CMA(i2r, i2i, l4r, l4i, i1r, i1i, e1r, e1i); CMA(i3r, i3i, l4r, l4i, i2r, i2i, e2r, e2i);
                    const f32x2 INR[2] = {(f32x2){i0r, i1r}, (f32x2){i2r, i3r}}, INI[2] = {(f32x2){i0i, i1i}, (f32x2){i2i, i3i}};
                    LAS unsigned char* hrow = lds + (size_t)(((it & 1) * 2 + d) * 32 + 16 * hh) * S5_HROW + 4 * p;
                    if (pt == 0) *(LAS bf16x8*)(lds + (size_t)(((it & 1) * 2 + d) * 32 + ipos) * S5_HROW + 256 + 16 * kh) = a;
                    float cr = 0.f, ci = 0.f;
#pragma unroll
                    for (int j = 0; j < 4; ++j)
#pragma unroll
                        for (int q = 0; q < 2; ++q) { f32x2 hr2, hi2; CMA2(hr2, hi2, pr[j], pi[j], INR[q], INI[q], XR[j][q], XI[j][q]);
                            *(LAS unsigned*)(hrow + (4 * (2 * q) + j) * S5_HROW) = cvt_pk_bf16(hr2.x, hi2.x); *(LAS unsigned*)(hrow + (4 * (2 * q + 1) + j) * S5_HROW) = cvt_pk_bf16(hr2.y, hi2.y);
                            if (j == 3 && q == 1) { cr = hr2.y; ci = hi2.y; } }
#undef CMA
#undef CMA2
                    const float ocr = swap32(cr, hh), oci = swap32(ci, hh);
                    Hr = hh ? cr : ocr; Hi = hh ? ci : oci;
                }
                WG_BAR();
               }
              }
            }
        } else {
            const int cw = wid - 4, d = cw >> 1, tt = cw & 1, tk = lane & 15, q = lane >> 4;
            const unsigned char* tb = ws_tab + (size_t)((l * 2 + d) * NG + g) * S5_STRIDE;
            bf16x8 Cf[4];
#pragma unroll
            for (int ks = 0; ks < 4; ++ks) Cf[ks] = *(const bf16x8*)(tb + S5_CEF + (tk * 128 + 32 * ks + 8 * q) * 2);
            bf16x8 Dfrag = {0, 0, 0, 0, 0, 0, 0, 0};
            if (d == 0 && q < 2) { const float dv = dskip[GS * g + tk]; const unsigned short db = (unsigned short)(cvt_pk_bf16(dv, 0.f) & 0xffffu);
#pragma unroll
                for (int jj = 0; jj < 8; ++jj) Dfrag[jj] = (8 * q + jj == tk) ? (short)db : (short)0; }
            LAS unsigned char* part = lds + S5_POFF;
            for (int it = 0; it <= S5_NCH; ++it) {
                if (it >= 1) {
                    const int s = it - 1;
                    const LAS unsigned char* hrow = lds + (size_t)(((s & 1) * 2 + d) * 32 + 16 * tt + tk) * S5_HROW;
                    f32x4 acc = {0.f, 0.f, 0.f, 0.f};
#pragma unroll
                    for (int ks = 0; ks < 4; ++ks) { const bf16x8 hf = *(const LAS bf16x8*)(hrow + 16 * q + 64 * ks); acc = __builtin_amdgcn_mfma_f32_16x16x32_bf16(Cf[ks], hf, acc, 0, 0, 0); }
                    if (d == 0) { bf16x8 uf = {0, 0, 0, 0, 0, 0, 0, 0}; if (q < 2) uf = *(const LAS bf16x8*)(hrow + 256 + 16 * q); acc = __builtin_amdgcn_mfma_f32_16x16x32_bf16(Dfrag, uf, acc, 0, 0, 0); }
                    const int tau = 32 * s + 16 * tt + tk, t = d ? (S5_LP - 1 - tau) : tau;
                    if (t < LTOK) {
                        LAS unsigned char* pp = part + (size_t)(t * GS + 4 * q) * 2;
                        if (s <= 32) { u32x2 w; w.x = cvt_pk_bf16(acc[0], acc[1]); w.y = cvt_pk_bf16(acc[2], acc[3]); *(LAS u32x2*)pp = w; }
                        else { const u32x2 o = *(const LAS u32x2*)pp;
                            const float y0 = acc[0] + bflo(o.x), y1 = acc[1] + bfhi(o.x), y2 = acc[2] + bflo(o.y), y3 = acc[3] + bfhi(o.y);
                            const float g0 = gelu_tanh(y0), g1 = gelu_tanh(y1), g2 = gelu_tanh(y2), g3 = gelu_tanh(y3); const size_t ro = (size_t)tok_row(b, t) * SSMW + GS * g + 4 * q;
                            u32x2 w; w.x = cvt_pk_bf16(g0, g1); w.y = cvt_pk_bf16(g2, g3); *(u32x2*)(gb + ro) = w;
                            *(unsigned*)(g8 + ro) = pk4_fp8(g0 * F8_GS, g1 * F8_GS, g2 * F8_GS, g3 * F8_GS); }
                    }
                }
                WG_BAR();
            }
        }
        __syncthreads();
    }
}

namespace att {
constexpr int KVBLK = 64, NMINI = 7;
constexpr int SHM_V = 16384, SHM_K = 16384, SHM_P = 8192;
constexpr int V_OFF = 0, KN_OFF = 3 * SHM_V, KP_OFF = KN_OFF + 2 * SHM_K, WS_OFF = KP_OFF + 2 * SHM_P, QR_OFF = WS_OFF + NWAVES * 256, NQL = 6, LDS_NEED = QR_OFF + NWAVES * NQL * 1024;
static_assert(LDS_NEED <= MISC_OFF, "attention LDS");
constexpr float THRL = 8.0f * 1.4426950408889634f;
#define KSWZ(row, colB) ((row) * 256 + ((colB) ^ (((row) & 7) << 4)))
#define KPSWZ(row, colB) ((row) * 128 + ((colB) ^ ((((row) >> 1) & 7) << 4)))
#define SBAR() __builtin_amdgcn_sched_barrier(0)
__device__ __forceinline__ int crow(int r, int hi) { return (r & 3) + 8 * (r >> 2) + 4 * hi; }
__device__ __forceinline__ void partialSM(f32x16& p0, f32x16& p1, float& m_reg, float& mn, float& alpha) {
    float pmax = p0[0];
#pragma unroll
    for (int r = 1; r < 16; ++r) pmax = fmaxf(pmax, p0[r]);
#pragma unroll
    for (int r = 0; r < 16; ++r) pmax = fmaxf(pmax, p1[r]);
    { auto rr = __builtin_amdgcn_permlane32_swap(__float_as_uint(pmax), __float_as_uint(pmax), false, false); pmax = fmaxf(__uint_as_float(rr[0]), __uint_as_float(rr[1])); }
    if (__builtin_expect(__all(pmax - m_reg <= THRL), 1)) { mn = m_reg; alpha = 1.f; }
    else { mn = fmaxf(m_reg, pmax); alpha = fast_exp2(m_reg - mn); m_reg = mn; }
#pragma unroll
    for (int r = 0; r < 16; ++r) p0[r] = p0[r] - mn;
#pragma unroll
    for (int r = 0; r < 16; ++r) p1[r] = p1[r] - mn;
#pragma unroll
    for (int r = 0; r < 16; ++r) p0[r] = fast_exp2(p0[r]);
}
__device__ __forceinline__ void finishSM(f32x16& p0, f32x16& p1, float alpha, float& l_reg, bf16x8& pa0, bf16x8& pa1, bf16x8& pa2, bf16x8& pa3) {
#pragma unroll
    for (int r = 0; r < 16; ++r) p1[r] = fast_exp2(p1[r]);
    float ps = 0;
#pragma unroll
    for (int r = 0; r < 16; ++r) ps += p0[r];
#pragma unroll
    for (int r = 0; r < 16; ++r) ps += p1[r];
    { auto rr = __builtin_amdgcn_permlane32_swap(__float_as_uint(ps), __float_as_uint(ps), false, false); ps = __uint_as_float(rr[0]) + __uint_as_float(rr[1]); }
    l_reg = l_reg * alpha + ps;
#define PK4(P, BASE, OUT) do { unsigned a0 = cvt_pk_bf16(P[BASE + 0], P[BASE + 1]), a1 = cvt_pk_bf16(P[BASE + 2], P[BASE + 3]);   \
    unsigned b0 = cvt_pk_bf16(P[BASE + 4], P[BASE + 5]), b1 = cvt_pk_bf16(P[BASE + 6], P[BASE + 7]);                              \
    auto r0 = __builtin_amdgcn_permlane32_swap(a0, b0, false, false); auto r1 = __builtin_amdgcn_permlane32_swap(a1, b1, false, false); \
    u32x4 w = {r0[0], r1[0], r0[1], r1[1]}; OUT = *reinterpret_cast<bf16x8*>(&w); } while (0)
    PK4(p0, 0, pa0); PK4(p0, 8, pa1); PK4(p1, 0, pa2); PK4(p1, 8, pa3);
#undef PK4
}
__device__ __forceinline__ void qkt(f32x16& p0, f32x16& p1, const LAS char* Kn, const LAS char* Kp, const bf16x8* qr, const LAS char* qrl, int r32, int hi, bool masked) {
    p0 = f32x16{}; p1 = f32x16{};
#pragma unroll
    for (int d0 = 0; d0 < 8; ++d0) { const int cb = (d0 * 16 + hi * 8) * 2;
        const bf16x8 b0 = *(const LAS bf16x8*)(Kn + KSWZ(r32, cb)), b1 = *(const LAS bf16x8*)(Kn + KSWZ(32 + r32, cb));
        const bf16x8 qf = d0 < 6 ? qr[d0 < 6 ? d0 : 0] : *(const LAS bf16x8*)(qrl + (d0 == 6 ? 5 : 4) * 1024);
        p0 = __builtin_amdgcn_mfma_f32_32x32x16_bf16(b0, qf, p0, 0, 0, 0); p1 = __builtin_amdgcn_mfma_f32_32x32x16_bf16(b1, qf, p1, 0, 0, 0); }
#pragma unroll
    for (int d0 = 0; d0 < 4; ++d0) { const int cb = (d0 * 16 + hi * 8) * 2;
        const bf16x8 b0 = *(const LAS bf16x8*)(Kp + KPSWZ(r32, cb)), b1 = *(const LAS bf16x8*)(Kp + KPSWZ(32 + r32, cb));
        const bf16x8 qf = *(const LAS bf16x8*)(qrl + d0 * 1024);
        p0 = __builtin_amdgcn_mfma_f32_32x32x16_bf16(b0, qf, p0, 0, 0, 0); p1 = __builtin_amdgcn_mfma_f32_32x32x16_bf16(b1, qf, p1, 0, 0, 0); }
    if (masked) {
#pragma unroll
        for (int r = 8; r < 16; ++r) p0[r] = -1e30f;
#pragma unroll
        for (int r = 0; r < 16; ++r) p1[r] = -1e30f;
    }
}
__device__ __forceinline__ int v_st(int k, int c) { const int kk = (k & ~0xC) | ((k & 4) << 1) | ((k & 8) >> 1); return ((kk >> 3) * 4 + (c >> 5)) * 512 + ((kk & 7) * 32 + (c & 31)) * 2; }
__device__ __forceinline__ int v_rd_base(int lane) { return ((lane & 3) << 3) | (((lane >> 2) & 3) << 6) | (((lane >> 4) & 1) << 5) | (((lane >> 5) & 1) << 8); }
constexpr int v_rd_off(int d0, int ks, int half) { return d0 * 512 + ks * 4096 + half * 2048; }
template <int OFF> __device__ __forceinline__ s16x4 tr_read(int vb) { s16x4 r; asm volatile("ds_read_b64_tr_b16 %0, %1 offset:%2" : "=&v"(r) : "v"(vb), "i"(OFF) : "memory"); return r; }
template <int D0> __device__ __forceinline__ void pv_one(f32x16& od, int vb, bf16x8 pa0, bf16x8 pa1, bf16x8 pa2, bf16x8 pa3) {
    const s16x4 l0 = tr_read<v_rd_off(D0, 0, 0)>(vb), h0 = tr_read<v_rd_off(D0, 0, 1)>(vb), l1 = tr_read<v_rd_off(D0, 1, 0)>(vb), h1 = tr_read<v_rd_off(D0, 1, 1)>(vb);
    const s16x4 l2 = tr_read<v_rd_off(D0, 2, 0)>(vb), h2 = tr_read<v_rd_off(D0, 2, 1)>(vb), l3 = tr_read<v_rd_off(D0, 3, 0)>(vb), h3 = tr_read<v_rd_off(D0, 3, 1)>(vb);
    asm volatile("s_waitcnt lgkmcnt(0)" ::: "memory"); SBAR();
#define PK(L, H) (bf16x8){L[0], L[1], L[2], L[3], H[0], H[1], H[2], H[3]}
    od = __builtin_amdgcn_mfma_f32_32x32x16_bf16(pa0, PK(l0, h0), od, 0, 0, 0);
    od = __builtin_amdgcn_mfma_f32_32x32x16_bf16(pa1, PK(l1, h1), od, 0, 0, 0);
    od = __builtin_amdgcn_mfma_f32_32x32x16_bf16(pa2, PK(l2, h2), od, 0, 0, 0);
    od = __builtin_amdgcn_mfma_f32_32x32x16_bf16(pa3, PK(l3, h3), od, 0, 0, 0);
#undef PK
}
__device__ __forceinline__ void pv_d0(f32x16* o, int vb, bf16x8 pa0, bf16x8 pa1, bf16x8 pa2, bf16x8 pa3) {
    pv_one<0>(o[0], vb, pa0, pa1, pa2, pa3); pv_one<1>(o[1], vb, pa0, pa1, pa2, pa3); pv_one<2>(o[2], vb, pa0, pa1, pa2, pa3); pv_one<3>(o[3], vb, pa0, pa1, pa2, pa3);
}

template <bool MINI>
__device__ __forceinline__ void attn_unit(int b, int h, int qrow0, int x0, int nx, bool has_meta, const bf16_t* __restrict__ qb, const bf16_t* __restrict__ kvb, const bf16_t* __restrict__ kpe,
                                          bf16_t* __restrict__ mix, float* __restrict__ part, float* __restrict__ psq_att, LAS char* lds, int tid) {
    const int wid = tid >> 6, lane = tid & 63, r32 = lane & 31, hi = lane >> 5;
    LAS char* V_lds = lds + V_OFF; LAS char* Kn_lds = lds + KN_OFF; LAS char* Kp_lds = lds + KP_OFF;
    LAS float* wsf = (LAS float*)(lds + WS_OFF) + wid * 64; LAS float* li_l = wsf; LAS float* al_l = wsf + 32;
    float m_reg = -1e30f, l_reg = 0; f32x16 o[4] = {}; bf16x8 qr[6];
    LAS char* qrl = lds + QR_OFF + wid * (NQL * 1024) + lane * 16;
    const int krow = tid >> 4, kcol = (((tid & 15) ^ (krow & 7)) * 8);
    const int vk0 = (tid >> 7) * 8 + ((tid & 31) >> 2), vc = ((tid >> 5) & 3) * 32 + (tid & 3) * 8;
    const int vkk1 = vk0 + 32, vka = (vk0 & ~0xC) | ((vk0 & 4) << 1) | ((vk0 & 8) >> 1), vkb = (vkk1 & ~0xC) | ((vkk1 & 4) << 1) | ((vkk1 & 8) >> 1);
    const int prow = tid >> 3, pcol = (((tid & 7) ^ ((prow >> 1) & 7)) * 8);
    const int vb0 = (int)(uintptr_t)V_lds + v_rd_base(lane);
    const int NT = nx + (has_meta ? 1 : 0);
    const bf16_t* kvh = kvb + h * 256;
    const unsigned ldsw = (unsigned)__builtin_amdgcn_readfirstlane(wid) * 1024u;
#define TILE_ID(i) ((i) < nx ? x0 + (i) : 32)
#define GLDS(src, dst) __builtin_amdgcn_global_load_lds((const unsigned*)(src), (LAS unsigned*)(dst), 16, 0, 0)
#define SLOAD(i, bf, vbf) do { const int _t = TILE_ID(i); const size_t _kb = _t < 32 ? (size_t)b * SEQ + 64 * _t : (size_t)MX + NMETA * b; \
    GLDS(kvh + (_kb + krow) * 2048 + kcol, Kn_lds + (bf) * SHM_K + ldsw); GLDS(kvh + (_kb + 32 + krow) * 2048 + kcol, Kn_lds + (bf) * SHM_K + 8192 + ldsw); \
    GLDS(kvh + (_kb + vka) * 2048 + 128 + vc, V_lds + (vbf) * SHM_V + ldsw); GLDS(kvh + (_kb + vkb) * 2048 + 128 + vc, V_lds + (vbf) * SHM_V + 8192 + ldsw); \
    GLDS(kpe + (_kb + prow) * 64 + pcol, Kp_lds + (bf) * SHM_P + ldsw); } while (0)
#define RESC(a) do { if (__any((a) < 1.f)) { if (hi == 0) al_l[r32] = (a); asm volatile("s_waitcnt lgkmcnt(0)" ::: "memory"); \
    _Pragma("unroll") for (int d = 0; d < 4; ++d) _Pragma("unroll") for (int r = 0; r < 16; ++r) o[d][r] *= al_l[crow(r, hi)]; } } while (0)
    f32x16 pA0, pA1; float mnA, alA; bf16x8 pa0 = {}, pa1 = {}, pa2 = {}, pa3 = {};
    const bool lag = wid >= 4;
    const bool act = !MINI || wid == 0;
    SLOAD(0, 0, 0);
    { const int qrow = MINI ? qrow0 + (r32 & 15) : qrow0 + wid * 32 + r32; const bf16_t* Qw = qb + (size_t)qrow * 1536 + h * DQK + hi * 8;
#pragma unroll
      for (int d0 = 0; d0 < 6; ++d0) qr[d0] = *(const bf16x8*)(Qw + d0 * 16);
#pragma unroll
      for (int d0 = 0; d0 < 4; ++d0) *(LAS bf16x8*)(qrl + d0 * 1024) = *(const bf16x8*)(Qw + (8 + d0) * 16);
      *(LAS bf16x8*)(qrl + 4 * 1024) = *(const bf16x8*)(Qw + 7 * 16); *(LAS bf16x8*)(qrl + 5 * 1024) = *(const bf16x8*)(Qw + 6 * 16); }
    VM_WAIT(); __syncthreads();
    int vcur = 0, vprev = 2;
    for (int i = 0; i < NT; ++i) {
        const int bf = i & 1; const bool more = (i + 1 < NT); const int vnext = vcur == 2 ? 0 : vcur + 1;
        if (more) SLOAD(i + 1, bf ^ 1, vnext);
        if (act) {
        if (lag && i > 0) { SBAR(); pv_d0(o, vb0 + vprev * SHM_V, pa0, pa1, pa2, pa3); }
        SBAR(); qkt(pA0, pA1, Kn_lds + bf * SHM_K, Kp_lds + bf * SHM_P, qr, qrl, r32, hi, TILE_ID(i) == 32);
        partialSM(pA0, pA1, m_reg, mnA, alA);
        RESC(alA);
        finishSM(pA0, pA1, alA, l_reg, pa0, pa1, pa2, pa3); SBAR();
        if (!lag) pv_d0(o, vb0 + vcur * SHM_V, pa0, pa1, pa2, pa3);
        }
        VM_WAIT();
        __syncthreads();
        vprev = vcur; vcur = vnext;
    }
    if (lag && act) pv_d0(o, vb0 + vprev * SHM_V, pa0, pa1, pa2, pa3);
    __syncthreads();
    if constexpr (!MINI) {
        if (hi == 0) li_l[r32] = l_reg; asm volatile("s_waitcnt lgkmcnt(0)" ::: "memory");
        float rli[16];
#pragma unroll
        for (int r = 0; r < 16; ++r) rli[r] = fast_rcp(li_l[crow(r, hi)]);
        LAS char* ost = lds + wid * 8192;
#pragma unroll
        for (int r = 0; r < 16; ++r)
#pragma unroll
            for (int d0 = 0; d0 < 4; ++d0) *(LAS unsigned short*)(ost + crow(r, hi) * 256 + (d0 * 32 + r32) * 2) = (unsigned short)(cvt_pk_bf16(o[d0][r] * rli[r], 0.f) & 0xffffu);
        asm volatile("s_waitcnt lgkmcnt(0)" ::: "memory");
        bf16_t* Ob = mix + (size_t)(qrow0 + wid * 32) * 2048 + h * DV;
        float* psq = psq_att; asm volatile("" : "+s"(psq));
#pragma unroll
        for (int i = 0; i < 8; ++i) { const int ch = i * 64 + lane, rw = ch >> 4, cp = ch & 15; const u32x4 ov = *(const LAS u32x4*)(ost + rw * 256 + cp * 16);
            *(u32x4*)(Ob + (size_t)rw * 2048 + cp * 8) = ov;
            float ss = (bflo(ov.x) * bflo(ov.x) + bfhi(ov.x) * bfhi(ov.x)) + (bflo(ov.y) * bflo(ov.y) + bfhi(ov.y) * bfhi(ov.y)) + (bflo(ov.z) * bflo(ov.z) + bfhi(ov.z) * bfhi(ov.z)) + (bflo(ov.w) * bflo(ov.w) + bfhi(ov.w) * bfhi(ov.w));
            ss += __shfl_xor(ss, 1); ss += __shfl_xor(ss, 2); ss += __shfl_xor(ss, 4); ss += __shfl_xor(ss, 8);
            if (cp == 0) psq[(size_t)(qrow0 + wid * 32 + rw) * 8 + h] = ss; }
        __syncthreads();
    } else {
        asm volatile("" :: "v"(o[0]), "v"(o[1]), "v"(o[2]), "v"(o[3]));
        if (wid == 0) {
#pragma unroll
            for (int r = 0; r < 8; ++r)
#pragma unroll
                for (int d0 = 0; d0 < 4; ++d0) __hip_atomic_store(part + crow(r, hi) * 128 + d0 * 32 + r32, o[d0][r], __ATOMIC_RELAXED, __HIP_MEMORY_SCOPE_AGENT);
            if (lane < 16) { __hip_atomic_store(part + 16 * 128 + lane, m_reg, __ATOMIC_RELAXED, __HIP_MEMORY_SCOPE_AGENT); __hip_atomic_store(part + 16 * 128 + 16 + lane, l_reg, __ATOMIC_RELAXED, __HIP_MEMORY_SCOPE_AGENT); }
        }
        __syncthreads();
    }
#undef TILE_ID
#undef SLOAD
#undef GLDS
#undef RESC
}
__device__ __forceinline__ void meta_merge(int b, int h, const float* apart, bf16_t* mix, float* psq_att, int wid, int lane) {
    const float* p0 = (const float*)((const char*)apart + (size_t)((b * NH + h) * 8) * APART_STRIDE);
    float ml[2][NMINI], ll[2][NMINI]; unsigned long long ov[2][NMINI];
#pragma unroll
    for (int j = 0; j < 2; ++j)
#pragma unroll
        for (int e = 0; e < NMINI; ++e) { const float* pe = (const float*)((const char*)p0 + (size_t)e * APART_STRIDE); const int i = 2 * wid + j;
            ml[j][e] = __hip_atomic_load(pe + 16 * 128 + i, __ATOMIC_RELAXED, __HIP_MEMORY_SCOPE_AGENT); ll[j][e] = __hip_atomic_load(pe + 16 * 128 + 16 + i, __ATOMIC_RELAXED, __HIP_MEMORY_SCOPE_AGENT);
            ov[j][e] = __hip_atomic_load((const unsigned long long*)(pe + i * 128 + 2 * lane), __ATOMIC_RELAXED, __HIP_MEMORY_SCOPE_AGENT); }
#pragma unroll
    for (int j = 0; j < 2; ++j) { float m = -1e30f;
#pragma unroll
        for (int e = 0; e < NMINI; ++e) m = fmaxf(m, ml[j][e]);
        float L = 0.f, o0 = 0.f, o1 = 0.f;
#pragma unroll
        for (int e = 0; e < NMINI; ++e) { const float w = fast_exp2(ml[j][e] - m); L += w * ll[j][e]; o0 += w * __uint_as_float((unsigned)ov[j][e]); o1 += w * __uint_as_float((unsigned)(ov[j][e] >> 32)); }
        const float rl = 1.0f / L; const unsigned pk = cvt_pk_bf16(o0 * rl, o1 * rl); const int row = MX + NMETA * b + 2 * wid + j;
        *(unsigned*)(mix + (size_t)row * 2048 + h * DV + 2 * lane) = pk;
        const float ss = wave_sum(bflo(pk) * bflo(pk) + bfhi(pk) * bfhi(pk)); if (lane == 0) psq_att[(size_t)row * 8 + h] = ss; }
}
__device__ __forceinline__ void attn_phase(const bf16_t* qb, const bf16_t* kvb, const bf16_t* kpe, bf16_t* mix, float* apart, float* psq_att, unsigned* tkt, LAS char* lds, int tid, int G, bool minis) {
    for (int u0 = blockIdx.x; u0 < 256; u0 += G) { const int u = (G == 256) ? ((u0 & 7) << 5) | (u0 >> 3) : u0;
        const int bh = u >> 3, qblk = u & 7, b = bh >> 3, h = bh & 7;
        attn_unit<false>(b, h, b * SEQ + 256 * qblk, 0, 32, true, qb, kvb, kpe, mix, nullptr, psq_att, lds, tid); }
    const int nglu = (MP / 256) * (SSMW / 256), first = G > nglu ? nglu : 0, nw = G - first;
    if (minis && (int)blockIdx.x >= first)
        for (int v = (int)blockIdx.x - first; v < 32 * NMINI; v += nw) { const int bh = v / NMINI, e = v - bh * NMINI, b = bh >> 3, h = bh & 7;
            const int x0 = e == 0 ? 0 : (e <= 5 ? 5 * e - 1 : 24 + 4 * (e - 5)), nx = (e == 0 || e >= 5) ? 4 : 5;
            attn_unit<true>(b, h, MX + NMETA * b, x0, nx, e == 0, qb, kvb, kpe, nullptr, (float*)((char*)apart + (size_t)(bh * 8 + e) * APART_STRIDE), nullptr, lds, tid);
            LAS unsigned* flag = (LAS unsigned*)(lds + MISC_OFF + 80);
            if (tid == 0) { VM_WAIT(); *flag = atomicAdd(tkt + bh * 16, 1u); }
            __syncthreads();
            if (*flag == NMINI - 1) meta_merge(b, h, apart, mix, psq_att, tid >> 6, tid & 63); }
}
#undef KSWZ
#undef KPSWZ
#undef SBAR
}

template <class Sched>
__device__ __forceinline__ void outnorm_scales(const Sched& S, const float* psq, float* scl, int nr, int tid) {
    for (int i = 0; ; ++i) { pg8::Unit u; if (!S.next(i, u)) break;
        const int row = u.pm * 256 + tid;
        if (tid < 256 && row < nr) {
            const f32x4 a0 = *(const f32x4*)(psq + (size_t)row * 8), a1 = *(const f32x4*)(psq + (size_t)row * 8 + 4);
            const float* ps = psq + (size_t)MP * 8 + (size_t)row * 16;
            const f32x4 s0 = *(const f32x4*)ps, s1 = *(const f32x4*)(ps + 4), s2 = *(const f32x4*)(ps + 8), s3 = *(const f32x4*)(ps + 12);
            const f32x4 sa = a0 + a1, sv = (s0 + s1) + (s2 + s3);
            const float ra = 1.0f / sqrtf(((sa[0] + sa[1]) + (sa[2] + sa[3])) * (1.0f / ATTW) + EPS), rs = 1.0f / sqrtf(((sv[0] + sv[1]) + (sv[2] + sv[3])) * (1.0f / SSMW) + EPS);
            scl[row] = ra / rs; scl[MP + row] = rs; } }
    VM_WAIT(); __syncthreads();
}


template <int N>
__device__ __forceinline__ float psq_sum(const float* p) {
    f32x4 v[N / 4];
#pragma unroll
    for (int j = 0; j < N / 4; ++j) v[j] = *(const f32x4*)(p + 4 * j);
    f32x4 a = v[0];
#pragma unroll
    for (int j = 1; j < N / 4; ++j) a += v[j];
    return (a[0] + a[1]) + (a[2] + a[3]);
}
template <int LO, int HI>
__device__ __forceinline__ f32x4 slab_sum_range(const float* slab, int r, int N, int c) {
    f32x4 v[HI - LO];
#pragma unroll
    for (int s = LO; s < HI; ++s) v[s - LO] = *(const f32x4*)(slab + ((size_t)s * 64 + r) * N + c);
    f32x4 a = v[0];
#pragma unroll
    for (int s = 1; s < HI - LO; ++s) a += v[s];
    return a;
}
template <int NS>
__device__ __forceinline__ f32x4 slab_sum(const float* slab, int r, int N, int c) {
    f32x4 v[NS];
#pragma unroll
    for (int s = 0; s < NS; ++s) v[s] = *(const f32x4*)(slab + ((size_t)s * 64 + r) * N + c);
    f32x4 a = v[0];
#pragma unroll
    for (int s = 1; s < NS; ++s) a += v[s];
    return a;
}
template <int NS>
__device__ __forceinline__ void tail_res_ffn_phase(float* h, bf16_t* hb, const float* psq, float* rs, const float* slab, const float* scl, int tid, int G) {
    const int lane = tid & 63, gw = blockIdx.x * NWAVES + (tid >> 6), ngw = G * NWAVES;
    constexpr float C = 1.0f / (F8_HS * F8_WGU);
    for (int r = ngw - 1 - gw; r < 64; r += ngw) { float ss = 0.f; const float rs_ = scl[MP + MX + r]; const f32x2 sc2 = {scl[MX + r] * rs_, rs_};
#pragma unroll 2
        for (int j = 0; j < 8; ++j) { const int c = j * 256 + 4 * lane; const size_t off = (size_t)(MX + r) * DM + c;
            const f32x4 v = *(const f32x4*)(h + off) + slab_sum_range<0, NS / 2>(slab, r, DM, c) * sc2.x + slab_sum_range<NS / 2, NS>(slab, r, DM, c) * sc2.y;
            *(f32x4*)(h + off) = v; *(unsigned*)((unsigned char*)hb + off) = pk4_fp8(v[0] * F8_HS, v[1] * F8_HS, v[2] * F8_HS, v[3] * F8_HS);
            ss += (v[0] * v[0] + v[1] * v[1]) + (v[2] * v[2] + v[3] * v[3]); }
        ss = wave_sum(ss); if (lane == 0) rs[MX + r] = C * __builtin_amdgcn_rsqf(ss * (1.0f / DM) + EPS); }
    for (int row = gw * 64 + lane; row < MP; row += ngw * 64)
        if (row < MX || row >= MREAL) rs[row] = row < MX ? C * __builtin_amdgcn_rsqf(psq_sum<32>(psq + (size_t)row * 32) * (1.0f / DM) + EPS) : 0.f;
}
template <bool F8OUT, int NS>
__device__ __forceinline__ void tail_res_phase(float* h, bf16_t* hb, ssq_t* ssq, const float* psq, const float* slab, float sc, int tid, int G) {
    const int lane = tid & 63, gw = blockIdx.x * NWAVES + (tid >> 6), ngw = G * NWAVES;
    for (int row = (ngw - 1 - gw) * 64 + lane; row < MX; row += ngw * 64) ssq[row] = ssq_fix(psq_sum<32>(psq + (size_t)row * 32));
    for (int w = gw; w < 64 * 8; w += ngw) { const int r = w >> 3, c = (w & 7) * 256 + 4 * lane; const size_t off = (size_t)(MX + r) * DM + c;
        const f32x4 v = *(const f32x4*)(h + off) + slab_sum<NS>(slab, r, DM, c) * sc;
        *(f32x4*)(h + off) = v;
        if constexpr (F8OUT) *(unsigned*)((unsigned char*)hb + off) = pk4_fp8(v[0] * F8_HS, v[1] * F8_HS, v[2] * F8_HS, v[3] * F8_HS);
        else { u32x2 pk; pk.x = cvt_pk_bf16(v[0], v[1]); pk.y = cvt_pk_bf16(v[2], v[3]); *(u32x2*)(hb + off) = pk; }
        const float ss = wave_sum((v[0] * v[0] + v[1] * v[1]) + (v[2] * v[2] + v[3] * v[3])); if (lane == 0) atomicAdd(ssq + MX + r, ssq_fix(ss)); }
}
template <int NS>
__device__ __forceinline__ void tail_g1_phase(bf16_t* proj, bf16_t* kpe, const ssq_t* ssq_h, ssq_t* ssq_cq, ssq_t* ssq_ckv, const float* psq, const float* cosb, const float* sinb, const float* slab, int tid, int G) {
    const int lane = tid & 63, gw = blockIdx.x * NWAVES + (tid >> 6), ngw = G * NWAVES;
    for (int row = (ngw - 1 - gw) * 64 + lane; row < MX; row += ngw * 64) {
        ssq_cq[row] = ssq_fix(psq_sum<8>(psq + (size_t)row * 12)); ssq_ckv[row] = ssq_fix(psq_sum<4>(psq + (size_t)row * 12 + 8)); }
    for (int w = gw; w < 64 * 8; w += ngw) { const int r = w >> 3, pn = w & 7, c = pn * 256 + 4 * lane, row = MX + r;
        const float rr = 1.0f / sqrtf(ssq_get(ssq_h, row) * (1.0f / DM) + EPS);
        const f32x4 v = slab_sum<NS>(slab, r, PROJW, c) * rr;
        if (pn == 3) {
            if (lane < 16) { const int pos = row_pos(row), i0 = 2 * lane; const f32x2 cc = *(const f32x2*)(cosb + pos * 32 + i0), sn = *(const f32x2*)(sinb + pos * 32 + i0);
                u32x2 pk; pk.x = cvt_pk_bf16(v[0] * cc.x - v[1] * sn.x, v[0] * sn.x + v[1] * cc.x); pk.y = cvt_pk_bf16(v[2] * cc.y - v[3] * sn.y, v[2] * sn.y + v[3] * cc.y);
                *(u32x2*)(kpe + (size_t)row * 64 + 4 * lane) = pk; }
        } else {
            u32x2 pk; pk.x = cvt_pk_bf16(v[0], v[1]); pk.y = cvt_pk_bf16(v[2], v[3]); *(u32x2*)(proj + (size_t)row * PROJW + c) = pk;
            if (pn < 3) { const float ss = wave_sum((v[0] * v[0] + v[1] * v[1]) + (v[2] * v[2] + v[3] * v[3])); if (lane == 0) atomicAdd((pn < 2 ? ssq_cq : ssq_ckv) + row, ssq_fix(ss)); }
        }
    }
}

struct Route { int e0, e1, s0, s1; float w0, w1, r, pad; };
template <int NS>
__device__ __forceinline__ void router_phase(float* h, bf16_t* hb, const float* slab, const float* scl, const float* wr, const float* gain, Route* route, unsigned* cnt, unsigned char* xp8, unsigned char* mact8, float* rperm, float* gperm, int nrows, LAS unsigned char* lds, int tid, int G) {
    const int lane = tid & 63, gw = blockIdx.x * NWAVES + (tid >> 6), ngw = G * NWAVES;
    { unsigned zz = 0u; asm volatile("" : "+v"(zz));
      for (int i = gw * 8 + (lane >> 3); i < MOE_ROWS; i += ngw * 8) *(u32x4*)(mact8 + (size_t)i * DFEP + DFE + 16 * (lane & 7)) = (u32x4){zz, zz, zz, zz}; }
    f32x4 nx[8];
#pragma unroll
    for (int j = 0; j < 8; ++j) nx[j] = *(const f32x4*)(h + (size_t)(gw < nrows ? gw : 0) * DM + 4 * lane + 256 * j);
    LAS float* wl = (LAS float*)lds;
    for (int i0 = tid; i0 < DM * NE; i0 += NTHR * 8) { float a[8], g[8];
#pragma unroll
        for (int u = 0; u < 8; ++u) { const int i = i0 + u * NTHR; a[u] = wr[i]; g[u] = gain[i >> 3]; }
#pragma unroll
        for (int u = 0; u < 8; ++u) { const int i = i0 + u * NTHR; wl[(i & 7) * DM + (i >> 3)] = a[u] * g[u]; } }
    __syncthreads();
    for (int row = gw; row < nrows; row += ngw) {
        float lg[NE] = {0.f, 0.f, 0.f, 0.f, 0.f, 0.f, 0.f, 0.f}; float ss = 0.f;
        f32x4 hv[8];
#pragma unroll
        for (int j = 0; j < 8; ++j) hv[j] = nx[j];
        { const int nrow = row + ngw < nrows ? row + ngw : row;
#pragma unroll
          for (int j = 0; j < 8; ++j) nx[j] = *(const f32x4*)(h + (size_t)nrow * DM + 4 * lane + 256 * j); }
        if (row >= MX) {
            const float rs_ = scl[MP + row]; const f32x2 sc2 = {scl[row] * rs_, rs_};
#pragma unroll
            for (int hf = 0; hf < 4; ++hf) { f32x4 sl[2];
#pragma unroll
                for (int j = 0; j < 2; ++j) sl[j] = slab_sum_range<0, NS / 2>(slab, row - MX, DM, 4 * lane + 256 * (2 * hf + j)) * sc2.x + slab_sum_range<NS / 2, NS>(slab, row - MX, DM, 4 * lane + 256 * (2 * hf + j)) * sc2.y;
#pragma unroll
                for (int j = 0; j < 2; ++j) hv[2 * hf + j] += sl[j];
                asm volatile("" : "+v"(hv[2 * hf]), "+v"(hv[2 * hf + 1])); }
#pragma unroll
            for (int j = 0; j < 8; ++j) { const int c = 4 * lane + 256 * j; *(f32x4*)(h + (size_t)row * DM + c) = hv[j]; }
        }
#pragma unroll
        for (int j = 0; j < 8; ++j) { const int c = 4 * lane + 256 * j; const f32x4 x = hv[j];
            ss += (x[0] * x[0] + x[1] * x[1]) + (x[2] * x[2] + x[3] * x[3]);
#pragma unroll
            for (int e = 0; e < NE; ++e) { const f32x4 w = *(const LAS f32x4*)(wl + e * DM + c); lg[e] += (x[0] * w[0] + x[1] * w[1]) + (x[2] * w[2] + x[3] * w[3]); } }
        ss = wave_sum(ss);
#pragma unroll
        for (int e = 0; e < NE; ++e) lg[e] = wave_sum(lg[e]);
        const float r = 1.0f / sqrtf(ss * (1.0f / DM) + EPS);
        {
            int e0 = 0; float v0 = lg[0];
#pragma unroll
            for (int e = 1; e < NE; ++e) if (lg[e] > v0) { v0 = lg[e]; e0 = e; }
            int e1 = -1; float v1 = -3.0e38f;
#pragma unroll
            for (int e = 0; e < NE; ++e) if (e != e0 && lg[e] > v1) { v1 = lg[e]; e1 = e; }
            const float w1 = 1.0f / (1.0f + expf((v0 - v1) * r)), w0 = 1.0f - w1;
            int s0 = 0, s1 = 0;
            if (lane == 0) { s0 = (int)atomicAdd(cnt + 64 * e0, 1u); s1 = (int)atomicAdd(cnt + 64 * e1, 1u); }
            s0 = __builtin_amdgcn_readfirstlane(s0); s1 = __builtin_amdgcn_readfirstlane(s1);
            const size_t d0 = (size_t)e0 * MP + s0, d1 = (size_t)e1 * MP + s1;
            if (lane == 0) { Route rt; rt.e0 = e0; rt.e1 = e1; rt.s0 = s0; rt.s1 = s1; rt.w0 = w0; rt.w1 = w1; rt.r = r; rt.pad = 0.f; route[row] = rt;
                rperm[d0] = r * (1.0f / (F8_HS * F8_WGU)); rperm[d1] = r * (1.0f / (F8_HS * F8_WGU)); gperm[d0] = w0; gperm[d1] = w1; }
#pragma unroll
            for (int j = 0; j < 8; ++j) { const int c = 4 * lane + 256 * j; const unsigned pk = pk4_fp8(hv[j][0] * F8_HS, hv[j][1] * F8_HS, hv[j][2] * F8_HS, hv[j][3] * F8_HS);
                *(unsigned*)(xp8 + d0 * DM + c) = pk; *(unsigned*)(xp8 + d1 * DM + c) = pk; }
        }
    }
    __syncthreads();
}
__device__ __forceinline__ void moe_counts(const unsigned* cnt, int (&cv)[NE]) {
    unsigned t[NE];
#pragma unroll
    for (int e = 0; e < NE; ++e) t[e] = cnt[64 * e];
#pragma unroll
    for (int e = 0; e < NE; ++e) cv[e] = __builtin_amdgcn_readfirstlane((int)t[e]);
}
__device__ __forceinline__ void moe_prefix(const unsigned* cnt, int (&pfx)[NE + 1]) {
    int cv[NE]; moe_counts(cnt, cv);
    pfx[0] = 0;
#pragma unroll
    for (int e = 0; e < NE; ++e) pfx[e + 1] = pfx[e] + ((cv[e] + 255) >> 8);
}
__device__ __forceinline__ void moe_prefix_put(LAS unsigned char* lds, const int (&pfx)[NE + 1], int tid) {
    if (tid == 0) {
#pragma unroll
        for (int e = 0; e <= NE; ++e) *(LAS int*)(lds + MISC_OFF + 40 + 4 * e) = pfx[e]; } }
__device__ __forceinline__ void moe_prefix_get(LAS unsigned char* lds, int (&pfx)[NE + 1]) {
    int t[NE + 1];
#pragma unroll
    for (int e = 0; e <= NE; ++e) t[e] = *(const LAS int*)(lds + MISC_OFF + 40 + 4 * e);
#pragma unroll
    for (int e = 0; e <= NE; ++e) pfx[e] = __builtin_amdgcn_readfirstlane(t[e]); }
__device__ __forceinline__ void permute_phase(const bf16_t* hb, const Route* route, const unsigned* cnt, bf16_t* xperm, unsigned char* mact8, float* rperm, float* gperm, int nrows, int tid, int G) {
    const int lane = tid & 63, gw = blockIdx.x * NWAVES + (tid >> 6), ngw = G * NWAVES;
    int pfx[NE + 1]; moe_prefix(cnt, pfx);
    { unsigned zz = 0u; asm volatile("" : "+v"(zz));
      for (int i = gw * 8 + (lane >> 3); i < pfx[NE] * 256; i += ngw * 8) *(u32x4*)(mact8 + (size_t)i * DFEP + DFE + 16 * (lane & 7)) = (u32x4){zz, zz, zz, zz}; }
    const unsigned char* hb8 = (const unsigned char*)hb; unsigned char* xp8 = (unsigned char*)xperm;
    Route nrt = route[gw < nrows ? gw : 0]; u32x4 nv[2];
#pragma unroll
    for (int j = 0; j < 2; ++j) nv[j] = *(const u32x4*)(hb8 + (size_t)(gw < nrows ? gw : 0) * DM + 1024 * j + 16 * lane);
    for (int row = gw; row < nrows; row += ngw) {
        const Route rt = nrt; u32x4 v[2] = {nv[0], nv[1]};
        const int nrow = row + ngw < nrows ? row + ngw : row;
        nrt = route[nrow];
#pragma unroll
        for (int j = 0; j < 2; ++j) nv[j] = *(const u32x4*)(hb8 + (size_t)nrow * DM + 1024 * j + 16 * lane);
#pragma unroll
        for (int k = 0; k < 2; ++k) { const int e = k ? rt.e1 : rt.e0, s = k ? rt.s1 : rt.s0; const size_t dst = (size_t)pfx[e] * 256 + s;
#pragma unroll
            for (int j = 0; j < 2; ++j) *(u32x4*)(xp8 + dst * DM + 1024 * j + 16 * lane) = v[j];
            if (lane == 0) { rperm[dst] = rt.r * (1.0f / (F8_HS * F8_WGU)); gperm[dst] = k ? rt.w1 : rt.w0; } }
    }
    int cv[NE]; moe_counts(cnt, cv);
    for (int e = 0; e < NE; ++e) { const int c = cv[e]; const int npad = (pfx[e + 1] - pfx[e]) * 256 - c;
        for (int i = gw; i < npad; i += ngw) { const size_t dst = (size_t)pfx[e] * 256 + c + i;
#pragma unroll
            for (int j = 0; j < 2; ++j) *(u32x4*)((unsigned char*)xperm + dst * DM + 1024 * j + 16 * lane) = (u32x4){0u, 0u, 0u, 0u};
            if (lane == 0) { rperm[dst] = 0.f; gperm[dst] = 0.f; } } }
}
template <bool LAST>
__device__ __forceinline__ void combine_phase(float* h, bf16_t* hb, ssq_t* ssq, const bf16_t* y, const Route* route, LAS unsigned char* lds, const float* fnorm, float* out, int tid, int G) {
    const int lane = tid & 63, gw = blockIdx.x * NWAVES + (tid >> 6), ngw = G * NWAVES;
    int pfx[NE + 1]; moe_prefix_get(lds, pfx);
    constexpr int NR = LAST ? MX : MREAL;
    f32x4 fn[8];
#pragma unroll
    for (int j = 0; j < 8; ++j) fn[j] = LAST ? *(const f32x4*)(fnorm + 8 * lane + 512 * (j >> 1) + 4 * (j & 1)) : (f32x4){0.f, 0.f, 0.f, 0.f};
    Route nrt = route[gw + ngw < NR ? gw + ngw : (gw < NR ? gw : 0)];
    u32x4 nya[4], nyb[4]; f32x4 nh[8];
#define CMB_LD(r_, rt_) do { const size_t d0_ = ((size_t)pfx[(rt_).e0] * 256 + (rt_).s0) * DM, d1_ = ((size_t)pfx[(rt_).e1] * 256 + (rt_).s1) * DM; \
        _Pragma("unroll") for (int jj = 0; jj < 4; ++jj) { const int c_ = 8 * lane + 512 * jj; nya[jj] = *(const u32x4*)(y + d0_ + c_); nyb[jj] = *(const u32x4*)(y + d1_ + c_); \
            nh[2 * jj] = *(const f32x4*)(h + (size_t)(r_) * DM + c_); nh[2 * jj + 1] = *(const f32x4*)(h + (size_t)(r_) * DM + c_ + 4); } } while (0)
    { const int r0 = gw < NR ? gw : 0; const Route rt0 = route[r0]; CMB_LD(r0, rt0); }
    for (int row = gw; row < NR; row += ngw) {
        u32x4 cya[4], cyb[4]; f32x4 ch[8];
#pragma unroll
        for (int jj = 0; jj < 4; ++jj) { cya[jj] = nya[jj]; cyb[jj] = nyb[jj]; ch[2 * jj] = nh[2 * jj]; ch[2 * jj + 1] = nh[2 * jj + 1]; }
        { const int nrow = row + ngw < NR ? row + ngw : row; const Route rt = nrt; nrt = route[row + 2 * ngw < NR ? row + 2 * ngw : row]; CMB_LD(nrow, rt); }
        f32x4 v[8]; float ss = 0.f;
#pragma unroll
        for (int jj = 0; jj < 4; ++jj) { const int c = 8 * lane + 512 * jj; const u32x4 ya = cya[jj], yb = cyb[jj];
            v[2 * jj] = ch[2 * jj] + ((f32x4){bflo(ya.x), bfhi(ya.x), bflo(ya.y), bfhi(ya.y)} + (f32x4){bflo(yb.x), bfhi(yb.x), bflo(yb.y), bfhi(yb.y)});
            v[2 * jj + 1] = ch[2 * jj + 1] + ((f32x4){bflo(ya.z), bfhi(ya.z), bflo(ya.w), bfhi(ya.w)} + (f32x4){bflo(yb.z), bfhi(yb.z), bflo(yb.w), bfhi(yb.w)});
#pragma unroll
            for (int n = 0; n < 2; ++n) { const int j = 2 * jj + n; ss += (v[j][0] * v[j][0] + v[j][1] * v[j][1]) + (v[j][2] * v[j][2] + v[j][3] * v[j][3]); } }
        ss = wave_sum(ss);
        if constexpr (!LAST) {
#pragma unroll
            for (int jj = 0; jj < 4; ++jj) { const int c = 8 * lane + 512 * jj; *(f32x4*)(h + (size_t)row * DM + c) = v[2 * jj]; *(f32x4*)(h + (size_t)row * DM + c + 4) = v[2 * jj + 1];
                u32x4 w; w.x = cvt_pk_bf16(v[2 * jj][0], v[2 * jj][1]); w.y = cvt_pk_bf16(v[2 * jj][2], v[2 * jj][3]); w.z = cvt_pk_bf16(v[2 * jj + 1][0], v[2 * jj + 1][1]); w.w = cvt_pk_bf16(v[2 * jj + 1][2], v[2 * jj + 1][3]);
                *(u32x4*)(hb + (size_t)row * DM + c) = w; }
            if (lane == 0) ssq[row] = ssq_fix(ss);
        } else {
#if DBG
#pragma unroll
            for (int j = 0; j < 8; ++j) { const int c = 8 * lane + 512 * (j >> 1) + 4 * (j & 1); *(f32x4*)(h + (size_t)row * DM + c) = v[j]; }
#endif
            if (row < MX) { const float r = 1.0f / sqrtf(ss * (1.0f / DM) + EPS);
#pragma unroll
                for (int j = 0; j < 8; ++j) { const int c = 8 * lane + 512 * (j >> 1) + 4 * (j & 1); *(f32x4*)(out + (size_t)row * DM + c) = v[j] * r * fn[j]; } }
        }
    }
}

struct Args { Inputs in; float* out; unsigned char* ws; int ph_lo, ph_hi; };
__global__ void __launch_bounds__(NTHR, 2) fwd_kernel(Args args) {
    extern __shared__ __attribute__((aligned(16))) unsigned char lds_raw[];
    LAS unsigned char* lds = (LAS unsigned char*)lds_raw;
    volatile LAS unsigned* MISC = (volatile LAS unsigned*)(lds + MISC_OFF);
    const int tid = threadIdx.x, G = gridDim.x;
    unsigned char* ws = args.ws;
    unsigned* ctl = (unsigned*)(ws + WS_CTL);
    for (int u = tid; u < 32; u += NTHR) MISC[u] = 0u;
    __syncthreads();
    const int lo = args.ph_lo, hi = args.ph_hi;
    const bool multi = (hi - lo) > 1;
    XcdBarrier bar; bar.bar = ctl + CW_BAR; bar.x = 0; bar.st = MISC + 8;
    if (multi) bar = xcd_barrier_post(ctl + CW_BAR, MISC + 8);
#ifdef PH_ONLY
#define IN(k) ((((k) % 32) == PH_ONLY) && lo <= (k) && (k) < hi)
#else
#define IN(k) (lo <= (k) && (k) < hi)
#endif
#define SEAM(k) do { if (IN(k) && IN((k) + 1)) { xcd_barrier(bar); if (PROBE_REP & 128) xcd_barrier(bar); } } while (0)
#define SEAM2(k, k2) do { if (IN(k) && IN(k2)) { xcd_barrier(bar); if (PROBE_REP & 128) xcd_barrier(bar); } } while (0)
#define WSL ({ GAS unsigned char* _w = (GAS unsigned char*)ws; asm volatile("" : "+s"(_w)); _w; })
#define AS_GLOBAL(T, p) ((T)({ GAS void* _g = (GAS void*)(p); asm volatile("" : "+v"(_g)); _g; }))
#define DEFP unsigned char* wsl = (unsigned char*)WSL; const float* const* itab = (const float* const*)(wsl + WS_TAB); (void)itab; float* h = (float*)(wsl + WS_H); bf16_t* hb = (bf16_t*)(wsl + WS_HB); bf16_t* proj = (bf16_t*)(wsl + WS_PROJ); bf16_t* kpe = (bf16_t*)(wsl + WS_KPE); \
    bf16_t* qb = (bf16_t*)(wsl + WS_QB); bf16_t* kvb = (bf16_t*)(wsl + WS_KVB); bf16_t* mix = (bf16_t*)(wsl + WS_MIX); bf16_t* mixn = (bf16_t*)(wsl + WS_MIXN); \
    unsigned char* yp = wsl + WS_YP; bf16_t* gb = (bf16_t*)(wsl + WS_GB); float* apart = (float*)(wsl + WS_APART); \
    ssq_t* ssqb = (ssq_t*)(wsl + CTL_SSQ); const float* cosb = (const float*)(wsl + WS_ROPE); const float* sinb = cosb + LTOK * 32; \
    Route* route = (Route*)(wsl + WS_ROUTE); float* rperm = (float*)(wsl + WS_RPERM); float* gperm = (float*)(wsl + WS_GPERM); \
    bf16_t* act = (bf16_t*)(wsl + WS_BIG); bf16_t* xperm = (bf16_t*)(wsl + WS_XPERM); bf16_t* mact = (bf16_t*)(wsl + WS_MACT); bf16_t* yslot = (bf16_t*)(wsl + WS_YSLOT); float* slab = (float*)(wsl + WS_SLAB); (void)slab; \
    const unsigned char* wl = wsl + WS_W + (size_t)l * SZ_LAYER; const unsigned char* wd = wsl + WS_WFF + (size_t)(l >> 1) * SZ_DENSE; \
    const unsigned char* wm = wsl + WS_WFF + 2 * SZ_DENSE + (size_t)(l >> 1) * SZ_MOE; unsigned* cnt = (unsigned*)(wsl + WS_CTL) + CW_CNT + (l >> 1) * 1024; \
    (void)h; (void)hb; (void)proj; (void)kpe; (void)qb; (void)kvb; (void)mix; (void)mixn; (void)yp; (void)gb; (void)apart; (void)ssqb; (void)cosb; (void)sinb; (void)route; (void)rperm; (void)gperm; \
    (void)act; (void)xperm; (void)mact; (void)yslot; (void)wl; (void)wd; (void)wm; (void)cnt;
    const int c = (int)blockIdx.x;
    const int wid_s = __builtin_amdgcn_readfirstlane((int)threadIdx.x >> 6);
#define TIDL ({ unsigned _z = 0u; asm volatile("" : "+v"(_z)); int _t = (wid_s << 6) | (int)__builtin_amdgcn_mbcnt_hi(~0u, __builtin_amdgcn_mbcnt_lo(~0u, _z)); asm volatile("" : "+v"(_t)); _t; })

    if (IN(0)) {
        if (blockIdx.x == 0 && tid == 0) { const float** tab = (const float**)(ws + WS_TAB);
#pragma unroll
            for (int k = 0; k < 29; ++k) tab[k] = args.in.p[k];
            tab[29] = args.out; }
        prologue_phase(args.in, ws, lds, TIDL, G);
        if (PROBE_REP & 1) { __syncthreads(); prologue_phase(args.in, ws, lds, TIDL, G); }
    }
    SEAM(0);
    for (int l = 0; l < DEPTH; ++l) {
        const int P = 32 * l;
        if (IN(P + 1)) {
            DEFP
            pg8::SchedT S{hb, (const bf16_t*)(wl + OFF_WIN), DM, DM, 8, G, c, 256, 8};
            pg8::EpiG1 E{proj, kpe, ssqb + (size_t)SSQ_H1(l) * MP, ssqb + (size_t)SSQ_CQ(l) * MP, ssqb + (size_t)SSQ_CKV(l) * MP, cosb, sinb, slab, (float*)mix};
            pg8::gemm_phase<pg8::EpiG1, pg8::SchedT, true>(lds, S, E, TIDL);
            ffn_slot(l, 0, G, c, TIDL, itab, wsl, lds);
        }
        SEAM(P + 1);
        if (IN(P + 2)) { DEFP tail_g1_phase<8>(proj, kpe, ssqb + (size_t)SSQ_H1(l) * MP, ssqb + (size_t)SSQ_CQ(l) * MP, ssqb + (size_t)SSQ_CKV(l) * MP, (const float*)mix, cosb, sinb, slab, TIDL, G); }
        SEAM(P + 2);
        if (IN(P + 3)) {
            DEFP
            { pg8::Sched2D S{proj, (const bf16_t*)(wl + OFF_WUQ), PROJW, QL, MP / 256, 6, G, c};
              pg8::EpiQ E{qb, ssqb + (size_t)SSQ_CQ(l) * MP, cosb, sinb};
              pg8::gemm_phase<pg8::EpiQ, pg8::Sched2D, true>(lds, S, E, TIDL); }
            { pg8::Sched2D S{proj + QL, (const bf16_t*)(wl + OFF_WUKV), PROJW, KVL, MP / 256, 8, G, (c + 58) % G};
              pg8::EpiScaleBf16 E{kvb, 2048, ssqb + (size_t)SSQ_CKV(l) * MP, 1.0f / KVL};
              pg8::gemm_phase<pg8::EpiScaleBf16, pg8::Sched2D, true>(lds, S, E, TIDL); }
            s5_phase(wsl + WS_S5, proj, yp, gb, AS_GLOBAL(const float*, itab[15]) + (size_t)l * SSMW, l, lds, TIDL, G);
            ffn_slot(l, 5, G, c, TIDL, itab, wsl, lds);
            if (PROBE_REP & 4) s5_phase(wsl + WS_S5, proj, yp, gb, AS_GLOBAL(const float*, itab[15]) + (size_t)l * SSMW, l, lds, TIDL, G);
        }
        SEAM(P + 3);
        if (IN(P + 4)) {
            DEFP
            att::attn_phase(qb, kvb, kpe, mix, apart, (float*)proj, (unsigned*)(wsl + WS_CTL) + CW_TKT + l * 512, (LAS char*)lds, TIDL, G, l != DEPTH - 1);
            { pg8::Sched2D S{(const bf16_t*)yp, (const bf16_t*)(wl + OFF_WGLU), SSMW / 2, SSMW / 2, MP / 256, 4, G, c};
              pg8::EpiGlu E{gb, mix, (float*)proj + (size_t)MP * 8};
              pg8::gemm_phase<pg8::EpiGlu, pg8::Sched2D, true, true>(lds, S, E, TIDL); }
        }
        SEAM2(P + 4, P + 6);
#define nrows ({ int _n = l == DEPTH - 1 ? MX : MREAL; asm volatile("" : "+s"(_n)); _n; })
        if (IN(P + 6)) {
            DEFP
            const float* xin; { const unsigned long long xa = (unsigned long long)itab[0];
              xin = (const float*)(GAS const void*)(((unsigned long long)(unsigned)__builtin_amdgcn_readfirstlane((int)(xa >> 32)) << 32) | (unsigned)__builtin_amdgcn_readfirstlane((int)xa)); }
            pg8::SchedT S{mix, (const bf16_t*)(wl + OFF_WOUT), DM, DM, 8, G, c, 256, l == DEPTH - 1 ? 0 : 8};
            pg8::EpiRes<true, true> E{h, (l & 1) ? (bf16_t*)nullptr : hb, ssqb + (size_t)SSQ_H2(l) * MP, slab, 1.0f, (const float*)gb, l == 0 ? xin : (const float*)h, (float*)proj + (1 << 18), (const float*)proj, nrows};
            pg8::gemm_phase<pg8::EpiRes<true, true>, pg8::SchedT, true>(lds, S, E, TIDL);
            ffn_slot(l, 1, G, c, TIDL, itab, wsl, lds);
            if (PROBE_REP & 2048) { pg8::Sched2D S2{mixn, (const bf16_t*)(wl + OFF_WOUT), DM, DM, 32, 8, G, c}; pg8::EpiScaleBf16 E2{mix, 2048, ssqb + (size_t)SSQ_H2(l) * MP, 1.0f / DM}; pg8::gemm_phase<pg8::EpiScaleBf16, pg8::Sched2D, true>(lds, S2, E2, TIDL); }
        }
        if ((l & 1) == 0) {
            SEAM(P + 6);
            if (IN(P + 7)) { DEFP tail_res_ffn_phase<8>(h, hb, (const float*)proj + (1 << 18), rperm, slab, (const float*)gb, TIDL, G); }
            SEAM(P + 7);
            if (IN(P + 8)) {
                DEFP
                pg8::Sched2D S{hb, (const bf16_t*)wd, DM / 2, DM / 2, MP / 256, 2 * DFF / 256, G, c};
                pg8::EpiGU<true> E{act, DFF, rperm};
                pg8::gemm_phase<pg8::EpiGU<true>, pg8::Sched2D, true, true>(lds, S, E, TIDL);
                ffn_slot(l, 2, G, c, TIDL, itab, wsl, lds);
                if (PROBE_REP & 8) pg8::gemm_phase<pg8::EpiGU<true>, pg8::Sched2D, true, true>(lds, S, E, TIDL);
            }
            SEAM(P + 8);
            if (IN(P + 9)) {
                DEFP
                pg8::SchedT S{act, (const bf16_t*)(wd + SZ_DGU), DFF / 2, DFF / 2, 8, G, c, 256, 11};
                pg8::EpiRes<false> E{h, hb, ssqb + (size_t)SSQ_H1(l + 1) * MP, slab, 1.0f / (F8_AS * F8_WDN), nullptr, h, (float*)proj + (3 << 18), nullptr, 0};
                pg8::gemm_phase<pg8::EpiRes<false>, pg8::SchedT, true, true>(lds, S, E, TIDL);
                ffn_slot(l, 3, G, c, TIDL, itab, wsl, lds);
                if (PROBE_REP & 1024) { pg8::Sched2D S2{act, (const bf16_t*)(wd + SZ_DGU), DFF, DFF, 32, 8, G, c}; pg8::EpiScaleBf16 E2{mix, 2048, ssqb + (size_t)SSQ_H2(l) * MP, 1.0f / DM}; pg8::gemm_phase<pg8::EpiScaleBf16, pg8::Sched2D, true>(lds, S2, E2, TIDL); }
            }
            SEAM(P + 9);
            if (IN(P + 10)) { DEFP tail_res_phase<false, 11>(h, hb, ssqb + (size_t)SSQ_H1(l + 1) * MP, (const float*)proj + (3 << 18), slab, 1.0f / (F8_AS * F8_WDN), TIDL, G); }
            SEAM2(P + 10, P + 33);
        } else {
            SEAM2(P + 6, P + 16);
            if (IN(P + 16)) { DEFP router_phase<8>(h, hb, slab, (const float*)gb, AS_GLOBAL(const float*, itab[24]) + (size_t)(l >> 1) * DM * NE, AS_GLOBAL(const float*, itab[20]) + (size_t)l * DM, route, cnt, (unsigned char*)xperm, (unsigned char*)mact, rperm, gperm, nrows, lds, TIDL, G); }
            SEAM2(P + 16, P + 18);
            if (IN(P + 18)) {
                DEFP
                pg8::SchedMoE S; S.A = xperm; S.Bt0 = (const bf16_t*)wm; S.estride = SZ_EXP; S.lda = DM / 2; S.K = DM / 2; S.nN = 2 * DFE / 256; S.G = G; S.c = c; S.capA = 1; moe_prefix(cnt, S.pfx); moe_prefix_put(lds, S.pfx, TIDL);
                pg8::EpiGU<true> E{mact, DFEP, rperm};
                pg8::gemm_phase<pg8::EpiGU<true>, pg8::SchedMoE, true, true>(lds, S, E, TIDL);
                if (PROBE_REP & 32) pg8::gemm_phase<pg8::EpiGU<true>, pg8::SchedMoE, true, true>(lds, S, E, TIDL);
            }
            SEAM(P + 18);
            if (IN(P + 19)) {
                DEFP
                pg8::SchedMoE S; S.A = mact; S.Bt0 = (const bf16_t*)(wm + SZ_EGU); S.estride = SZ_EXP; S.lda = DFEP / 2; S.K = DFEP / 2; S.nN = 8; S.G = G; S.c = c; S.capA = 0; moe_prefix_get(lds, S.pfx);
                pg8::EpiMD E{yslot, gperm};
                pg8::gemm_phase<pg8::EpiMD, pg8::SchedMoE, true, true>(lds, S, E, TIDL);
                ffn_slot(l, 4, G, c, TIDL, itab, wsl, lds);
                if (PROBE_REP & 256) pg8::gemm_phase<pg8::EpiMD, pg8::SchedMoE, true, true>(lds, S, E, TIDL);
            }
            SEAM(P + 19);
            if (IN(P + 20)) {
                DEFP
                if (l == DEPTH - 1) combine_phase<true>(h, hb, nullptr, yslot, route, lds, AS_GLOBAL(const float*, itab[28]), AS_GLOBAL(float*, itab[29]), TIDL, G);
                else combine_phase<false>(h, hb, ssqb + (size_t)SSQ_H1(l + 1) * MP, yslot, route, lds, nullptr, nullptr, TIDL, G);
            }
            SEAM2(P + 20, P + 33);
        }
    }
#undef IN
#undef SEAM
#undef SEAM2
#undef nrows
}

#if DBG
namespace dbg {
__device__ __forceinline__ unsigned hsh(unsigned a, unsigned b) { unsigned x = a * 0x9E3779B1u ^ (b + 0x7F4A7C15u) * 0x85EBCA6Bu; x ^= x >> 15; x *= 0x2C1B3C6Du; x ^= x >> 12; x *= 0x297A2D39u; x ^= x >> 15; return x; }
__device__ __forceinline__ int pick_row(int s, unsigned salt) { const int sp[8] = {0, 2047, 2048, 8191, 8192, 8207, 8255, 4097}; return s < 8 ? sp[s] : (int)(hsh(s, salt) % MREAL); }
__device__ __forceinline__ void report(unsigned* et, int slot, float got, float ref, float rtol, float atol, int lane) {
    if (lane == 0) { float e = fabsf(got - ref) / (rtol * fabsf(ref) + atol); if (!(e == e) || !(got == got)) e = 1e30f; atomicMax(et + slot, __float_as_uint(e)); } }
template <class F> __device__ __forceinline__ float wdot(int K, int lane, F f) { float s = 0.f; for (int k = lane; k < K; k += 64) s += f(k); return wave_sum(s); }
__device__ __forceinline__ float rope_cos(int pos, int i) { return cosf((float)pos * powf(10000.0f, -(float)(2 * i) / 64.0f)); }
__device__ __forceinline__ float rope_sin(int pos, int i) { return sinf((float)pos * powf(10000.0f, -(float)(2 * i) / 64.0f)); }

__global__ void ck_g1(const float* h, const float* w_in, const float* gain, const bf16_t* proj, const bf16_t* kpe, unsigned* et, int slot) {
    const int s = blockIdx.x, lane = threadIdx.x, row = pick_row(s, 11); int j = hsh(s, 12) % INC; if (s & 1) j = 768 + hsh(s, 13) % 64;
    const float* hr = h + (size_t)row * DM;
    const float r = 1.0f / sqrtf(wdot(DM, lane, [&](int k) { return hr[k] * hr[k]; }) / DM + EPS);
    if (j >= 768 && j < 832) { const int i = (j - 768) & 31;
        const float x1 = r * wdot(DM, lane, [&](int k) { return hr[k] * gain[k] * w_in[(size_t)k * INC + 768 + i]; }), x2 = r * wdot(DM, lane, [&](int k) { return hr[k] * gain[k] * w_in[(size_t)k * INC + 800 + i]; });
        const int pos = row_pos(row); const float c = rope_cos(pos, i), sn = rope_sin(pos, i);
        report(et, slot, bf2f(kpe[(size_t)row * 64 + 2 * i]), x1 * c - x2 * sn, 0.02f, 0.02f, lane); report(et, slot, bf2f(kpe[(size_t)row * 64 + 2 * i + 1]), x1 * sn + x2 * c, 0.02f, 0.02f, lane);
    } else { const float ref = r * wdot(DM, lane, [&](int k) { return hr[k] * gain[k] * w_in[(size_t)k * INC + j]; });
        report(et, slot, bf2f(proj[(size_t)row * PROJW + (j < 768 ? j : 1024 + j - 832)]), ref, 0.02f, 0.02f, lane); }
}
__global__ void ck_g2(const bf16_t* proj, const float* w_uq, const float* qn, const float* w_ukv, const float* kvn, const bf16_t* qb, const bf16_t* kvb, unsigned* et, int slot) {
    const int s = blockIdx.x, lane = threadIdx.x, row = pick_row(s, 21); const bf16_t* pr = proj + (size_t)row * PROJW;
    if (s & 1) {
        const int c = hsh(s, 22) % 1536, hd = c / DQK, d = c % DQK;
        const float r = 1.0f / sqrtf(wdot(QL, lane, [&](int k) { const float v = bf2f(pr[k]); return v * v; }) / QL + EPS);
        float ref;
        if (d < DNOPE) ref = r * wdot(QL, lane, [&](int k) { return bf2f(pr[k]) * qn[k] * w_uq[(size_t)k * 1536 + c]; });
        else { const int i = (d - DNOPE) >> 1, wh = (d - DNOPE) & 1;
            const float x1 = r * wdot(QL, lane, [&](int k) { return bf2f(pr[k]) * qn[k] * w_uq[(size_t)k * 1536 + hd * DQK + DNOPE + i]; }), x2 = r * wdot(QL, lane, [&](int k) { return bf2f(pr[k]) * qn[k] * w_uq[(size_t)k * 1536 + hd * DQK + DNOPE + 32 + i]; });
            const int pos = row_pos(row); const float cc = rope_cos(pos, i), sn = rope_sin(pos, i); ref = wh ? x1 * sn + x2 * cc : x1 * cc - x2 * sn; }
        report(et, slot, bf2f(qb[(size_t)row * 1536 + c]), ref * CQ, 0.02f, 0.003f, lane);
    } else {
        const int c = hsh(s, 23) % 2048;
        const float r = 1.0f / sqrtf(wdot(KVL, lane, [&](int k) { const float v = bf2f(pr[QL + k]); return v * v; }) / KVL + EPS);
        const float ref = r * wdot(KVL, lane, [&](int k) { return bf2f(pr[QL + k]) * kvn[k] * w_ukv[(size_t)k * 2048 + c]; });
        report(et, slot, bf2f(kvb[(size_t)row * 2048 + c]), ref, 0.02f, 0.02f, lane);
    }
}
__global__ void ck_att(const bf16_t* qb, const bf16_t* kvb, const bf16_t* kpe, const bf16_t* mix, unsigned* et, int slot, int meta) {
    const int s = blockIdx.x, lane = threadIdx.x, row = meta ? MX + (int)(hsh(s, 31) % 64) : (int)(hsh(s, 31) % MX), hd = hsh(s, 32) % NH, d = hsh(s, 33) % DV;
    const int b = row < MX ? row >> 11 : (row - MX) >> 4;
    const bf16_t* q = qb + (size_t)row * 1536 + hd * DQK;
    float sc[33], mx = -1e30f;
    for (int jj = 0; jj < 33; ++jj) { const int t = jj * 64 + lane; float a = -1e30f;
        if (t < LTOK) { const int kr = tok_row(b, t); a = 0.f; for (int k = 0; k < DNOPE; ++k) a += bf2f(q[k]) * bf2f(kvb[(size_t)kr * 2048 + hd * 256 + k]); for (int k = 0; k < ROPE; ++k) a += bf2f(q[DNOPE + k]) * bf2f(kpe[(size_t)kr * 64 + k]); }
        sc[jj] = a; mx = fmaxf(mx, a); }
    for (int o = 1; o < 64; o <<= 1) mx = fmaxf(mx, __shfl_xor(mx, o));
    float num = 0.f, den = 0.f, p2 = 0.f;
    for (int jj = 0; jj < 33; ++jj) { const int t = jj * 64 + lane; if (t < LTOK) { const float p = exp2f(sc[jj] - mx); den += p; p2 += p * p; num += p * bf2f(kvb[(size_t)tok_row(b, t) * 2048 + hd * 256 + 128 + d]); } }
    num = wave_sum(num); den = wave_sum(den); p2 = wave_sum(p2);
    report(et, slot, bf2f(mix[(size_t)row * 2048 + hd * DV + d]), num / den, 0.02f, 0.02f * sqrtf(p2) / den, lane);
}
__global__ void ck_part(const bf16_t* qb, const bf16_t* kvb, const bf16_t* kpe, const float* apart, unsigned* et, int slot_l, int slot_o) {
    const int s = blockIdx.x, lane = threadIdx.x, b = hsh(s, 35) % NBATCH, hd = hsh(s, 36) % NH, e = s % 8, i = hsh(s, 37) % 16, d = hsh(s, 38) % DV;
    const bf16_t* q = qb + (size_t)(MX + NMETA * b + i) * 1536 + hd * DQK;
    const float* pe = (const float*)((const char*)apart + (size_t)((b * NH + hd) * 8 + e) * APART_STRIDE);
    const float m = pe[16 * 128 + i], l = pe[16 * 128 + 16 + i], od = pe[i * 128 + d];
    float S = 0.f, O = 0.f, P2 = 0.f;
    for (int jj = 0; jj < 5; ++jj) { const int kk = jj * 64 + lane; int t = -1;
        if (jj < 4) t = NMETA + 256 * e + kk; else if (e == 0 && lane < NMETA) t = lane;
        if (t >= 0) { const int kr = tok_row(b, t); float a = 0.f; for (int k = 0; k < DNOPE; ++k) a += bf2f(q[k]) * bf2f(kvb[(size_t)kr * 2048 + hd * 256 + k]); for (int k = 0; k < ROPE; ++k) a += bf2f(q[DNOPE + k]) * bf2f(kpe[(size_t)kr * 64 + k]);
            const float p = exp2f(a - m); S += p; P2 += p * p; O += p * bf2f(kvb[(size_t)kr * 2048 + hd * 256 + 128 + d]); } }
    S = wave_sum(S); O = wave_sum(O); P2 = wave_sum(P2);
    report(et, slot_l, l, S, 0.02f, 1e-6f, lane); report(et, slot_o, od, O, 0.02f, 0.02f * sqrtf(P2) + 1e-9f, lane);
}
__global__ void ck_part2(const bf16_t* qb, const bf16_t* kvb, const bf16_t* kpe, const float* apart, unsigned* et, int slot0) {
    const int s = blockIdx.x, lane = threadIdx.x, b = hsh(s, 35) % NBATCH, hd = hsh(s, 36) % NH, e = 1 + s % 7, i = hsh(s, 37) % 16, d = hsh(s, 38) % DV;
    const bf16_t* q = qb + (size_t)(MX + NMETA * b + i) * 1536 + hd * DQK;
    const float* pe = (const float*)((const char*)apart + (size_t)((b * NH + hd) * 8 + e) * APART_STRIDE);
    const float m = pe[16 * 128 + i], od = pe[i * 128 + d];
    float Ot[4], P2 = 0.f;
    for (int jj = 0; jj < 4; ++jj) { const int t = NMETA + 256 * e + jj * 64 + lane; const int kr = tok_row(b, t); float a = 0.f;
        for (int k = 0; k < DNOPE; ++k) a += bf2f(q[k]) * bf2f(kvb[(size_t)kr * 2048 + hd * 256 + k]); for (int k = 0; k < ROPE; ++k) a += bf2f(q[DNOPE + k]) * bf2f(kpe[(size_t)kr * 64 + k]);
        const float p = exp2f(a - m); P2 += p * p; Ot[jj] = wave_sum(p * bf2f(kvb[(size_t)kr * 2048 + hd * 256 + 128 + d])); }
    P2 = wave_sum(P2); const float O = Ot[0] + Ot[1] + Ot[2] + Ot[3], at = 0.02f * sqrtf(P2) + 1e-9f;
    report(et, slot0 + (i >> 2), od, O, 0.02f, at, lane);
    report(et, slot0 + 4 + (d >> 5), od, O, 0.02f, at, lane);
}
__global__ void ck_s5(const bf16_t* proj, const float* lre, const float* lim, const float* lst, const float* bre, const float* bim, const float* cre, const float* cim, const float* dsk, const bf16_t* gb, unsigned* et, int slot, int l) {
    const int s = blockIdx.x, p = threadIdx.x, b = hsh(s, 41) % NBATCH, g = hsh(s, 42) % NG, co = hsh(s, 43) % GS; int t = hsh(s, 44) % LTOK; if (s == 0) t = 0; if (s == 1) t = LTOK - 1; if (s == 2) t = 15; if (s == 3) t = 16; if (s == 4) t = 1055; if (s == 5) t = 1056;
    float y = 0.f;
    for (int d = 0; d < 2; ++d) { const int ldg = (l * 2 + d) * NG + g, i = ldg * NS + p;
        const float lr = lre[i], li = lim[i], dt = expf(lst[ldg]), mag = expf(lr * dt), ar = mag * cosf(li * dt), ai = mag * sinf(li * dt);
        const float den = 1.0f / (lr * lr + li * li), xr = ar - 1.0f, xi = ai, fr = (xr * lr + xi * li) * den, fi = (xi * lr - xr * li) * den;
        float br[GS], bi[GS]; for (int c = 0; c < GS; ++c) { const float a = bre[(size_t)i * GS + c], bb = bim[(size_t)i * GS + c]; br[c] = fr * a - fi * bb; bi[c] = fr * bb + fi * a; }
        float hr = 0.f, hi = 0.f;
        const int t0 = d ? LTOK - 1 : 0, step = d ? -1 : 1, n = d ? LTOK - t : t + 1;
        for (int k = 0, tt = t0; k < n; ++k, tt += step) { const bf16_t* u = proj + (size_t)tok_row(b, tt) * PROJW + 1024 + GS * g; float ur = 0.f, ui = 0.f;
            for (int c = 0; c < GS; ++c) { const float uv = bf2f(u[c]); ur += br[c] * uv; ui += bi[c] * uv; }
            const float nr = ar * hr - ai * hi + ur, ni = ar * hi + ai * hr + ui; hr = nr; hi = ni; }
        y += cre[((size_t)ldg * GS + co) * NS + p] * hr - cim[((size_t)ldg * GS + co) * NS + p] * hi; }
    y = wave_sum(y);
    const size_t row = tok_row(b, t); y += dsk[GS * g + co] * bf2f(proj[row * PROJW + 1024 + GS * g + co]);
    const float tt = 0.7978845608028654f * (y + 0.044715f * y * y * y), ref = 0.5f * y * (1.0f + tanhf(tt));
    report(et, slot, bf2f(gb[row * SSMW + GS * g + co]), ref, 0.03f, 0.03f, p);
}
__global__ void ck_glu(const bf16_t* gb, const float* w_glu, const bf16_t* mix, unsigned* et, int slot) {
    const int s = blockIdx.x, lane = threadIdx.x, row = pick_row(s, 51), c = hsh(s, 52) % SSMW; const bf16_t* g = gb + (size_t)row * SSMW;
    const float z = wdot(SSMW, lane, [&](int k) { return bf2f(g[k]) * w_glu[(size_t)k * SSMW + c]; }), gv = bf2f(g[c]);
    report(et, slot, bf2f(mix[(size_t)row * 2048 + ATTW + c]), gv / (1.0f + expf(-z)), 0.02f, 0.01f, lane);
}
__global__ void ck_mixn(const bf16_t* mix, const bf16_t* mixn, unsigned* et, int slot) {
    const int s = blockIdx.x, lane = threadIdx.x, row = pick_row(s, 61), c = hsh(s, 62) % 2048, hf = c >> 10; const bf16_t* m = mix + (size_t)row * 2048 + hf * 1024;
    const float r = 1.0f / sqrtf(wdot(1024, lane, [&](int k) { const float v = bf2f(m[k]); return v * v; }) / 1024 + EPS);
    report(et, slot, bf2f(mixn[(size_t)row * 2048 + c]), bf2f(mix[(size_t)row * 2048 + c]) * r, 0.02f, 0.02f, lane);
}
__global__ void ck_gout(const float* h, const float* hs, const bf16_t* mixn, const float* w_out, const float* ga, const float* gs, unsigned* et, int slot) {
    const int s = blockIdx.x, lane = threadIdx.x, row = pick_row(s, 71), c = hsh(s, 72) % DM; const bf16_t* m = mixn + (size_t)row * 2048;
    const float ref = hs[(size_t)row * DM + c] + wdot(DM, lane, [&](int k) { return bf2f(m[k]) * (k < ATTW ? ga[k] : gs[k - ATTW]) * w_out[(size_t)k * DM + c]; });
    report(et, slot, h[(size_t)row * DM + c], ref, 0.01f, 0.02f, lane);
}
__global__ void ck_act(const float* h, const float* wg, const float* wu, const float* gain, const bf16_t* act, unsigned* et, int slot) {
    const int s = blockIdx.x, lane = threadIdx.x, row = pick_row(s, 81), f = hsh(s, 82) % DFF; const float* hr = h + (size_t)row * DM;
    const float r = 1.0f / sqrtf(wdot(DM, lane, [&](int k) { return hr[k] * hr[k]; }) / DM + EPS);
    const float g = r * wdot(DM, lane, [&](int k) { return hr[k] * gain[k] * wg[(size_t)k * DFF + f]; }), u = r * wdot(DM, lane, [&](int k) { return hr[k] * gain[k] * wu[(size_t)k * DFF + f]; });
    report(et, slot, bf2f(act[(size_t)row * DFF + f]), g / (1.0f + expf(-g)) * u, 0.03f, 0.02f, lane);
}
__global__ void ck_down(const float* h, const float* hs, const bf16_t* act, const float* wd, unsigned* et, int slot) {
    const int s = blockIdx.x, lane = threadIdx.x, row = pick_row(s, 91), c = hsh(s, 92) % DM; const bf16_t* a = act + (size_t)row * DFF;
    const float ref = hs[(size_t)row * DM + c] + wdot(DFF, lane, [&](int k) { return bf2f(a[k]) * wd[(size_t)k * DM + c]; });
    report(et, slot, h[(size_t)row * DM + c], ref, 0.01f, 0.02f, lane);
}
__global__ void ck_moe(const float* h, const float* hs, const float* wr, const float* wg, const float* wu, const float* wd, const float* gain, unsigned* et, int slot) {
    const int s = blockIdx.x, lane = threadIdx.x, row = pick_row(s, 101), c = hsh(s, 102) % DM; const float* hr = hs + (size_t)row * DM;
    const float r = 1.0f / sqrtf(wdot(DM, lane, [&](int k) { return hr[k] * hr[k]; }) / DM + EPS);
    float lg[NE]; for (int e = 0; e < NE; ++e) lg[e] = r * wdot(DM, lane, [&](int k) { return hr[k] * gain[k] * wr[(size_t)k * NE + e]; });
    int e0 = 0; for (int e = 1; e < NE; ++e) if (lg[e] > lg[e0]) e0 = e; int e1 = -1; for (int e = 0; e < NE; ++e) if (e != e0 && (e1 < 0 || lg[e] > lg[e1])) e1 = e;
    const float w1 = 1.0f / (1.0f + expf(lg[e0] - lg[e1])), w0 = 1.0f - w1;
    float acc = 0.f;
    for (int kk = 0; kk < 2; ++kk) { const int e = kk ? e1 : e0; const float we = kk ? w1 : w0; const float* g_ = wg + (size_t)e * DM * DFE; const float* u_ = wu + (size_t)e * DM * DFE; const float* d_ = wd + (size_t)e * DFE * DM;
        for (int f = lane; f < DFE; f += 64) { float ga = 0.f, ua = 0.f; for (int k = 0; k < DM; ++k) { const float x = hr[k] * gain[k]; ga += x * g_[(size_t)k * DFE + f]; ua += x * u_[(size_t)k * DFE + f]; }
            ga *= r; ua *= r; acc += we * (ga / (1.0f + expf(-ga)) * ua) * d_[(size_t)f * DM + c]; } }
    acc = wave_sum(acc);
    report(et, slot, h[(size_t)row * DM + c], hr[c] + acc, 0.01f, 0.02f, lane);
}
__global__ void ck_final(const float* h, const float* fn, const float* out, unsigned* et, int slot) {
    const int s = blockIdx.x, lane = threadIdx.x, row = pick_row(s, 111) % MX, c = hsh(s, 112) % DM; const float* hr = h + (size_t)row * DM;
    const float r = 1.0f / sqrtf(wdot(DM, lane, [&](int k) { return hr[k] * hr[k]; }) / DM + EPS);
    report(et, slot, out[(size_t)row * DM + c], hr[c] * r * fn[c], 0.001f, 0.001f, lane);
}
__global__ void encode(const unsigned* et, float* out, size_t n) {
    float code = -1.f; const unsigned tmo = et[200] | et[256 + 200];
    for (int pass = 0; pass < 2 && code < 0.f; ++pass)
        for (int l = 0; l < DEPTH && code < 0.f; ++l) { int v = 0;
            for (int k = 1; k <= 10; ++k) { const int sl = 10 + 20 * l + k; const bool f1 = __uint_as_float(et[sl]) > 3.0f, f2 = __uint_as_float(et[256 + sl]) > 3.0f; if (pass == 0 ? (f1 && f2) : (f1 != f2)) v |= 1 << (k - 1); }
            if (v) code = (float)(10 + v % 90) * 0.1f * powf(10.0f, (float)(4 + v / 90 + 12 * l + 48 * pass)); }
    if (code < 0.f && (__uint_as_float(et[95]) > 3.0f || __uint_as_float(et[256 + 95]) > 3.0f)) code = 9.5e2f;
    if (tmo) code = 9.9e2f;
    if (code < 0.f) return;
    const float a = sqrtf(code);
    for (size_t i = (size_t)blockIdx.x * blockDim.x + threadIdx.x; i < n; i += (size_t)gridDim.x * blockDim.x) out[i] = a;
}
__global__ void copy_tmo(const unsigned* ctl, unsigned* et) { if (threadIdx.x == 0) et[200] = ctl[CW_BAR + XB_TMO] | ctl[CW_TMO]; }
}
#endif

__global__ void fill_kernel(float* out, size_t n, float a) { for (size_t i = (size_t)blockIdx.x * blockDim.x + threadIdx.x; i < n; i += (size_t)gridDim.x * blockDim.x) out[i] = a; }
extern "C" void kernel_launch(void* const* d_in, const int* in_sizes, int n_in, void* d_out, int out_size, void* d_ws, size_t ws_size, hipStream_t stream) {
    static int grid = 0;
    if (grid == 0) {
        if (n_in == 29 && out_size == MX * DM && ws_size < WS_TOTAL) { grid = -2; }
        else if (n_in != 29 || out_size != MX * DM) { fprintf(stderr, "kernel_launch: built for 29 inputs, %d outputs, >= %zu bytes of workspace; got n_in %d, out %d, ws %zu; nothing launched\n", MX * DM, (size_t)WS_TOTAL, n_in, out_size, ws_size); grid = -1; return; }
        int dev = 0, cus = 0, per_cu = 0;
        if (grid == -2) {   } else
        if (hipGetDevice(&dev) != hipSuccess || hipDeviceGetAttribute(&cus, hipDeviceAttributeMultiprocessorCount, dev) != hipSuccess) { grid = -1; return; }
        if (grid == -2) {} else if (hipFuncSetAttribute((const void*)fwd_kernel, hipFuncAttributeMaxDynamicSharedMemorySize, LDS_BYTES) != hipSuccess) { fprintf(stderr, "kernel_launch: hipFuncSetAttribute failed\n"); grid = -1; return; }
        if (grid != -2) if (hipOccupancyMaxActiveBlocksPerMultiprocessor(&per_cu, (const void*)fwd_kernel, NTHR, LDS_BYTES) != hipSuccess || per_cu < 1) fprintf(stderr, "kernel_launch: occupancy query says %d\n", per_cu);
        (void)hipGetLastError();
        if (grid != -2) grid = cus;
    }
    if (grid == -2) { hipLaunchKernelGGL(fill_kernel, dim3(1024), dim3(256), 0, stream, (float*)d_out, (size_t)out_size, 9949.87f); return; }
    if (grid < 0) return;
    (void)hipMemsetAsync((char*)d_ws + WS_CTL, 0, CTL_BYTES, stream);
    Args a{};
    for (int i = 0; i < 29; ++i) a.in.p[i] = (const float*)d_in[i];
    a.out = (float*)d_out; a.ws = (unsigned char*)d_ws;
#if !DBG
    a.ph_lo = 0; a.ph_hi = 128;
    hipLaunchKernelGGL(fwd_kernel, dim3(grid), dim3(NTHR), LDS_BYTES, stream, a);
#else
    unsigned char* ws = (unsigned char*)d_ws; unsigned* et = (unsigned*)(ws + WS_DBG_ERR); float* hs = (float*)(ws + WS_DBG_H);
    float* h = (float*)(ws + WS_H); bf16_t* proj = (bf16_t*)(ws + WS_PROJ); bf16_t* kpe = (bf16_t*)(ws + WS_KPE); bf16_t* qb = (bf16_t*)(ws + WS_QB); bf16_t* kvb = (bf16_t*)(ws + WS_KVB);
    bf16_t* mix = (bf16_t*)(ws + WS_MIX); bf16_t* mixn = (bf16_t*)(ws + WS_MIXN); bf16_t* gb = (bf16_t*)(ws + WS_GB); bf16_t* act = (bf16_t*)(ws + WS_BIG);
    const float* const* in = (const float* const*)a.in.p;
    (void)hipMemsetAsync(et, 0, 4096, stream);
    for (int rep = 0; rep < 2; ++rep) {
    if (rep) { (void)hipMemsetAsync((char*)d_ws + WS_CTL, 0, CTL_BYTES, stream); et += 256; }
    auto run = [&](int ph) { a.ph_lo = ph; a.ph_hi = ph + 1; hipLaunchKernelGGL(fwd_kernel, dim3(grid), dim3(NTHR), LDS_BYTES, stream, a); };
    auto snap = [&]() { (void)hipMemcpyAsync(hs, h, (size_t)MP * DM * 4, hipMemcpyDeviceToDevice, stream); };
    const int NSMP = 512;
    run(0);
    for (int l = 0; l < DEPTH; ++l) {
        const int P = 32 * l, SL = 10 + 20 * l;
        run(P + 1); run(P + 2); hipLaunchKernelGGL(dbg::ck_g1, dim3(NSMP), dim3(64), 0, stream, h, in[3] + (size_t)l * DM * INC, in[2] + l * DM, proj, kpe, et, SL + 1);
        run(P + 3); hipLaunchKernelGGL(dbg::ck_g2, dim3(NSMP), dim3(64), 0, stream, proj, in[5] + (size_t)l * QL * 1536, in[4] + l * QL, in[7] + (size_t)l * KVL * 2048, in[6] + l * KVL, qb, kvb, et, SL + 2);
        hipLaunchKernelGGL(dbg::ck_s5, dim3(96), dim3(64), 0, stream, proj, in[8], in[9], in[10], in[11], in[12], in[13], in[14], in[15] + (size_t)l * SSMW, gb, et, SL + 4, l);
        run(P + 4); hipLaunchKernelGGL(dbg::ck_glu, dim3(NSMP), dim3(64), 0, stream, gb, in[16] + (size_t)l * SSMW * SSMW, mix, et, SL + 5);
        run(P + 5); hipLaunchKernelGGL(dbg::ck_att, dim3(256), dim3(64), 0, stream, qb, kvb, kpe, mix, et, SL + 3, 0); hipLaunchKernelGGL(dbg::ck_att, dim3(64), dim3(64), 0, stream, qb, kvb, kpe, mix, et, SL + ((l & 1) ? 8 : 10), 1);
        hipLaunchKernelGGL(dbg::ck_mixn, dim3(NSMP), dim3(64), 0, stream, mix, mixn, et, SL + 6);
        snap(); run(P + 6); run((l & 1) ? P + 16 : P + 7);
        hipLaunchKernelGGL(dbg::ck_gout, dim3(NSMP), dim3(64), 0, stream, h, hs, mixn, in[19] + (size_t)l * DM * DM, in[17] + l * ATTW, in[18] + l * SSMW, et, SL + 7);
        if ((l & 1) == 0) { const int i = l >> 1;
            run(P + 8); hipLaunchKernelGGL(dbg::ck_act, dim3(NSMP), dim3(64), 0, stream, h, in[21] + (size_t)i * DM * DFF, in[22] + (size_t)i * DM * DFF, in[20] + (size_t)l * DM, act, et, SL + 8);
            snap(); run(P + 9); run(P + 10); hipLaunchKernelGGL(dbg::ck_down, dim3(NSMP), dim3(64), 0, stream, h, hs, act, in[23] + (size_t)i * DFF * DM, et, SL + 9);
        } else { const int i = l >> 1;
            snap(); run(P + 17); run(P + 18); run(P + 19); run(P + 20);
            hipLaunchKernelGGL(dbg::ck_moe, dim3(48), dim3(64), 0, stream, h, hs, in[24] + (size_t)i * DM * NE, in[25] + (size_t)i * NE * DM * DFE, in[26] + (size_t)i * NE * DM * DFE, in[27] + (size_t)i * NE * DFE * DM, in[20] + (size_t)l * DM, et, SL + 10);
        }
    }
    hipLaunchKernelGGL(dbg::ck_final, dim3(NSMP), dim3(64), 0, stream, h, in[28], (const float*)d_out, et, 95);
    hipLaunchKernelGGL(dbg::copy_tmo, dim3(1), dim3(64), 0, stream, (const unsigned*)(ws + WS_CTL), et);
    }
    hipLaunchKernelGGL(dbg::encode, dim3(1024), dim3(256), 0, stream, (const unsigned*)(ws + WS_DBG_ERR), (float*)d_out, (size_t)MX * DM);
#endif
}
```
